# Optimizing an MI355X kernel written in HIP

```python
import math
import jax
import jax.numpy as jnp
from jax import lax
import numpy as np

D_MODEL = 1024
BATCH = 8
SEQ = 8192
DEPTH = 4

HEAD_DIM = 64
N_HEADS = D_MODEL // HEAD_DIM
MEM_HEADS = 4
NA_HEADS = (N_HEADS - MEM_HEADS) // 2
DIL_HEADS = N_HEADS - MEM_HEADS - NA_HEADS
NA_WIDTH = NA_HEADS * HEAD_DIM
DIL_WIDTH = DIL_HEADS * HEAD_DIM
MEM_WIDTH = MEM_HEADS * HEAD_DIM
IN_PROJ_DIM = 3 * NA_WIDTH + 3 * DIL_WIDTH + MEM_WIDTH
GRID_W = 64
NA_WIN_ROWS = 8
NA_WIN_COLS = 16
DIL_BRANCHES = ((128, 1), (512, 4), (2048, 16))
DIL_Q_BLOCK = 64
ROPE_THETA = 500000.0
ROT_DIM = HEAD_DIM // 4
N_MEM = 256
FFN_DIM = 3584
N_EXPERTS = 8
TOP_K = 2
MOE_BLOCK = 512
RMS_EPS = 1e-6
ATTN_SCALE = HEAD_DIM ** -0.5

kernel_name = 'hybrid_na_dilated_mem_moe_encoder'


def rms_norm(x, g):
    xf = x.astype(jnp.float32)
    y = xf * lax.rsqrt(jnp.mean(xf * xf, axis=-1, keepdims=True) + RMS_EPS)
    return (y * g.astype(jnp.float32)).astype(x.dtype)


def partial_rotary(x):
    t = x.shape[1]
    half = ROT_DIM // 2
    inv_freq = ROPE_THETA ** (-jnp.arange(0, ROT_DIM, 2, dtype=jnp.float32) / ROT_DIM)
    ang = jnp.arange(t, dtype=jnp.float32)[:, None] * inv_freq[None, :]
    cos = jnp.cos(ang)[None, :, None, :]
    sin = jnp.sin(ang)[None, :, None, :]
    xr = x[..., :ROT_DIM].astype(jnp.float32)
    x1, x2 = xr[..., :half], xr[..., half:]
    rot = jnp.concatenate([x1 * cos - x2 * sin, x2 * cos + x1 * sin], axis=-1).astype(x.dtype)
    return jnp.concatenate([rot, x[..., ROT_DIM:]], axis=-1)


def neighbourhood_attention(q, k, v, rpb):
    bsz, t, _ = q.shape
    rows = t // GRID_W
    win_r = min(NA_WIN_ROWS, rows)

    def grid(a):
        return a.reshape(bsz, rows, GRID_W, NA_HEADS, HEAD_DIM).transpose(0, 3, 1, 2, 4)

    qg, kg, vg = grid(q * ATTN_SCALE), grid(k), grid(v)
    row_start = jnp.clip(jnp.arange(rows) - win_r // 2, 0, rows - win_r)
    col_start = jnp.clip(jnp.arange(GRID_W) - NA_WIN_COLS // 2, 0, GRID_W - NA_WIN_COLS)
    col_idx = col_start[:, None] + jnp.arange(NA_WIN_COLS)[None, :]
    col_off = col_idx - jnp.arange(GRID_W)[:, None] + (NA_WIN_COLS - 1)

    def row_block(r):
        r0 = row_start[r]
        k_rows = lax.dynamic_slice_in_dim(kg, r0, win_r, axis=2)
        v_rows = lax.dynamic_slice_in_dim(vg, r0, win_r, axis=2)
        k_nb = k_rows[:, :, :, col_idx]
        v_nb = v_rows[:, :, :, col_idx]
        q_r = lax.dynamic_index_in_dim(qg, r, axis=2, keepdims=False)
        s = jnp.einsum('bhcd,bhrckd->bhcrk', q_r, k_nb, preferred_element_type=jnp.float32)
        row_off = r0 + jnp.arange(win_r) - r + (NA_WIN_ROWS - 1)
        bias = rpb[:, row_off[None, :, None], col_off[:, None, :]]
        s = s + bias[None].astype(jnp.float32)
        p = jax.nn.softmax(s.reshape(bsz, NA_HEADS, GRID_W, win_r * NA_WIN_COLS), axis=-1)
        p = p.reshape(s.shape).astype(v.dtype)
        return jnp.einsum('bhcrk,bhrckd->bhcd', p, v_nb)

    o = lax.map(row_block, jnp.arange(rows))
    return o.transpose(1, 0, 3, 2, 4).reshape(bsz, t, NA_WIDTH)


def dilated_branch(q, k, v, dil, n_side):
    bsz, nh, t, hd = q.shape
    seg = t // dil
    qb = math.gcd(DIL_Q_BLOCK, seg)
    nb = seg // qb
    width = qb + 2 * n_side

    def by_residue(a):
        return a.reshape(bsz, nh, seg, dil, hd).transpose(0, 1, 3, 2, 4)

    pad = ((0, 0), (0, 0), (0, 0), (n_side, n_side), (0, 0))
    qs = by_residue(q).reshape(bsz, nh, dil, nb, qb, hd)
    ks = jnp.pad(by_residue(k), pad)
    vs = jnp.pad(by_residue(v), pad)
    win = jnp.arange(nb)[:, None] * qb + jnp.arange(width)[None, :]
    kw = ks[:, :, :, win]
    vw = vs[:, :, :, win]
    s = jnp.einsum('bhrnqd,bhrnkd->bhrnqk', qs, kw, preferred_element_type=jnp.float32)
    key_m = win - n_side
    query_m = jnp.arange(nb)[:, None] * qb + jnp.arange(qb)[None, :]
    dist = key_m[:, None, :] - query_m[:, :, None]
    valid = (jnp.abs(dist) <= n_side) & (key_m[:, None, :] >= 0) & (key_m[:, None, :] < seg)
    s = jnp.where(valid, s, -jnp.inf)
    m = jnp.max(s, axis=-1, keepdims=True)
    p = jnp.exp(s - m)
    den = jnp.sum(p, axis=-1, keepdims=True)
    o = jnp.einsum('bhrnqk,bhrnkd->bhrnqd', (p / den).astype(v.dtype), vw)
    lse = (m + jnp.log(den))[..., 0]
    o = o.reshape(bsz, nh, dil, seg, hd).transpose(0, 1, 3, 2, 4).reshape(bsz, nh, t, hd)
    lse = lse.reshape(bsz, nh, dil, seg).transpose(0, 1, 3, 2).reshape(bsz, nh, t)
    return o, lse


def dilated_attention(q, k, v):
    bsz, t, _ = q.shape
    qh = partial_rotary((q * ATTN_SCALE).reshape(bsz, t, DIL_HEADS, HEAD_DIM)).transpose(0, 2, 1, 3)
    kh = partial_rotary(k.reshape(bsz, t, DIL_HEADS, HEAD_DIM)).transpose(0, 2, 1, 3)
    vh = v.reshape(bsz, t, DIL_HEADS, HEAD_DIM).transpose(0, 2, 1, 3)
    outs, lses = [], []
    for window, dil in DIL_BRANCHES:
        o, lse = dilated_branch(qh, kh, vh, dil, window // (2 * dil))
        outs.append(o)
        lses.append(lse)
    w = jax.nn.softmax(jnp.stack(lses), axis=0)
    o = jnp.einsum('gbht,gbhtd->bthd', w, jnp.stack(outs).astype(jnp.float32))
    return o.reshape(bsz, t, DIL_WIDTH).astype(q.dtype)


def memory_attention(q, mem, g_mem, w_mem_kv):
    bsz, t, _ = q.shape
    kv = jnp.dot(rms_norm(mem, g_mem), w_mem_kv)
    k, v = jnp.split(kv, 2, axis=-1)
    qh = (q * ATTN_SCALE).reshape(bsz, t, MEM_HEADS, HEAD_DIM)
    kh = k.reshape(bsz, -1, MEM_HEADS, HEAD_DIM)
    vh = v.reshape(bsz, -1, MEM_HEADS, HEAD_DIM)
    s = jnp.einsum('bthd,bmhd->bhtm', qh, kh, preferred_element_type=jnp.float32)
    p = jax.nn.softmax(s, axis=-1).astype(v.dtype)
    o = jnp.einsum('bhtm,bmhd->bthd', p, vh)
    return o.reshape(bsz, t, MEM_WIDTH)


def swiglu(h, w_gate, w_up, w_down):
    return jnp.dot(jax.nn.silu(jnp.dot(h, w_gate)) * jnp.dot(h, w_up), w_down)


def moe_swiglu(h, w_router, w_gate, w_up, w_down):
    n, d = h.shape
    n_assign = n * TOP_K
    logits = jnp.dot(h, w_router).astype(jnp.float32)
    top_logit, top_idx = lax.top_k(logits, TOP_K)
    gates = jax.nn.softmax(top_logit, axis=-1)
    flat_e = top_idx.reshape(-1)
    flat_tok = jnp.repeat(jnp.arange(n), TOP_K)
    order = jnp.argsort(flat_e)
    e_sorted = flat_e[order]
    tok_sorted = flat_tok[order]
    gate_sorted = gates.reshape(-1)[order]
    counts = jnp.bincount(flat_e, length=N_EXPERTS)
    padded = (counts + MOE_BLOCK - 1) // MOE_BLOCK * MOE_BLOCK
    start = jnp.cumsum(counts) - counts
    pend = jnp.cumsum(padded)
    pstart = pend - padded
    dest = pstart[e_sorted] + jnp.arange(n_assign) - start[e_sorted]
    n_blocks = -(-n_assign // MOE_BLOCK) + N_EXPERTS
    buf = jnp.zeros((n_blocks * MOE_BLOCK, d), h.dtype).at[dest].set(h[tok_sorted])
    block_first = jnp.arange(n_blocks) * MOE_BLOCK
    block_expert = jnp.minimum(jnp.sum(block_first[:, None] >= pend[None, :], axis=1), N_EXPERTS - 1)

    def expert_block(args):
        xb, e = args
        return swiglu(xb, w_gate[e], w_up[e], w_down[e])

    yb = lax.map(expert_block, (buf.reshape(n_blocks, MOE_BLOCK, d), block_expert))
    y_sorted = yb.reshape(-1, d)[dest]
    contrib = gate_sorted[:, None].astype(h.dtype) * y_sorted
    return jax.ops.segment_sum(contrib, tok_sorted, num_segments=n)


def setup_inputs(seed: int = 0) -> dict:
    key = jax.random.key(seed)
    ks = jax.random.split(key, 18)
    f32 = jnp.float32
    n_dense = (DEPTH + 1) // 2
    n_moe = DEPTH // 2
    out_scale = (2 * DEPTH) ** -0.5

    def normal(k, shape, scale):
        return jax.random.normal(k, shape, f32) * scale

    def gain(k, shape):
        return 1.0 + 0.05 * jax.random.normal(k, shape, f32)

    return {
        'x': normal(ks[0], (BATCH, SEQ, D_MODEL), 1.0),
        'mem': normal(ks[1], (BATCH, N_MEM, D_MODEL), 1.0),
        'g_mix_norm': gain(ks[2], (DEPTH, D_MODEL)),
        'w_in': normal(ks[3], (DEPTH, D_MODEL, IN_PROJ_DIM), D_MODEL ** -0.5),
        'rpb': normal(ks[4], (DEPTH, NA_HEADS, 2 * NA_WIN_ROWS - 1, 2 * NA_WIN_COLS - 1), 0.1),
        'g_mem_norm': gain(ks[5], (DEPTH, D_MODEL)),
        'w_mem_kv': normal(ks[6], (DEPTH, D_MODEL, 2 * MEM_WIDTH), D_MODEL ** -0.5),
        'g_mix_out': gain(ks[7], (DEPTH, D_MODEL)),
        'w_out': normal(ks[8], (DEPTH, D_MODEL, D_MODEL), D_MODEL ** -0.5 * out_scale),
        'g_ffn_norm': gain(ks[9], (DEPTH, D_MODEL)),
        'w_dense_gate': normal(ks[10], (n_dense, D_MODEL, FFN_DIM), D_MODEL ** -0.5),
        'w_dense_up': normal(ks[11], (n_dense, D_MODEL, FFN_DIM), D_MODEL ** -0.5),
        'w_dense_down': normal(ks[12], (n_dense, FFN_DIM, D_MODEL), FFN_DIM ** -0.5 * out_scale),
        'w_router': normal(ks[13], (n_moe, D_MODEL, N_EXPERTS), D_MODEL ** -0.5),
        'w_moe_gate': normal(ks[14], (n_moe, N_EXPERTS, D_MODEL, FFN_DIM), D_MODEL ** -0.5),
        'w_moe_up': normal(ks[15], (n_moe, N_EXPERTS, D_MODEL, FFN_DIM), D_MODEL ** -0.5),
        'w_moe_down': normal(ks[16], (n_moe, N_EXPERTS, FFN_DIM, D_MODEL), FFN_DIM ** -0.5 * out_scale),
        'g_final': gain(ks[17], (D_MODEL,)),
    }


def reference(x, mem, g_mix_norm, w_in, rpb, g_mem_norm, w_mem_kv, g_mix_out, w_out,
              g_ffn_norm, w_dense_gate, w_dense_up, w_dense_down, w_router,
              w_moe_gate, w_moe_up, w_moe_down, g_final):
    bsz, t, d = x.shape
    widths = [NA_WIDTH] * 3 + [DIL_WIDTH] * 3 + [MEM_WIDTH]
    split_at = [sum(widths[:i + 1]) for i in range(len(widths) - 1)]
    for layer in range(DEPTH):
        h = rms_norm(x, g_mix_norm[layer])
        proj = jnp.dot(h, w_in[layer])
        qa, ka, va, qb, kb, vb, qm = jnp.split(proj, split_at, axis=-1)
        out_a = neighbourhood_attention(qa, ka, va, rpb[layer])
        out_b = dilated_attention(qb, kb, vb)
        out_m = memory_attention(qm, mem, g_mem_norm[layer], w_mem_kv[layer])
        gm = g_mix_out[layer]
        y = jnp.concatenate([
            rms_norm(out_a, gm[:NA_WIDTH]),
            rms_norm(out_b, gm[NA_WIDTH:NA_WIDTH + DIL_WIDTH]),
            rms_norm(out_m, gm[NA_WIDTH + DIL_WIDTH:]),
        ], axis=-1)
        x = x + jnp.dot(y, w_out[layer])
        h = rms_norm(x, g_ffn_norm[layer]).reshape(bsz * t, d)
        if layer % 2 == 0:
            i = layer // 2
            f = swiglu(h, w_dense_gate[i], w_dense_up[i], w_dense_down[i])
        else:
            i = layer // 2
            f = moe_swiglu(h, w_router[i], w_moe_gate[i], w_moe_up[i], w_moe_down[i])
        x = x + f.reshape(bsz, t, d)
    return rms_norm(x, g_final)
```

```cpp
#include <hip/hip_runtime.h>
#include <cstdio>
#include <cstdint>

#ifndef MK_ONE_LAUNCH
#define MK_ONE_LAUNCH 1
#endif
#define MAXSEQ 1000
#ifndef PROBE_ATT_REPS
#define PROBE_ATT_REPS 1
#endif
#ifndef PROBE_QKV_REPS
#define PROBE_QKV_REPS 1
#endif
#ifndef DENSE_UP8_MASK
#define DENSE_UP8_MASK 5
#endif
#ifndef DENSE_DN8_MASK
#define DENSE_DN8_MASK 5
#endif
#define DENSE_UP8(L) (((DENSE_UP8_MASK) >> (L)) & 1)
#define DENSE_DN8(L) (((DENSE_DN8_MASK) >> (L)) & 1)
#ifndef QKV_FP8
#define QKV_FP8 0
#endif
#ifndef PROBE_BAR2
#define PROBE_BAR2 0
#endif
#ifndef PROBE_PE2
#define PROBE_PE2 0
#endif
#ifndef PROBE_SAMPLE
#define PROBE_SAMPLE 0
#endif
#ifndef PROBE_CONV_REPS
#define PROBE_CONV_REPS 1
#endif

#define GAS __attribute__((address_space(1)))
#define LAS __attribute__((address_space(3)))
typedef unsigned short bf16;
typedef short bf16x8 __attribute__((ext_vector_type(8)));
typedef float f32x4 __attribute__((ext_vector_type(4)));
typedef float f32x2 __attribute__((ext_vector_type(2)));
typedef unsigned u32x4 __attribute__((ext_vector_type(4)));
typedef unsigned u32x2 __attribute__((ext_vector_type(2)));
typedef short v4i16_t __attribute__((ext_vector_type(4)));

constexpr int BATCH = 8, T = 8192, D = 1024, M = BATCH * T, DEPTH = 4;
constexpr int NQKV = 2560, FF = 3584, NE = 8, NMEM = 256, MROWS = BATCH * NMEM;
constexpr int OFF_QA = 0, OFF_KA = 384, OFF_VA = 768, OFF_QB = 1152, OFF_KB = 1536, OFF_VB = 1920, OFF_QM = 2304;
constexpr float RMS_EPS = 1e-6f;
constexpr float LOG2E = 1.4426950408889634f;
constexpr float QSCALE = 0.125f * LOG2E;
constexpr int XP = 2 * D;
constexpr int NWAVES = 8;
constexpr int MAXTILES = 520;
constexpr int CHUNK_TILES = 256;
constexpr int NCHUNK = 5;

constexpr size_t MiB = 1u << 20;
constexpr size_t WS_CTL = 0, CTL_ZERO_BYTES = 1 * MiB;
constexpr size_t WS_COS = 2 * MiB, WS_SIN = 2 * MiB + 256 * 1024;
constexpr size_t WS_E01 = 4 * MiB;
constexpr size_t WS_GATE = 4 * MiB + 256 * 1024;
constexpr size_t WS_POS = 5 * MiB;
constexpr size_t WS_TCNT = 6 * MiB;
constexpr size_t WS_TEXP = 6 * MiB + 64 * 1024;
constexpr size_t WS_SSQ = 8 * MiB;
constexpr size_t WS_WC = 16 * MiB, WC_STRIDE = 8 * MiB;
constexpr size_t WC_IN = 0, WC_MKV = 5 * MiB, WC_OUT = 6 * MiB;
constexpr size_t WS_WD = 48 * MiB, WD_STRIDE = 21 * MiB;
constexpr size_t WS_WM = 90 * MiB, WM_STRIDE = 112 * MiB;
constexpr size_t WM_DOWN = 56 * MiB;
constexpr size_t WS_HB = 314 * MiB;
constexpr size_t WS_BIG = 442 * MiB;
constexpr size_t WS_GA = WS_BIG, WS_HIDC = WS_BIG + 260 * MiB;
constexpr size_t WS_GA8 = 926 * MiB;
constexpr size_t WS_MEMN4 = 1056 * MiB;
constexpr size_t WS_MEMKV4 = 1072 * MiB;
constexpr size_t WS_END = 1080 * MiB;
static_assert(WS_HIDC + (size_t)CHUNK_TILES * 256 * FF <= WS_GA8 && WS_BIG + (size_t)M * FF * 2 <= WS_GA8 && WS_GA8 + (size_t)MAXTILES * 256 * D <= WS_END, "ws map");
constexpr float A8_SCALE = 32.0f, W8_SCALE = 1024.0f, ACC8_SCALE = 1.0f / 32768.0f;
constexpr float H8_SCALE = 16.0f, WD8_SCALE = 4096.0f, ACCD8_SCALE = 1.0f / 65536.0f;
constexpr size_t WD8_ESTRIDE = (size_t)D * FF;

constexpr int CW_TMO = 0, CW_CODE = 1, CW_BAR = 4096;

constexpr int RING_BYTES = 131072;
constexpr int MISC_OFF = 139264;
constexpr int LDS_BYTES = 155648;
constexpr int MISC_BARW = 0;
constexpr int MISC_TEXP = 64;
constexpr int MISC_PTAB = 2560;
constexpr int MISC_SCR = 4096;

__device__ __forceinline__ float vmax2(float a, float b) { return __builtin_amdgcn_fmed3f(a, b, INFINITY); }
__device__ __forceinline__ float vmax3(float a, float b, float c) { return vmax2(vmax2(a, b), c); }
__device__ __forceinline__ float clamp8(float x) { return __builtin_amdgcn_fmed3f(x, -448.0f, 448.0f); }
__device__ __forceinline__ unsigned cvt4_fp8(float a, float b, float c, float d) {
    unsigned w = 0; w = __builtin_amdgcn_cvt_pk_fp8_f32(clamp8(a), clamp8(b), w, false); w = __builtin_amdgcn_cvt_pk_fp8_f32(clamp8(c), clamp8(d), w, true); return w; }
namespace pg8 {
#define PG8_LAS __attribute__((address_space(3)))
typedef unsigned short bf16_t;
constexpr int BM = 256, BK = 64, HALF = 128, HTB = HALF * BK * 2, STAGE_BYTES = 8 * HTB, NXCD = 8, WGM = 8;

__host__ __device__ __forceinline__ int lds_byte(int r, int c) { const int st = (r >> 4) * 2 + (c >> 5), rr = r & 15, cc = c & 31, ob = rr * 64 + cc * 2; return st * 1024 + (ob ^ (((ob >> 9) & 1) << 5)); }
__host__ __device__ __forceinline__ void stage_rc(int b, int& R, int& C) { const int st = b / 1024, sb = b % 1024, swz = sb ^ (((sb >> 9) & 1) << 5); R = (st >> 1) * 16 + swz / 64; C = (st & 1) * 32 + (swz % 64) / 2; }
__host__ __device__ __forceinline__ int perm32(int rho) { const int n = rho >> 4, i = rho & 15; return 8 * (i >> 2) + 4 * n + (i & 3); }

struct Unit { int pm, pn, e; };
struct Gemm { const bf16_t* A; const bf16_t* Bt; int M, N, K; size_t estride; };

struct TileOrder {
    int nM, nN, nwg, G, c; const PG8_LAS int* texp;
    __device__ void init(int Mr, int N, int G_, int c_, const PG8_LAS int* texp_) { nM = Mr / BM; nN = N / BM; nwg = nM * nN; G = G_; c = c_; texp = texp_; }
    __device__ bool next(int i, Unit& u) const {
        const long L = (long)i * G + c; if (L >= nwg) return false;
        int wgid = (int)L; { const int q = nwg / NXCD, r = nwg % NXCD, xcd = wgid % NXCD, off = wgid / NXCD; wgid = (xcd < r ? xcd * (q + 1) : r * (q + 1) + (xcd - r) * q) + off; }
        const int nig = WGM * nN, gid = wgid / nig, fm = gid * WGM, gsz = (nM - fm) < WGM ? (nM - fm) : WGM;
        u.pm = fm + ((wgid % nig) % gsz); u.pn = (wgid % nig) / gsz; u.e = texp ? __builtin_amdgcn_readfirstlane(texp[u.pm]) : 0; return true;
    }
};

struct TileOrderSkew : TileOrder {
    int nsk, kd, per;
    __device__ bool next(int i, Unit& u) const {
        int cc = c, ii = i;
        if (nsk > 0) {
            if (c < nsk) { if (i >= per - kd) return false; }
            else if (i == per) { const int S = (nsk + 7) & ~7, j = c / S - 1, c2 = c % S; if (c < S || j >= kd || c2 >= nsk) return false; cc = c2; ii = per - kd + j; }
            else if (i > per) return false;
        }
        const long L = (long)ii * G + cc; if (L >= nwg) return false;
        int wgid = (int)L; { const int q = nwg / NXCD, r = nwg % NXCD, xcd = wgid % NXCD, off = wgid / NXCD; wgid = (xcd < r ? xcd * (q + 1) : r * (q + 1) + (xcd - r) * q) + off; }
        const int nig = WGM * nN, gid = wgid / nig, fm = gid * WGM, gsz = (nM - fm) < WGM ? (nM - fm) : WGM;
        u.pm = fm + ((wgid % nig) % gsz); u.pn = (wgid % nig) / gsz; u.e = texp ? __builtin_amdgcn_readfirstlane(texp[u.pm]) : 0; return true;
    }
};

typedef int i32x8 __attribute__((ext_vector_type(8)));
typedef int i32x4 __attribute__((ext_vector_type(4)));
__device__ __forceinline__ i32x8 cat8(bf16x8 a, bf16x8 b) { const i32x4 x = __builtin_bit_cast(i32x4, a), y = __builtin_bit_cast(i32x4, b); return __builtin_shufflevector(x, y, 0, 1, 2, 3, 4, 5, 6, 7); }
__device__ __forceinline__ void mfma8(f32x4& acc, const i32x8 a, const i32x8 b) { int sc = 0x7f7f7f7f;
    asm volatile("v_mfma_scale_f32_16x16x128_f8f6f4 %0, %1, %2, %0, %3, %3 op_sel_hi:[0,0,0]" : "+v"(acc) : "v"(a), "v"(b), "v"(sc)); }
__device__ __forceinline__ unsigned cvt_pk_bf16(float lo, float hi) { unsigned r; asm volatile("v_cvt_pk_bf16_f32 %0, %1, %2" : "=v"(r) : "v"(lo), "v"(hi)); return r; }


struct EpiPlain {
    static constexpr bool PERM = true, FP8 = false; static constexpr int LDA = 0;
    bf16_t* O; int ldc;
    __device__ __forceinline__ void operator()(const f32x4 (&acc)[2][2][4][2], const Unit& u, int wr, int wc, int fr, int fq) const {
        const int row0 = u.pm * BM + wr * 64 + fr, col0 = u.pn * BM + wc * 32 + 8 * fq;
#pragma unroll
        for (int ai = 0; ai < 2; ++ai)
#pragma unroll
            for (int m = 0; m < 4; ++m) { bf16_t* rowp = O + (size_t)(row0 + ai * HALF + m * 16) * ldc + col0;
#pragma unroll
                for (int bj = 0; bj < 2; ++bj) { const f32x4 v0 = acc[ai][bj][m][0], v1 = acc[ai][bj][m][1];
                    u32x4 w; w.x = cvt_pk_bf16(v0[0], v0[1]); w.y = cvt_pk_bf16(v0[2], v0[3]); w.z = cvt_pk_bf16(v1[0], v1[1]); w.w = cvt_pk_bf16(v1[2], v1[3]);
                    *(u32x4*)(rowp + bj * HALF) = w; } }
    }
};
template <bool F8> struct EpiQKVT {
    static constexpr bool PERM = true, FP8 = F8; static constexpr int LDA = F8 ? 0 : XP;
    bf16_t* O; const float* cosT; const float* sinT; float insc;
    const float* ssq; int npart;
    __device__ __forceinline__ void operator()(const f32x4 (&acc)[2][2][4][2], const Unit& u, int wr, int wc, int fr, int fq) const {
        const int row0 = u.pm * BM + wr * 64 + fr, col0 = u.pn * BM + wc * 32 + 8 * fq;
        const bool lane_rot = ((wc & 1) == 0) && (fq < 2);
        float rsv[2][4];
        if (npart) {
            f32x4 pp[2][4];
#pragma unroll
            for (int ai = 0; ai < 2; ++ai)
#pragma unroll
                for (int m = 0; m < 4; ++m) pp[ai][m] = *(const f32x4*)(ssq + (size_t)(row0 + ai * HALF + m * 16) * 16 + 4 * fq);
#pragma unroll
            for (int ai = 0; ai < 2; ++ai)
#pragma unroll
                for (int m = 0; m < 4; ++m) { float sq = (pp[ai][m][0] + pp[ai][m][1]) + (pp[ai][m][2] + pp[ai][m][3]); sq += __shfl_xor(sq, 16); sq += __shfl_xor(sq, 32);
                    rsv[ai][m] = insc / sqrtf(sq * (1.0f / D) + RMS_EPS); }
        } else {
#pragma unroll
            for (int ai = 0; ai < 2; ++ai)
#pragma unroll
                for (int m = 0; m < 4; ++m) rsv[ai][m] = insc;
        }
        const bool anyrot = (u.pn >= 4) && (u.pn <= 7);
#pragma unroll
        for (int ai = 0; ai < 2; ++ai) {
            f32x4 rc[4], rn[4];
#pragma unroll
            for (int m = 0; m < 4; ++m) { rc[m] = (f32x4){0.f, 0.f, 0.f, 0.f}; rn[m] = rc[m]; }
            if (anyrot) {
#pragma unroll
                for (int m = 0; m < 4; ++m) { const int t = (row0 + ai * HALF + m * 16) & (T - 1); rc[m] = *(const f32x4*)(cosT + t * 8 + 4 * (fq & 1)); rn[m] = *(const f32x4*)(sinT + t * 8 + 4 * (fq & 1)); }
            }
#pragma unroll
            for (int m = 0; m < 4; ++m) {
                const int row = row0 + ai * HALF + m * 16;
                const float rs = rsv[ai][m];
#pragma unroll
                for (int bj = 0; bj < 2; ++bj) {
                    const int idx = 2 * u.pn + bj;
                    const float sc = ((idx < 3 || (idx >= 9 && idx < 12) || idx >= 18) ? QSCALE : 1.0f) * rs;
                    const bool rot = (idx >= 9 && idx < 15) && lane_rot;
                    f32x4 v0 = acc[ai][bj][m][0] * sc, v1 = acc[ai][bj][m][1] * sc;
                    if (rot) {
                        const f32x4 c = rc[m], s = rn[m];
                        f32x4 a, b;
                        a[0] = v0[0] * c[0] - v0[1] * s[0]; a[1] = v0[1] * c[0] + v0[0] * s[0];
                        a[2] = v0[2] * c[1] - v0[3] * s[1]; a[3] = v0[3] * c[1] + v0[2] * s[1];
                        b[0] = v1[0] * c[2] - v1[1] * s[2]; b[1] = v1[1] * c[2] + v1[0] * s[2];
                        b[2] = v1[2] * c[3] - v1[3] * s[3]; b[3] = v1[3] * c[3] + v1[2] * s[3];
                        v0 = a; v1 = b;
                    }
                    u32x4 w; w.x = cvt_pk_bf16(v0[0], v0[1]); w.y = cvt_pk_bf16(v0[2], v0[3]); w.z = cvt_pk_bf16(v1[0], v1[1]); w.w = cvt_pk_bf16(v1[2], v1[3]);
                    *(u32x4*)(O + (size_t)row * NQKV + col0 + bj * HALF) = w;
                }
            }
        }
    }
};
template <bool F8> struct EpiSwigluT {
    static constexpr bool PERM = true, FP8 = F8; static constexpr int LDA = 0;
    bf16_t* O; float insc; int out_bf16;
    __device__ __forceinline__ void operator()(const f32x4 (&acc)[2][2][4][2], const Unit& u, int wr, int wc, int fr, int fq) const {
        const int row0 = u.pm * BM + wr * 64 + fr, col0 = u.pn * HALF + wc * 32 + 8 * fq;
#pragma unroll
        for (int ai = 0; ai < 2; ++ai)
#pragma unroll
            for (int m = 0; m < 4; ++m) {
                float h[8];
#pragma unroll
                for (int n = 0; n < 2; ++n)
#pragma unroll
                    for (int j = 0; j < 4; ++j) { const float g = acc[ai][0][m][n][j] * insc, up = acc[ai][1][m][n][j] * insc;
                        const float sg = g * __builtin_amdgcn_rcpf(1.0f + __builtin_amdgcn_exp2f(-g * LOG2E)); h[4 * n + j] = sg * up; }
                if (F8 && !out_bf16) {
                    u32x2 w; w.x = cvt4_fp8(h[0] * H8_SCALE, h[1] * H8_SCALE, h[2] * H8_SCALE, h[3] * H8_SCALE); w.y = cvt4_fp8(h[4] * H8_SCALE, h[5] * H8_SCALE, h[6] * H8_SCALE, h[7] * H8_SCALE);
                    *(u32x2*)((unsigned char*)O + (size_t)(row0 + ai * HALF + m * 16) * FF + col0) = w;
                } else {
                    u32x4 w; w.x = cvt_pk_bf16(h[0], h[1]); w.y = cvt_pk_bf16(h[2], h[3]); w.z = cvt_pk_bf16(h[4], h[5]); w.w = cvt_pk_bf16(h[6], h[7]);
                    *(u32x4*)(O + (size_t)(row0 + ai * HALF + m * 16) * FF + col0) = w;
                }
            }
    }
};
template <bool F8> struct EpiResT {
    static constexpr bool PERM = false, FP8 = F8; static constexpr int LDA = 0;
    const float* src; bf16_t* xbf; bf16_t* ob; int ldc; int as_bf16; float insc;
    __device__ __forceinline__ void operator()(const f32x4 (&acc)[2][2][4][2], const Unit& u, int wr, int wc, int fr, int fq) const {
        const int row0 = u.pm * BM + wr * 64 + fr, col0 = u.pn * BM + wc * 32 + 4 * fq;
        float* ssqp = nullptr;
        if (as_bf16 == 2) {
            extern __shared__ __attribute__((aligned(16))) unsigned char lds_epi[];
            const unsigned long long v = ((const PG8_LAS unsigned long long*)((PG8_LAS unsigned char*)lds_epi + MISC_OFF + MISC_PTAB))[18];
            const unsigned lo = __builtin_amdgcn_readfirstlane((unsigned)v), hi = __builtin_amdgcn_readfirstlane((unsigned)(v >> 32));
            ssqp = (float*)((unsigned char*)(((unsigned long long)hi << 32) | lo) + WS_SSQ); }
        if (as_bf16 == 1) {
#pragma unroll
            for (int ai = 0; ai < 2; ++ai)
#pragma unroll
                for (int m = 0; m < 4; ++m) { bf16_t* rowp = ob + (size_t)(row0 + ai * HALF + m * 16) * ldc + col0;
#pragma unroll
                    for (int bj = 0; bj < 2; ++bj)
#pragma unroll
                        for (int n = 0; n < 2; ++n) { const f32x4 v = acc[ai][bj][m][n] * insc; u32x2 w; w.x = cvt_pk_bf16(v[0], v[1]); w.y = cvt_pk_bf16(v[2], v[3]); *(u32x2*)(rowp + bj * HALF + n * 16) = w; } }
        } else {
            auto fin = [&](int ai, int m, const f32x4 (&b)[2][2]) {
                const size_t xoff = (size_t)(row0 + ai * HALF + m * 16) * XP + col0; float ss = 0.f;
#pragma unroll
                for (int bj = 0; bj < 2; ++bj)
#pragma unroll
                    for (int n = 0; n < 2; ++n) { const f32x4 x = b[bj][n] + acc[ai][bj][m][n] * insc; u32x2 w; w.x = cvt_pk_bf16(x[0], x[1]); w.y = cvt_pk_bf16(x[2], x[3]);
                        ss += (x[0] * x[0] + x[1] * x[1]) + (x[2] * x[2] + x[3] * x[3]);
                        *(u32x2*)(xbf + xoff + bj * HALF + n * 16) = w; }
                if (ssqp) { ss += __shfl_xor(ss, 16); ss += __shfl_xor(ss, 32); if (fq == 0) ssqp[(size_t)(row0 + ai * HALF + m * 16) * 16 + 4 * u.pn + wc] = ss; }
            };
            if (src) {
#pragma unroll
                for (int ai = 0; ai < 2; ++ai) {
                    f32x4 rb[4][2][2];
#pragma unroll
                    for (int m = 0; m < 4; ++m)
#pragma unroll
                        for (int bj = 0; bj < 2; ++bj)
#pragma unroll
                            for (int n = 0; n < 2; ++n) rb[m][bj][n] = *(const f32x4*)(src + (size_t)(row0 + ai * HALF + m * 16) * ldc + col0 + bj * HALF + n * 16);
#pragma unroll
                    for (int m = 0; m < 4; ++m) fin(ai, m, rb[m]);
                    asm volatile("" ::: "memory");
                }
            } else {
#pragma unroll
                for (int ai = 0; ai < 2; ++ai) {
                    u32x2 rw[4][2][2];
#pragma unroll
                    for (int m = 0; m < 4; ++m)
#pragma unroll
                        for (int bj = 0; bj < 2; ++bj)
#pragma unroll
                            for (int n = 0; n < 2; ++n) rw[m][bj][n] = *(const u32x2*)(xbf + (size_t)(row0 + ai * HALF + m * 16) * XP + col0 + bj * HALF + n * 16);
#pragma unroll
                    for (int m = 0; m < 4; ++m) { f32x4 bb[2][2];
#pragma unroll
                        for (int bj = 0; bj < 2; ++bj)
#pragma unroll
                            for (int n = 0; n < 2; ++n) { const u32x2 w = rw[m][bj][n];
                                bb[bj][n] = (f32x4){__builtin_bit_cast(float, w.x << 16), __builtin_bit_cast(float, w.x & 0xffff0000u), __builtin_bit_cast(float, w.y << 16), __builtin_bit_cast(float, w.y & 0xffff0000u)}; }
                        fin(ai, m, bb); }
                    asm volatile("" ::: "memory");
                }
            }
        }
    }
};

template <class Epi, class Sched>
__device__ __forceinline__ void gemm_phase(PG8_LAS unsigned char* lds, const Gemm g, const Sched& S, const Epi& E, const int tid) {
    const int wid = __builtin_amdgcn_readfirstlane(tid >> 6), lane = tid & 63, wr = wid >> 2, wc = wid & 3, fr = lane & 15, fq = lane >> 4;
    const int K = g.K, nt = K / BK;
    const int LDA_ = Epi::LDA ? Epi::LDA : K;
    unsigned voffA[2], voffB[2];
#pragma unroll
    for (int i = 0; i < 2; ++i) { int R, C; stage_rc(tid * 16 + i * 8192, R, C); const int Rb = Epi::PERM ? ((R & ~31) + perm32(R & 31)) : R;
        voffA[i] = (unsigned)(R * LDA_ + C) * 2u; voffB[i] = (unsigned)(Rb * K + C) * 2u; }
    const size_t kstep = (size_t)(BK * 2);
    const size_t hstep = (size_t)HALF * K * 2;
    const size_t tstep = 2 * hstep;
    const size_t hstepA = (size_t)HALF * LDA_ * 2, tstepA = 2 * hstepA;
    const unsigned ldsw = (unsigned)wid * 1024u;
    const int aoff = lds_byte(wr * 64 + fr, fq * 8), boff = lds_byte(wc * 32 + fr, fq * 8);
#define PG8_SA(b, h) (((b) * 2 + (h)) * HTB)
#define PG8_SB(b, h) ((4 + (b) * 2 + (h)) * HTB)
#define PG8_STAGE(bufoff, gbase, voff) do { _Pragma("unroll") for (int _i = 0; _i < 2; ++_i) \
        __builtin_amdgcn_global_load_lds((const unsigned*)((const char*)(gbase) + (voff)[_i]), (PG8_LAS unsigned*)(lds + (bufoff) + ldsw + _i * 8192), 16, 0, 0); } while (0)
#define PG8_LDA(dst, b, h) do { _Pragma("unroll") for (int m = 0; m < 4; ++m) _Pragma("unroll") for (int k = 0; k < 2; ++k) dst[m][k] = *(const PG8_LAS bf16x8*)(lds + PG8_SA(b, h) + aoff + m * 2048 + k * 1024); } while (0)
#define PG8_LDB(dst, b, h) do { _Pragma("unroll") for (int n = 0; n < 2; ++n) _Pragma("unroll") for (int k = 0; k < 2; ++k) dst[n][k] = *(const PG8_LAS bf16x8*)(lds + PG8_SB(b, h) + boff + n * 2048 + k * 1024); } while (0)
#define PG8_MMA(ai, bj, At, Bt) do { __builtin_amdgcn_s_setprio(1); \
        if constexpr (Epi::FP8) { _Pragma("unroll") for (int m = 0; m < 4; ++m) _Pragma("unroll") for (int n = 0; n < 2; ++n) \
            mfma8(acc[ai][bj][m][n], cat8(Bt[n][0], Bt[n][1]), cat8(At[m][0], At[m][1])); } \
        else { _Pragma("unroll") for (int m = 0; m < 4; ++m) _Pragma("unroll") for (int n = 0; n < 2; ++n) _Pragma("unroll") for (int k = 0; k < 2; ++k) \
            acc[ai][bj][m][n] = __builtin_amdgcn_mfma_f32_16x16x32_bf16(Bt[n][k], At[m][k], acc[ai][bj][m][n], 0, 0, 0); } \
        __builtin_amdgcn_s_setprio(0); } while (0)
#define PG8_WAIT_V(n) asm volatile("s_waitcnt vmcnt(" #n ")" ::: "memory")
#define PG8_WAIT_L(n) asm volatile("s_waitcnt lgkmcnt(" #n ")" ::: "memory")
#define PG8_BAR __builtin_amdgcn_s_barrier()
#define PG8_SCHED __builtin_amdgcn_sched_barrier(0)
    Unit cur, nxt; int ui = 0;
    if (!S.next(0, cur)) return;
    f32x4 acc[2][2][4][2];
#pragma unroll
    for (int a = 0; a < 2; ++a)
#pragma unroll
        for (int b = 0; b < 2; ++b)
#pragma unroll
            for (int m = 0; m < 4; ++m)
#pragma unroll
                for (int n = 0; n < 2; ++n) acc[a][b][m][n] = (f32x4){0.f, 0.f, 0.f, 0.f};
    bf16x8 At[4][2], B0[2][2], B1[2][2];
    const char* cA = (const char*)g.A + (size_t)cur.pm * tstepA; const char* cB = (const char*)g.Bt + (size_t)cur.e * g.estride + (size_t)cur.pn * tstep;
    PG8_STAGE(PG8_SB(0, 0), cB, voffB); PG8_STAGE(PG8_SB(0, 1), cB + hstep, voffB); PG8_STAGE(PG8_SA(0, 0), cA, voffA); PG8_STAGE(PG8_SA(0, 1), cA + hstepA, voffA);
    if (wr == 1) PG8_BAR;
    PG8_WAIT_V(2); PG8_BAR;
    PG8_STAGE(PG8_SB(1, 0), cB + kstep, voffB); PG8_STAGE(PG8_SA(1, 0), cA + kstep, voffA); PG8_STAGE(PG8_SB(1, 1), cB + hstep + kstep, voffB);
    PG8_WAIT_V(6); PG8_BAR;
    for (;;) {
        const bool has_next = S.next(ui + 1, nxt);
        const char* nA = has_next ? (const char*)g.A + (size_t)nxt.pm * tstepA : cA; const char* nB = has_next ? (const char*)g.Bt + (size_t)nxt.e * g.estride + (size_t)nxt.pn * tstep : cB;
        for (int t = 0; t < nt; t += 2) {
            const bool last = (t == nt - 2);
            const char* a1 = cA + (size_t)(t + 1) * kstep;
            const char* a2 = last ? nA : cA + (size_t)(t + 2) * kstep; const char* b2 = last ? nB : cB + (size_t)(t + 2) * kstep;
            const char* a3 = a2 + kstep; const char* b3 = b2 + kstep;
            PG8_LDB(B0, 0, 0); PG8_LDB(B1, 0, 1); PG8_SCHED; PG8_LDA(At, 0, 0); PG8_STAGE(PG8_SA(1, 1), a1 + hstepA, voffA);
            PG8_WAIT_V(8); PG8_WAIT_L(0); PG8_BAR; PG8_MMA(0, 0, At, B0); PG8_MMA(0, 1, At, B1); PG8_BAR; PG8_SCHED;
            PG8_LDA(At, 0, 1); PG8_STAGE(PG8_SB(0, 0), b2, voffB); PG8_STAGE(PG8_SB(0, 1), b2 + hstep, voffB); PG8_STAGE(PG8_SA(0, 0), a2, voffA);
            PG8_WAIT_V(8); PG8_WAIT_L(0); PG8_BAR; PG8_MMA(1, 0, At, B0); PG8_MMA(1, 1, At, B1); PG8_BAR; PG8_SCHED;
            PG8_LDB(B0, 1, 0); PG8_LDB(B1, 1, 1); PG8_SCHED; PG8_LDA(At, 1, 0); PG8_STAGE(PG8_SA(0, 1), a2 + hstepA, voffA);
            PG8_WAIT_V(8); PG8_WAIT_L(0); PG8_BAR; PG8_MMA(0, 0, At, B0); PG8_MMA(0, 1, At, B1); PG8_BAR; PG8_SCHED;
            PG8_LDA(At, 1, 1); PG8_STAGE(PG8_SB(1, 0), b3, voffB); PG8_STAGE(PG8_SB(1, 1), b3 + hstep, voffB); PG8_STAGE(PG8_SA(1, 0), a3, voffA);
            PG8_WAIT_V(8); PG8_WAIT_L(0); PG8_BAR; PG8_MMA(1, 0, At, B0); PG8_MMA(1, 1, At, B1); PG8_BAR; PG8_SCHED;
        }
        if (wr == 0) PG8_BAR;
        if constexpr (Epi::FP8) {
#pragma unroll
            for (int a = 0; a < 2; ++a)
#pragma unroll
                for (int b = 0; b < 2; ++b)
                    asm volatile("s_nop 15\n\ts_nop 15" : "+v"(acc[a][b][0][0]), "+v"(acc[a][b][0][1]), "+v"(acc[a][b][1][0]), "+v"(acc[a][b][1][1]), "+v"(acc[a][b][2][0]), "+v"(acc[a][b][2][1]), "+v"(acc[a][b][3][0]), "+v"(acc[a][b][3][1]));
        }
        E(acc, cur, wr, wc, fr, fq);
        if (!has_next) break;
#pragma unroll
        for (int a = 0; a < 2; ++a)
#pragma unroll
            for (int b = 0; b < 2; ++b)
#pragma unroll
                for (int m = 0; m < 4; ++m)
#pragma unroll
                    for (int n = 0; n < 2; ++n) acc[a][b][m][n] = (f32x4){0.f, 0.f, 0.f, 0.f};
        cur = nxt; cA = nA; cB = nB; ++ui;
        if (wr == 1) PG8_BAR;
    }
    PG8_WAIT_V(0);
    PG8_BAR;
#undef PG8_SA
#undef PG8_SB
#undef PG8_STAGE
#undef PG8_LDA
#undef PG8_LDB
#undef PG8_MMA
#undef PG8_WAIT_V
#undef PG8_WAIT_L
#undef PG8_BAR
#undef PG8_SCHED
}
}

typedef GAS unsigned gu32;
#define RLX_AGENT __ATOMIC_RELAXED, __HIP_MEMORY_SCOPE_AGENT
#define LDS_WAIT() asm volatile("s_waitcnt lgkmcnt(0)" ::: "memory")
#define VM_WAIT() asm volatile("s_waitcnt vmcnt(0)" ::: "memory")
__device__ __forceinline__ unsigned f2bf(float f) { unsigned u = __builtin_bit_cast(unsigned, f); return (u + 0x7fffu + ((u >> 16) & 1u)) >> 16; }
__device__ __forceinline__ unsigned pk2(float lo, float hi) { return f2bf(lo) | (f2bf(hi) << 16); }
__device__ __forceinline__ float bf_lo(unsigned w) { return __builtin_bit_cast(float, w << 16); }
__device__ __forceinline__ float bf_hi(unsigned w) { return __builtin_bit_cast(float, w & 0xffff0000u); }

#define XB_TMO      128
#define XB_XCNT(j)  (256  + 64 * (j))
#define XB_XSUB(j)  (1280 + 64 * (j))
#define XB_XGEN(j)  (2304 + 64 * (j))
#define XB_TOP      3328
#define XB_TOPGEN   3392
#define XCD_BAR_WORDS 3456
#define XB_SPIN_CAP (1u << 18)

__device__ __forceinline__ unsigned xb_ld(unsigned* p)              { return __hip_atomic_load(p, __ATOMIC_RELAXED, __HIP_MEMORY_SCOPE_AGENT); }
__device__ __forceinline__ unsigned xb_add(unsigned* p, unsigned v) { return __hip_atomic_fetch_add(p, v, __ATOMIC_RELAXED, __HIP_MEMORY_SCOPE_AGENT); }
__device__ __forceinline__ unsigned xb_xcc_id() { return (unsigned)__builtin_amdgcn_s_getreg((3 << 11) | 20) & 0xFu; }
#define XB_SPIN(cond, bar) do { unsigned _sp = 0; while (cond) { __builtin_amdgcn_s_sleep(1); \
    if ((++_sp & 255u) == 0u) { if (xb_ld(&(bar)[XB_TMO])) break; if (_sp > XB_SPIN_CAP) { atomicAdd(&(bar)[XB_TMO], 1u); break; } } } } while (0)

struct XcdBarrier { unsigned* bar; unsigned x; volatile LAS unsigned* st; };

__device__ __forceinline__ XcdBarrier xcd_barrier_post(unsigned* bar, volatile LAS unsigned* st) {
    XcdBarrier b; b.bar = bar; b.x = xb_xcc_id(); b.st = st;
    if (threadIdx.x == 0) (void)xb_add(&bar[XB_XCNT(b.x)], 1u);
    return b;
}
__device__ __forceinline__ void xcd_barrier_complete(unsigned* bar, unsigned x, unsigned& nloc, unsigned& nx) {
    const unsigned G = gridDim.x * gridDim.y * gridDim.z;
    unsigned sum, cnt, mine, sp = 0u;
    for (;;) {
        sum = 0u; cnt = 0u; mine = 0u;
#pragma unroll
        for (unsigned j = 0; j < 16; ++j) { const unsigned c = xb_ld(&bar[XB_XCNT(j)]); sum += c; cnt += (c > 0u) ? 1u : 0u; mine = (j == x) ? c : mine; }
        if (sum == G) break;
        __builtin_amdgcn_s_sleep(1);
        if ((++sp & 255u) == 0u) { if (xb_ld(&bar[XB_TMO])) break; if (sp > XB_SPIN_CAP) { atomicAdd(&bar[XB_TMO], 1u); break; } }
    }
    nloc = mine > 0u ? mine : 1u; nx = cnt > 0u ? cnt : 1u;
}
__device__ __forceinline__ void xcd_barrier(const XcdBarrier& b) {
    asm volatile("s_waitcnt vmcnt(0)" ::: "memory");
    __syncthreads();
    if (threadIdx.x == 0) {
        unsigned* bar = b.bar;
        __builtin_amdgcn_s_waitcnt(0);
        unsigned nloc = b.st[0], nx = b.st[1];
        if (nloc == 0u) { xcd_barrier_complete(bar, b.x, nloc, nx); b.st[0] = nloc; b.st[1] = nx; }
        const unsigned old = xb_add(&bar[XB_XSUB(b.x)], 1u);
        const unsigned gen = old / nloc;
        if (old + 1u == (gen + 1u) * nloc) {
            __builtin_amdgcn_fence(__ATOMIC_RELEASE, "agent");
            asm volatile("s_waitcnt vmcnt(0)" ::: "memory");
            const unsigned og = xb_add(&bar[XB_TOP], 1u);
            const unsigned tg = og / nx;
            if (og + 1u == (tg + 1u) * nx) xb_add(&bar[XB_TOPGEN], 1u);
            else XB_SPIN(xb_ld(&bar[XB_TOPGEN]) == tg, bar);
            __builtin_amdgcn_fence(__ATOMIC_ACQUIRE, "agent");
            xb_add(&bar[XB_XGEN(b.x)], 1u);
            asm volatile("s_waitcnt vmcnt(0)" ::: "memory");
        } else {
            XB_SPIN(xb_ld(&bar[XB_XGEN(b.x)]) == gen, bar);
            __builtin_amdgcn_fence(__ATOMIC_ACQUIRE, "agent");
            asm volatile("s_waitcnt vmcnt(0)" ::: "memory");
        }
    }
    __syncthreads();
}

struct Frame {
    LAS unsigned char* lds;
    LAS unsigned char* misc;
    unsigned char* ws;
    int tid, lane, wave, G, bx;
    float* out;
};
__device__ __forceinline__ const float* inp_ptr(LAS unsigned char* misc, int i) {
    const unsigned long long v = ((const LAS unsigned long long*)(misc + MISC_PTAB))[i];
    const unsigned lo = __builtin_amdgcn_readfirstlane((unsigned)v), hi = __builtin_amdgcn_readfirstlane((unsigned)(v >> 32));
    return (const float*)(GAS const float*)(((unsigned long long)hi << 32) | lo);
}
#define INP(i) inp_ptr(F.misc, (i))

__device__ __forceinline__ void lds_add(LAS int* p, int v) { (void)__hip_atomic_fetch_add(p, v, __ATOMIC_RELAXED, __HIP_MEMORY_SCOPE_WORKGROUP); }
__device__ __forceinline__ float wave_sum(float v) {
#pragma unroll
    for (int o = 1; o < 64; o <<= 1) v += __shfl_xor(v, o);
    return v;
}

__device__ __forceinline__ int map_row(int n, int mode) {
    if (mode == 1) { if (n >= OFF_QB && n < OFF_VB) { const int d = (n - OFF_QB) & 63; if (d < 16) { const int dn = d < 8 ? 2 * d : 2 * (d - 8) + 1; return n - d + dn; } } return n; }
    if (mode == 2) return ((n >> 7) << 8) + (n & 127);
    if (mode == 3) return ((n >> 7) << 8) + 128 + (n & 127);
    return n;
}
template <bool F8>
__device__ __forceinline__ void convert_mat(const float* W, int K, int N, unsigned char* WT, int mode, float wscale, int& base, int gw, int NGW, int lane, const float* kgain = nullptr) {
    constexpr int KI = F8 ? 128 : 64;
    const int nblk = N >> 6, nitems = (K / KI) * nblk;
    int r = gw - (base % NGW); if (r < 0) r += NGW;
    base += nitems;
    const int q = lane >> 4, c4 = lane & 15;
#pragma nounroll
    for (; r < nitems; r += NGW) {
        const int kb = r / nblk, nb = r - kb * nblk, k0 = kb * KI, n = nb * 64 + 4 * c4;
        const GAS float* src = (const GAS float*)W + (size_t)k0 * N + n;
        size_t drow[4];
#pragma unroll
        for (int c = 0; c < 4; ++c) drow[c] = (size_t)map_row(n + c, mode) * K + k0;
#pragma nounroll
        for (int sgm = 0; sgm < 2; ++sgm) {
            f32x4 v[16];
            if (F8) {
                const int kq = 64 * sgm + 16 * q;
#pragma unroll
                for (int j = 0; j < 16; ++j) v[j] = *(const GAS f32x4*)(src + (size_t)(kq + j) * N) * wscale;
#pragma unroll
                for (int c = 0; c < 4; ++c) { u32x4 o; o.x = cvt4_fp8(v[0][c], v[1][c], v[2][c], v[3][c]); o.y = cvt4_fp8(v[4][c], v[5][c], v[6][c], v[7][c]);
                    o.z = cvt4_fp8(v[8][c], v[9][c], v[10][c], v[11][c]); o.w = cvt4_fp8(v[12][c], v[13][c], v[14][c], v[15][c]);
                    *(GAS u32x4*)(WT + drow[c] + kq) = o; }
            } else {
                const int kq = 32 * sgm + 8 * q;
#pragma unroll
                for (int j = 0; j < 8; ++j) v[j] = *(const GAS f32x4*)(src + (size_t)(kq + j) * N);
                if (kgain) {
#pragma unroll
                    for (int j = 0; j < 8; ++j) v[j] = v[j] * kgain[k0 + kq + j]; }
#pragma unroll
                for (int c = 0; c < 4; ++c) { u32x4 o; o.x = pk2(v[0][c], v[1][c]); o.y = pk2(v[2][c], v[3][c]); o.z = pk2(v[4][c], v[5][c]); o.w = pk2(v[6][c], v[7][c]);
                    *(GAS u32x4*)((bf16*)WT + drow[c] + kq) = o; }
            }
        }
    }
}
__device__ __forceinline__ void phase_convert(Frame& F) {
    const int gw = F.bx * NWAVES + F.wave, NGW = F.G * NWAVES;
    int base = 0;
#pragma nounroll
    for (int L = 0; L < DEPTH; ++L) { unsigned char* wc = F.ws + WS_WC + (size_t)L * WC_STRIDE;
#if QKV_FP8
        convert_mat<true>(INP(3) + (size_t)L * D * NQKV, D, NQKV, wc + WC_IN, 1, W8_SCALE, base, gw, NGW, F.lane);
#else
        convert_mat<false>(INP(3) + (size_t)L * D * NQKV, D, NQKV, wc + WC_IN, 1, 1.0f, base, gw, NGW, F.lane, L > 0 ? INP(2) + (size_t)L * D : (const float*)nullptr);
#endif
        convert_mat<false>(INP(6) + (size_t)L * D * 512, D, 512, wc + WC_MKV, 0, 1.0f, base, gw, NGW, F.lane);
        convert_mat<false>(INP(8) + (size_t)L * D * D, D, D, wc + WC_OUT, 0, 1.0f, base, gw, NGW, F.lane); }
#pragma nounroll
    for (int i = 0; i < 2; ++i) { unsigned char* wd = F.ws + WS_WD + (size_t)i * WD_STRIDE;
        if (DENSE_UP8(2 * i)) { convert_mat<true>(INP(10) + (size_t)i * D * FF, D, FF, wd, 2, W8_SCALE, base, gw, NGW, F.lane); convert_mat<true>(INP(11) + (size_t)i * D * FF, D, FF, wd, 3, W8_SCALE, base, gw, NGW, F.lane); }
        else { convert_mat<false>(INP(10) + (size_t)i * D * FF, D, FF, wd, 2, 1.0f, base, gw, NGW, F.lane); convert_mat<false>(INP(11) + (size_t)i * D * FF, D, FF, wd, 3, 1.0f, base, gw, NGW, F.lane); }
        if (DENSE_DN8(2 * i)) convert_mat<true>(INP(12) + (size_t)i * FF * D, FF, D, wd + 14 * MiB, 0, WD8_SCALE, base, gw, NGW, F.lane);
        else convert_mat<false>(INP(12) + (size_t)i * FF * D, FF, D, wd + 14 * MiB, 0, 1.0f, base, gw, NGW, F.lane); }
#pragma nounroll
    for (int ie = 0; ie < 2 * NE; ++ie) { const int i = ie >> 3, e = ie & 7; unsigned char* wm = F.ws + WS_WM + (size_t)i * WM_STRIDE; const size_t eo = (size_t)ie * D * FF;
        convert_mat<true>(INP(14) + eo, D, FF, wm + (size_t)e * 7 * MiB, 2, W8_SCALE, base, gw, NGW, F.lane);
        convert_mat<true>(INP(15) + eo, D, FF, wm + (size_t)e * 7 * MiB, 3, W8_SCALE, base, gw, NGW, F.lane);
        convert_mat<true>(INP(16) + eo, FF, D, wm + WM_DOWN + (size_t)e * WD8_ESTRIDE, 0, WD8_SCALE, base, gw, NGW, F.lane); }
    float* cosT = (float*)(F.ws + WS_COS); float* sinT = (float*)(F.ws + WS_SIN);
    for (int idx = F.bx * 512 + F.tid; idx < T * 8; idx += F.G * 512) {
        const int t = idx >> 3, i = idx & 7;
        const double f = (i == 0) ? 0.15915494309189535 : (i == 1) ? 0.03086376340470123 : (i == 2) ? 0.005985185712713705 : (i == 3) ? 0.001160663641240061
                       : (i == 4) ? 0.00022507907903927653 : (i == 5) ? 4.364795279280289e-05 : (i == 6) ? 8.464330808241401e-06 : 1.6414262627950345e-06;
        double rev = (double)t * f; rev -= (double)(long long)rev;
        const float rf = (float)rev;
        cosT[idx] = __builtin_amdgcn_cosf(rf); sinT[idx] = __builtin_amdgcn_sinf(rf);
    }
}

struct RowPass {
    const float* xsrc; const bf16* xbf; bf16* xdst;
    const float* gain;
    bf16* ob; float* of;
    int obp; float* ssq;
    unsigned char* ob8;
    int combine;
    int router; const float* wr;
};
constexpr int RG = 2;
__device__ __forceinline__ void phase_rows(Frame& F, const RowPass P) {
    LAS float* wrl = (LAS float*)F.lds;
    LAS int* hist = (LAS int*)(F.misc + MISC_SCR);
    const bf16* YS = (const bf16*)(F.ws + WS_GA);
    const int* posg = (const int*)(F.ws + WS_POS); const float* gateg = (const float*)(F.ws + WS_GATE);
    int* e01g = (int*)(F.ws + WS_E01); float* gatew = (float*)(F.ws + WS_GATE); int* tcnt = (int*)(F.ws + WS_TCNT);
    if (P.router) { for (int i = F.tid; i < D * 8; i += 512) wrl[i] = P.wr[i]; }
    f32x4 gv[4];
#pragma unroll
    for (int j = 0; j < 4; ++j) gv[j] = *(const f32x4*)(P.gain + 4 * F.lane + 256 * j);
    const int tstart = (F.G == 256) ? ((F.bx & 7) * 32 + (F.bx >> 3)) : F.bx, tstride = (F.G == 256) ? M / 256 : F.G;
    for (int tile = tstart; tile < M / 256; tile += tstride) {
        if (P.router) { if (F.tid < 8) hist[F.tid] = 0; }
        __syncthreads();
        f32x4 buf[RG][4]; u32x2 bub[RG][4];
#pragma unroll
        for (int q = 0; q < RG; ++q) {
            if (P.xsrc) { const float* xr = P.xsrc + (size_t)(tile * 256 + F.wave * 32 + q) * D + 4 * F.lane;
#pragma unroll
                for (int j = 0; j < 4; ++j) buf[q][j] = *(const f32x4*)(xr + 256 * j); }
            else { const bf16* xr = P.xbf + (size_t)(tile * 256 + F.wave * 32 + q) * XP + 4 * F.lane;
#pragma unroll
                for (int j = 0; j < 4; ++j) bub[q][j] = *(const u32x2*)(xr + 256 * j); } }
#pragma nounroll
        for (int i0 = 0; i0 < 32; i0 += RG) {
            const int rowb = tile * 256 + F.wave * 32 + i0;
            f32x4 v[RG][4];
#pragma unroll
            for (int q = 0; q < RG; ++q)
#pragma unroll
                for (int j = 0; j < 4; ++j) v[q][j] = P.xsrc ? buf[q][j] : (f32x4){bf_lo(bub[q][j].x), bf_hi(bub[q][j].x), bf_lo(bub[q][j].y), bf_hi(bub[q][j].y)};
            if (i0 + RG < 32) {
#pragma unroll
                for (int q = 0; q < RG; ++q) {
                    if (P.xsrc) { const float* xr = P.xsrc + (size_t)(rowb + RG + q) * D + 4 * F.lane;
#pragma unroll
                        for (int j = 0; j < 4; ++j) buf[q][j] = *(const f32x4*)(xr + 256 * j); }
                    else { const bf16* xr = P.xbf + (size_t)(rowb + RG + q) * XP + 4 * F.lane;
#pragma unroll
                        for (int j = 0; j < 4; ++j) bub[q][j] = *(const u32x2*)(xr + 256 * j); } }
            }
#pragma unroll
            for (int q = 0; q < RG; ++q) {
                const int row = rowb + q;
                if (P.combine) {
                    const int p0 = posg[2 * row], p1 = posg[2 * row + 1]; const float g0 = gateg[2 * row], g1 = gateg[2 * row + 1];
                    const bf16* y0 = YS + (size_t)p0 * D + 4 * F.lane; const bf16* y1 = YS + (size_t)p1 * D + 4 * F.lane;
#pragma unroll
                    for (int j = 0; j < 4; ++j) { const u32x2 a = *(const u32x2*)(y0 + 256 * j), b = *(const u32x2*)(y1 + 256 * j);
                        v[q][j][0] += g0 * bf_lo(a.x) + g1 * bf_lo(b.x); v[q][j][1] += g0 * bf_hi(a.x) + g1 * bf_hi(b.x);
                        v[q][j][2] += g0 * bf_lo(a.y) + g1 * bf_lo(b.y); v[q][j][3] += g0 * bf_hi(a.y) + g1 * bf_hi(b.y); }
                }
                if (P.xdst) {
                    bf16* xw = P.xdst + (size_t)row * XP + 4 * F.lane;
#pragma unroll
                    for (int j = 0; j < 4; ++j) { u32x2 w; w.x = pk2(v[q][j][0], v[q][j][1]); w.y = pk2(v[q][j][2], v[q][j][3]); *(u32x2*)(xw + 256 * j) = w; }
                }
                float s = 0.f;
#pragma unroll
                for (int j = 0; j < 4; ++j) s += (v[q][j][0] * v[q][j][0] + v[q][j][1] * v[q][j][1]) + (v[q][j][2] * v[q][j][2] + v[q][j][3] * v[q][j][3]);
                const float wsum = wave_sum(s);
                if (P.ssq) { if (F.lane < 4) *(f32x4*)(P.ssq + (size_t)row * 16 + 4 * F.lane) = (f32x4){F.lane == 0 ? wsum : 0.f, 0.f, 0.f, 0.f}; }
                const float rstd = 1.0f / sqrtf(wsum * (1.0f / D) + RMS_EPS);
#pragma unroll
                for (int j = 0; j < 4; ++j) v[q][j] = v[q][j] * rstd * gv[j];
                if (P.ob) {
                    bf16* o = P.ob + (size_t)row * P.obp + 4 * F.lane;
#pragma unroll
                    for (int j = 0; j < 4; ++j) { u32x2 w; w.x = pk2(v[q][j][0], v[q][j][1]); w.y = pk2(v[q][j][2], v[q][j][3]); *(u32x2*)(o + 256 * j) = w; }
                }
                if (P.ob8) {
                    unsigned char* o = P.ob8 + (size_t)row * D + 4 * F.lane;
#pragma unroll
                    for (int j = 0; j < 4; ++j) *(unsigned*)(o + 256 * j) = cvt4_fp8(v[q][j][0] * A8_SCALE, v[q][j][1] * A8_SCALE, v[q][j][2] * A8_SCALE, v[q][j][3] * A8_SCALE);
                }
                if (P.of) {
                    float* o = P.of + (size_t)row * D + 4 * F.lane;
#pragma unroll
                    for (int j = 0; j < 4; ++j) *(f32x4*)(o + 256 * j) = v[q][j];
                }
            }
            if (P.router) {
                float lg[RG][8];
#pragma unroll
                for (int q = 0; q < RG; ++q)
#pragma unroll
                    for (int e = 0; e < 8; ++e) lg[q][e] = 0.f;
#pragma unroll
                for (int j = 0; j < 4; ++j)
#pragma unroll
                    for (int c = 0; c < 4; ++c) { const LAS f32x4* w = (const LAS f32x4*)(wrl + (4 * F.lane + 256 * j + c) * 8); const f32x4 w0 = w[0], w1 = w[1];
#pragma unroll
                        for (int q = 0; q < RG; ++q) { const float h = v[q][j][c];
                            lg[q][0] += h * w0[0]; lg[q][1] += h * w0[1]; lg[q][2] += h * w0[2]; lg[q][3] += h * w0[3]; lg[q][4] += h * w1[0]; lg[q][5] += h * w1[1]; lg[q][6] += h * w1[2]; lg[q][7] += h * w1[3]; } }
#pragma unroll
                for (int q = 0; q < RG; ++q) {
                    const int row = rowb + q;
#pragma unroll
                    for (int e = 0; e < 8; ++e) lg[q][e] = wave_sum(lg[q][e]);
                    int e0 = 0; float b0 = lg[q][0];
#pragma unroll
                    for (int e = 1; e < 8; ++e) if (lg[q][e] > b0) { b0 = lg[q][e]; e0 = e; }
                    int e1 = -1; float b1 = -INFINITY;
#pragma unroll
                    for (int e = 0; e < 8; ++e) if (e != e0 && lg[q][e] > b1) { b1 = lg[q][e]; e1 = e; }
                    if (e1 < 0) { e1 = (e0 + 1) & 7; b1 = b0; }
                    const float g0 = 1.0f / (1.0f + expf(b1 - b0));
                    if (F.lane == 0) { e01g[row] = e0 | (e1 << 8); gatew[2 * row] = g0; gatew[2 * row + 1] = 1.0f - g0; lds_add(&hist[e0], 1); lds_add(&hist[e1], 1); }
                }
            }
        }
        __syncthreads();
        if (P.router) { if (F.tid < 8) tcnt[tile * 8 + F.tid] = hist[F.tid]; }
    }
}
__device__ __forceinline__ void phase_memnorm(Frame& F) {
    const int gw = F.bx * NWAVES + F.wave, NGW = F.G * NWAVES;
    bf16* MN = (bf16*)(F.ws + WS_MEMN4);
    const float* memp = INP(1); const float* gbase = INP(5);
    for (int r = gw; r < DEPTH * MROWS; r += NGW) {
        const int L = r / MROWS, row = r - L * MROWS;
        const float* xr = memp + (size_t)row * D + 4 * F.lane; const float* gain = gbase + (size_t)L * D + 4 * F.lane;
        f32x4 v[4]; float s = 0.f;
#pragma unroll
        for (int j = 0; j < 4; ++j) { v[j] = *(const f32x4*)(xr + 256 * j); s += (v[j][0] * v[j][0] + v[j][1] * v[j][1]) + (v[j][2] * v[j][2] + v[j][3] * v[j][3]); }
        const float rstd = 1.0f / sqrtf(wave_sum(s) * (1.0f / D) + RMS_EPS);
        bf16* o = MN + (size_t)r * D + 4 * F.lane;
#pragma unroll
        for (int j = 0; j < 4; ++j) { const f32x4 y = v[j] * rstd * *(const f32x4*)(gain + 256 * j); u32x2 w; w.x = pk2(y[0], y[1]); w.y = pk2(y[2], y[3]); *(u32x2*)(o + 256 * j) = w; }
    }
}

__device__ __forceinline__ void phase_moe_assign(Frame& F) {
    LAS int* sc = (LAS int*)(F.misc + MISC_SCR);
    LAS int* dst = (LAS int*)(F.lds);
    const int* tcnt = (const int*)(F.ws + WS_TCNT); const int* e01g = (const int*)(F.ws + WS_E01);
    int* posg = (int*)(F.ws + WS_POS); int* texp = (int*)(F.ws + WS_TEXP);
    const unsigned char* HB8 = F.ws + WS_HB; unsigned char* GA8 = F.ws + WS_GA8;
    const int tstart = (F.G == 256) ? ((F.bx & 7) * 32 + (F.bx >> 3)) : F.bx, tstride = (F.G == 256) ? M / 256 : F.G;
    for (int tile = tstart; tile < M / 256; tile += tstride) {
        __syncthreads();
        if (F.tid < 80) sc[F.tid] = 0;
        __syncthreads();
        if (F.tid < 256) {
            const int j = F.tid;
#pragma unroll
            for (int e = 0; e < 8; ++e) { const int c = tcnt[j * 8 + e]; lds_add(&sc[e], c); if (j < tile) lds_add(&sc[8 + e], c); }
        }
        __syncthreads();
        if (F.tid == 0) { int ps = 0; for (int e = 0; e < 8; ++e) { sc[64 + e] = ps; sc[16 + e] = ps + sc[8 + e]; ps += (sc[e] + 255) & ~255; } sc[72] = ps; }
        __syncthreads();
        if (tile == 0 && F.tid < 8) {
            const int e = F.tid; const int t0 = sc[64 + e] >> 8, t1 = (e == 7 ? sc[72] : sc[64 + e + 1]) >> 8;
            for (int t = t0; t < t1; ++t) texp[t] = e;
            if (e == 7) texp[MAXTILES] = sc[72] >> 8;
        }
        int e0 = 0, e1 = 0, r0 = 0, r1 = 0;
        if (F.tid < 256) {
            const int w = F.tid >> 6; const int pk = e01g[tile * 256 + F.tid]; e0 = pk & 255; e1 = pk >> 8;
            const unsigned long long below = (1ull << F.lane) - 1ull;
#pragma unroll
            for (int e = 0; e < 8; ++e) {
                const unsigned long long m0 = __ballot(e0 == e), m1 = __ballot(e1 == e);
                const int rk = __popcll(m0 & below) + __popcll(m1 & below);
                if (e0 == e) r0 = rk; if (e1 == e) r1 = rk;
                if (F.lane == 0) sc[32 + w * 8 + e] = __popcll(m0) + __popcll(m1);
            }
        }
        __syncthreads();
        if (F.tid < 256) {
            const int w = F.tid >> 6; int b0 = sc[16 + e0], b1 = sc[16 + e1];
            for (int ww = 0; ww < w; ++ww) { b0 += sc[32 + ww * 8 + e0]; b1 += sc[32 + ww * 8 + e1]; }
            const int d0 = b0 + r0, d1 = b1 + r1;
            dst[2 * F.tid] = d0; dst[2 * F.tid + 1] = d1;
            posg[2 * (tile * 256 + F.tid)] = d0; posg[2 * (tile * 256 + F.tid) + 1] = d1;
        }
        __syncthreads();
#pragma nounroll
        for (int t0 = F.wave * 32; t0 < F.wave * 32 + 32; t0 += 16) {
            u32x4 v[16];
#pragma unroll
            for (int j = 0; j < 16; ++j) v[j] = ((const u32x4*)(HB8 + (size_t)(tile * 256 + t0 + j) * D))[F.lane];
#pragma unroll
            for (int j = 0; j < 16; ++j) { const int d0 = dst[2 * (t0 + j)], d1 = dst[2 * (t0 + j) + 1];
                ((u32x4*)(GA8 + (size_t)d0 * D))[F.lane] = v[j]; ((u32x4*)(GA8 + (size_t)d1 * D))[F.lane] = v[j]; }
        }
    }
}

namespace att {
constexpr int L_OS = 0, L_MS = 32768, L_LS = 33792, L_SSQ = 34816, L_RPB = 51200, L_KV = 62976, KV_WAVE = 8832, KT_BYTES = 4608;
static_assert(L_KV + 8 * KV_WAVE <= MISC_OFF, "attention LDS map");
__device__ __forceinline__ f32x4 mfma16(bf16x8 a, bf16x8 b, f32x4 c) { return __builtin_amdgcn_mfma_f32_16x16x32_bf16(a, b, c, 0, 0, 0); }
__device__ __forceinline__ v4i16_t vtr(const LAS unsigned char* p) { return __builtin_amdgcn_ds_read_tr16_b64_v4i16((LAS v4i16_t*)p); }

struct St { float m, lp; f32x4 o[4]; };
__device__ __forceinline__ void st_init(St& s) { s.m = -1e30f; s.lp = 0.f;
#pragma unroll
    for (int d = 0; d < 4; ++d) s.o[d] = (f32x4){0.f, 0.f, 0.f, 0.f}; }

struct Ld { u32x4 k0, k1, k2, k3, v0, v1, v2, v3; };
__device__ __forceinline__ void ld_issue8(Ld& L, const bf16* k0p, const bf16* k1p, const bf16* k2p, const bf16* k3p, const bf16* v0p, const bf16* v1p, const bf16* v2p, const bf16* v3p) {
    L.k0 = *(const u32x4*)(k0p); L.k1 = *(const u32x4*)(k1p); L.k2 = *(const u32x4*)(k2p); L.k3 = *(const u32x4*)(k3p);
    L.v0 = *(const u32x4*)(v0p); L.v1 = *(const u32x4*)(v1p); L.v2 = *(const u32x4*)(v2p); L.v3 = *(const u32x4*)(v3p);
}
__device__ __forceinline__ void ld_issue(Ld& L, const bf16* kp, const bf16* vp, size_t r8) { ld_issue8(L, kp, kp + r8, kp + 2 * r8, kp + 3 * r8, vp, vp + r8, vp + 2 * r8, vp + 3 * r8); }
constexpr int VPL = 1056;
struct Kf { bf16x8 k00, k01, k10, k11; };
__device__ __forceinline__ void stage_kv(const Ld& L, LAS unsigned char* kvl, int lane) {
    LAS unsigned char* kw = kvl + (lane >> 3) * 144 + (lane & 7) * 16;
    *(LAS u32x4*)(kw) = L.k0; *(LAS u32x4*)(kw + 1152) = L.k1; *(LAS u32x4*)(kw + 2304) = L.k2; *(LAS u32x4*)(kw + 3456) = L.k3;
    const int c = lane & 7; LAS unsigned char* vw = kvl + KT_BYTES + (c >> 1) * VPL + (lane >> 3) * 32 + (c & 1) * 16;
    *(LAS u32x4*)(vw) = L.v0; *(LAS u32x4*)(vw + 256) = L.v1; *(LAS u32x4*)(vw + 512) = L.v2; *(LAS u32x4*)(vw + 768) = L.v3;
}
__device__ __forceinline__ Kf kf_read(const LAS unsigned char* kvl, int lq, int lg) {
    const LAS unsigned char* p = kvl + lq * 144 + lg * 16; Kf k;
    k.k00 = *(const LAS bf16x8*)(p); k.k01 = *(const LAS bf16x8*)(p + 64); k.k10 = *(const LAS bf16x8*)(p + 16 * 144); k.k11 = *(const LAS bf16x8*)(p + 16 * 144 + 64); return k;
}
__device__ __forceinline__ void qk(const Kf& L, const bf16x8 (&q)[2], f32x4& s0, f32x4& s1) {
    const f32x4 z = (f32x4){0.f, 0.f, 0.f, 0.f};
    s0 = mfma16(L.k00, q[0], z); s0 = mfma16(L.k01, q[1], s0); s1 = mfma16(L.k10, q[0], z); s1 = mfma16(L.k11, q[1], s1);
}
__device__ __forceinline__ void soft_pv(f32x4 s0, f32x4 s1, const LAS unsigned char* vl, int lq, int lg, St& S) {
    const float mx = vmax2(vmax3(s0[0], s0[1], s0[2]), vmax3(vmax3(s0[3], s1[0], s1[1]), s1[2], s1[3]));
    if (__any(mx > S.m + 8.0f)) {
        float mf = vmax2(mx, __shfl_xor(mx, 16)); mf = vmax2(mf, __shfl_xor(mf, 32));
        const float mn = vmax2(S.m, mf); const float alpha = __builtin_amdgcn_exp2f(S.m - mn); S.m = mn;
        S.lp *= alpha;
#pragma unroll
        for (int d = 0; d < 4; ++d) S.o[d] = S.o[d] * alpha;
    }
    const float mn = S.m;
    float p[8];
#pragma unroll
    for (int r = 0; r < 4; ++r) { p[r] = __builtin_amdgcn_exp2f(s0[r] - mn); p[4 + r] = __builtin_amdgcn_exp2f(s1[r] - mn); }
    S.lp += ((p[0] + p[1]) + (p[2] + p[3])) + ((p[4] + p[5]) + (p[6] + p[7]));
    u32x4 pw; pw.x = pg8::cvt_pk_bf16(p[0], p[1]); pw.y = pg8::cvt_pk_bf16(p[2], p[3]); pw.z = pg8::cvt_pk_bf16(p[4], p[5]); pw.w = pg8::cvt_pk_bf16(p[6], p[7]);
    const bf16x8 pf = __builtin_bit_cast(bf16x8, pw);
    const LAS unsigned char* tb = vl + KT_BYTES + (4 * lg + (lq >> 2)) * 32 + 8 * (lq & 3);
#pragma unroll
    for (int d = 0; d < 4; ++d) {
        const v4i16_t lo = vtr(tb + d * VPL), hi = vtr(tb + d * VPL + 512);
        const bf16x8 vf = (bf16x8){lo[0], lo[1], lo[2], lo[3], hi[0], hi[1], hi[2], hi[3]};
        S.o[d] = mfma16(vf, pf, S.o[d]);
    }
}
template <int NT>
__device__ __forceinline__ void multi_soft_pv(f32x4 (&s0)[NT], f32x4 (&s1)[NT], const LAS unsigned char* vl, int lq, int lg, St (&S)[NT], const int am = -1) {
    float mx[NT]; bool trig = false;
#pragma unroll
    for (int t = 0; t < NT; ++t) if (am & (1 << t)) { mx[t] = vmax2(vmax3(s0[t][0], s0[t][1], s0[t][2]), vmax3(vmax3(s0[t][3], s1[t][0], s1[t][1]), s1[t][2], s1[t][3])); trig = trig || (mx[t] > S[t].m + 8.0f); }
    if (__any(trig)) {
#pragma unroll
        for (int t = 0; t < NT; ++t) if (am & (1 << t)) {
            float mf = vmax2(mx[t], __shfl_xor(mx[t], 16)); mf = vmax2(mf, __shfl_xor(mf, 32));
            const float mn = vmax2(S[t].m, mf); const float alpha = __builtin_amdgcn_exp2f(S[t].m - mn); S[t].m = mn; S[t].lp *= alpha;
#pragma unroll
            for (int d = 0; d < 4; ++d) S[t].o[d] = S[t].o[d] * alpha;
        }
    }
    bf16x8 pf[NT];
#pragma unroll
    for (int t = 0; t < NT; ++t) if (am & (1 << t)) {
        const float mn = S[t].m; float p[8];
#pragma unroll
        for (int r = 0; r < 4; ++r) { p[r] = __builtin_amdgcn_exp2f(s0[t][r] - mn); p[4 + r] = __builtin_amdgcn_exp2f(s1[t][r] - mn); }
        S[t].lp += ((p[0] + p[1]) + (p[2] + p[3])) + ((p[4] + p[5]) + (p[6] + p[7]));
        u32x4 pw; pw.x = pg8::cvt_pk_bf16(p[0], p[1]); pw.y = pg8::cvt_pk_bf16(p[2], p[3]); pw.z = pg8::cvt_pk_bf16(p[4], p[5]); pw.w = pg8::cvt_pk_bf16(p[6], p[7]);
        pf[t] = __builtin_bit_cast(bf16x8, pw);
    }
    const LAS unsigned char* tb = vl + KT_BYTES + (4 * lg + (lq >> 2)) * 32 + 8 * (lq & 3);
#pragma unroll
    for (int d = 0; d < 4; ++d) {
        const v4i16_t lo = vtr(tb + d * VPL), hi = vtr(tb + d * VPL + 512);
        const bf16x8 vf = (bf16x8){lo[0], lo[1], lo[2], lo[3], hi[0], hi[1], hi[2], hi[3]};
#pragma unroll
        for (int t = 0; t < NT; ++t) if (am & (1 << t)) S[t].o[d] = mfma16(vf, pf[t], S[t].o[d]);
    }
}
__device__ __forceinline__ float lsum(float lp) { lp += __shfl_xor(lp, 16); lp += __shfl_xor(lp, 32); return lp; }

__device__ __forceinline__ void finish(const St& S, float l, bf16* yrow  , LAS float* ssq_slot, int lg) {
    const float inv = 1.0f / l; float ss = 0.f;
#pragma unroll
    for (int d = 0; d < 4; ++d) { const f32x4 v = S.o[d] * inv; ss += (v[0] * v[0] + v[1] * v[1]) + (v[2] * v[2] + v[3] * v[3]);
        u32x2 w; w.x = pg8::cvt_pk_bf16(v[0], v[1]); w.y = pg8::cvt_pk_bf16(v[2], v[3]); *(u32x2*)(yrow + 16 * d + 4 * lg) = w; }
    ss += __shfl_xor(ss, 16); ss += __shfl_xor(ss, 32);
    if (lg == 0) *ssq_slot = ss;
}

__device__ __forceinline__ void attn_unit(Frame& F, int b, int t0, int layer) {
    LAS unsigned char* lds = F.lds;
    int lane = F.lane, lq = lane & 15, lg = lane >> 4; const int wave = F.wave;
#define RELANE() do { asm volatile("" : "+v"(lane)); lq = lane & 15; lg = lane >> 4; } while (0)
    const bf16* QKV = (const bf16*)(F.ws + WS_BIG); const bf16* MKV = (const bf16*)(F.ws + WS_MEMKV4) + (size_t)layer * MROWS * 512; bf16* Y = (bf16*)(F.ws + WS_HB);
    LAS bf16* Os = (LAS bf16*)(lds + L_OS); LAS float* Ms = (LAS float*)(lds + L_MS); LAS float* Ls = (LAS float*)(lds + L_LS);
    LAS float* ssq = (LAS float*)(lds + L_SSQ); LAS float* rpb = (LAS float*)(lds + L_RPB);
    LAS unsigned char* vl = lds + L_KV + wave * KV_WAVE;
    const size_t rowb = (size_t)b * T;
    { const float* rp = INP(4) + (size_t)layer * 6 * 465; for (int i = F.tid; i < 6 * 480; i += 512) { const int hh = i / 480, rem = i - hh * 480, ro = rem >> 5, co = rem & 31; rpb[i] = co < 31 ? rp[hh * 465 + ro * 31 + co] * LOG2E : -INFINITY; } }
    __syncthreads();
    const int R0 = t0 >> 6;
#pragma nounroll
    for (int pass = 0; pass < 3; ++pass) {
        RELANE();
        const int h = 2 * pass + (wave >> 2), kq = wave & 3;
        const int qc = 16 * kq + lq, cs = (kq == 0) ? 0 : (kq == 1) ? 8 : (kq == 2) ? 24 : 32;
        int c0q = qc - 8; c0q = c0q < 0 ? 0 : (c0q > 48 ? 48 : c0q);
        unsigned bcol[8];
#pragma unroll
        for (int e = 0; e < 8; ++e) { const int c = cs + 16 * (e >> 2) + 4 * lg + (e & 3); const bool ok = (c >= c0q) && (c <= c0q + 15);
            bcol[e] = (unsigned)(uintptr_t)(rpb + h * 480) + 4u * (unsigned)(ok ? (c - qc + 15) : 31); }
        int r0v[4]; bf16x8 qf[4][2]; St S[4];
#pragma unroll
        for (int rr = 0; rr < 4; ++rr) { const int r = R0 + rr; int r0 = r - 4; r0 = r0 < 0 ? 0 : (r0 > 120 ? 120 : r0); r0v[rr] = r0;
            const size_t qrow = rowb + (size_t)r * 64 + qc;
            qf[rr][0] = *(const bf16x8*)(QKV + qrow * NQKV + OFF_QA + h * 64 + lg * 8); qf[rr][1] = *(const bf16x8*)(QKV + qrow * NQKV + OFF_QA + h * 64 + 32 + lg * 8);
            st_init(S[rr]); }
        const int krmin = r0v[0], nrows = r0v[3] + 8 - krmin;
        const bf16* kbase = QKV + (rowb + (size_t)krmin * 64 + cs + (lane >> 3)) * NQKV + OFF_KA + h * 64 + (lane & 7) * 8;
        const bf16* vbase = kbase + (OFF_VA - OFF_KA);
        const size_t v8 = (size_t)8 * NQKV;
        const size_t rstep = (size_t)64 * NQKV;
        auto na_row = [&](int kr) {
            const Kf kf = kf_read(vl, lq, lg);
            f32x4 s0[4], s1[4];
            int am = 0;
#pragma unroll
            for (int rr = 0; rr < 4; ++rr) am |= (kr >= r0v[rr] && kr < r0v[rr] + 8) ? (1 << rr) : 0;
            am = __builtin_amdgcn_readfirstlane(am);
#pragma unroll
            for (int rr = 0; rr < 4; ++rr) if (am & (1 << rr)) {
                const unsigned ro = (unsigned)(kr - (R0 + rr) + 7) * 128u;
                f32x4 a0, a1;
#pragma unroll
                for (int e = 0; e < 4; ++e) { a0[e] = *(const LAS float*)(uintptr_t)(bcol[e] + ro); a1[e] = *(const LAS float*)(uintptr_t)(bcol[4 + e] + ro); }
                qk(kf, qf[rr], s0[rr], s1[rr]);
                s0[rr] = s0[rr] + a0; s1[rr] = s1[rr] + a1;
            }
            multi_soft_pv<4>(s0, s1, vl, lq, lg, S, am);
            asm volatile("" ::: "memory");
        };
        Ld LA;
        ld_issue(LA, kbase, vbase, v8);
#pragma nounroll
        for (int j = 0; j < nrows; ++j) {
            stage_kv(LA, vl, lane);
            asm volatile("" ::: "memory");
            { const int jn = (j + 1 < nrows) ? j + 1 : nrows - 1; ld_issue(LA, kbase + (size_t)jn * rstep, vbase + (size_t)jn * rstep, v8); }
            na_row(krmin + j);
        }
#pragma unroll
        for (int rr = 0; rr < 4; ++rr) { const float l = lsum(S[rr].lp);
            finish(S[rr], l, Y + (rowb + (size_t)(R0 + rr) * 64 + qc) * D + h * 64, ssq + h * 256 + (rr * 64 + qc), lg); }
    }
#pragma nounroll
    for (int pass = 0; pass < 2; ++pass) {
        RELANE();
        const int h = 2 * pass + (wave >> 2), j0 = 4 * (wave & 3);
        bf16x8 qf[4][2]; St S[4];
#pragma unroll
        for (int t = 0; t < 4; ++t) { const size_t qrow = rowb + t0 + 16 * (j0 + t) + lq;
            qf[t][0] = *(const bf16x8*)(QKV + qrow * NQKV + OFF_QM + h * 64 + lg * 8); qf[t][1] = *(const bf16x8*)(QKV + qrow * NQKV + OFF_QM + h * 64 + 32 + lg * 8);
            st_init(S[t]); }
        const bf16* kbase = MKV + ((size_t)b * NMEM + (lane >> 3)) * 512 + h * 64 + (lane & 7) * 8;
        const bf16* vbase = kbase + 256;
        Ld LA;
        ld_issue(LA, kbase, vbase, (size_t)8 * 512);
#pragma nounroll
        for (int s = 0; s < 8; ++s) {
            stage_kv(LA, vl, lane);
            asm volatile("" ::: "memory");
            { const int sn = (s + 1 < 8) ? s + 1 : 7; ld_issue(LA, kbase + sn * 32 * 512, vbase + sn * 32 * 512, (size_t)8 * 512); }
            const Kf kf = kf_read(vl, lq, lg);
            f32x4 s0[4], s1[4];
#pragma unroll
            for (int t = 0; t < 4; ++t) qk(kf, qf[t], s0[t], s1[t]);
            multi_soft_pv<4>(s0, s1, vl, lq, lg, S);
            asm volatile("" ::: "memory");
        }
#pragma unroll
        for (int t = 0; t < 4; ++t) { const int idx = 16 * (j0 + t) + lq; const float l = lsum(S[t].lp);
            finish(S[t], l, Y + (rowb + t0 + idx) * D + 768 + h * 64, ssq + (12 + h) * 256 + idx, lg); }
    }
    __syncthreads();
    for (int h = 0; h < 6; ++h) {
#pragma nounroll
        for (int br = 0; br < 2; ++br) {
            RELANE();
            const int sh = 2 * br, dl = 1 << sh, seg = T >> sh;
            const int res = br ? (wave >> 1) : 0, m0 = br ? ((t0 >> 2) + 32 * (wave & 1)) : (t0 + 32 * wave);
            bf16x8 qf[2][2]; St S[2]; int idxv[2];
#pragma unroll
            for (int t = 0; t < 2; ++t) { const size_t qrow = rowb + (size_t)(m0 + 16 * t + lq) * dl + res;
                qf[t][0] = *(const bf16x8*)(QKV + qrow * NQKV + OFF_QB + h * 64 + lg * 8); qf[t][1] = *(const bf16x8*)(QKV + qrow * NQKV + OFF_QB + h * 64 + 32 + lg * 8);
                st_init(S[t]); idxv[t] = br ? (128 * (wave & 1) + 64 * t + 4 * lq + res) : (32 * wave + 16 * t + lq); }
            const bool edge = (m0 - 64 < 0) || (m0 + 95 >= seg);
            auto dload = [&](Ld& L, int s) {
                const int kb = m0 - 64 + 32 * s;
                int kv = kb + (lane >> 3);
                const bf16* kcol = QKV + (rowb + res) * NQKV + OFF_KB + h * 64 + (lane & 7) * 8; const bf16* vcol = kcol + (OFF_VB - OFF_KB);
                const size_t rs = (size_t)dl * NQKV;
                if (edge) {
                    int v0 = kv, v1 = kv + 8, v2 = kv + 16, v3 = kv + 24;
                    v0 = v0 < 0 ? 0 : (v0 >= seg ? seg - 1 : v0); v1 = v1 < 0 ? 0 : (v1 >= seg ? seg - 1 : v1); v2 = v2 < 0 ? 0 : (v2 >= seg ? seg - 1 : v2); v3 = v3 < 0 ? 0 : (v3 >= seg ? seg - 1 : v3);
                    ld_issue8(L, kcol + (size_t)v0 * rs, kcol + (size_t)v1 * rs, kcol + (size_t)v2 * rs, kcol + (size_t)v3 * rs, vcol + (size_t)v0 * rs, vcol + (size_t)v1 * rs, vcol + (size_t)v2 * rs, vcol + (size_t)v3 * rs);
                } else ld_issue(L, kcol + (size_t)kv * rs, vcol + (size_t)kv * rs, 8 * rs); };
            auto dstep = [&](int s) {
                const Kf kf = kf_read(vl, lq, lg);
                const int kb = m0 - 64 + 32 * s;
                f32x4 s0[2], s1[2];
#pragma unroll
                for (int t = 0; t < 2; ++t) {
                    qk(kf, qf[t], s0[t], s1[t]);
                    if (edge || s == 0 || s == 4) {
                        const int qm = m0 + 16 * t + lq;
#pragma unroll
                        for (int e = 0; e < 8; ++e) { const int km = kb + 16 * (e >> 2) + 4 * lg + (e & 3); const int dd = km - qm;
                            const bool ok = (km >= 0) && (km < seg) && (dd >= -64) && (dd <= 64); if (!ok) { if (e < 4) s0[t][e] = -INFINITY; else s1[t][e - 4] = -INFINITY; } }
                    }
                }
                multi_soft_pv<2>(s0, s1, vl, lq, lg, S);
                asm volatile("" ::: "memory");
            };
            { Ld LA;
              dload(LA, 0);
#pragma nounroll
              for (int s = 0; s < 5; ++s) {
                  stage_kv(LA, vl, lane);
                  asm volatile("" ::: "memory");
                  dload(LA, s + 1 < 5 ? s + 1 : 4);
                  dstep(s);
              } }
#pragma unroll
            for (int t = 0; t < 2; ++t) {
                const int idx = idxv[t]; float l = lsum(S[t].lp);
                LAS u32x2* osr = (LAS u32x2*)(Os + idx * 64 + 4 * lg);
                if (br > 0) {
                    const float m1 = Ms[idx], l1 = Ls[idx]; const float mn = vmax2(S[t].m, m1);
                    const float a1 = __builtin_amdgcn_exp2f(m1 - mn), a2 = __builtin_amdgcn_exp2f(S[t].m - mn);
#pragma unroll
                    for (int d = 0; d < 4; ++d) { const u32x2 w = osr[4 * d]; const f32x4 o1 = (f32x4){bf_lo(w.x), bf_hi(w.x), bf_lo(w.y), bf_hi(w.y)}; S[t].o[d] = o1 * a1 + S[t].o[d] * a2; }
                    l = l1 * a1 + l * a2; S[t].m = mn;
                }
#pragma unroll
                for (int d = 0; d < 4; ++d) { u32x2 w; w.x = pg8::cvt_pk_bf16(S[t].o[d][0], S[t].o[d][1]); w.y = pg8::cvt_pk_bf16(S[t].o[d][2], S[t].o[d][3]); osr[4 * d] = w; }
                if (lg == 0) { Ms[idx] = S[t].m; Ls[idx] = l; }
            }
            __syncthreads();
        }
        {
            constexpr int dl = 16, seg = T >> 4;
#pragma nounroll
            for (int tix = wave; tix < 16; tix += 8) {
                RELANE();
                const int res = tix, m0 = t0 >> 4, idx = 16 * lq + res;
                const size_t qrow = rowb + (size_t)(m0 + lq) * dl + res;
                bf16x8 qf[2];
                qf[0] = *(const bf16x8*)(QKV + qrow * NQKV + OFF_QB + h * 64 + lg * 8); qf[1] = *(const bf16x8*)(QKV + qrow * NQKV + OFF_QB + h * 64 + 32 + lg * 8);
                St S; st_init(S);
                const int qm = m0 + lq;
                const bool edge = (m0 - 64 < 0) || (m0 + 95 >= seg);
                auto dload = [&](Ld& L, int s) {
                    const int kb = m0 - 64 + 32 * s;
                    int kv = kb + (lane >> 3);
                    const bf16* kcol = QKV + (rowb + res) * NQKV + OFF_KB + h * 64 + (lane & 7) * 8; const bf16* vcol = kcol + (OFF_VB - OFF_KB);
                    const size_t rs = (size_t)dl * NQKV;
                    if (edge) {
                        int v0 = kv, v1 = kv + 8, v2 = kv + 16, v3 = kv + 24;
                        v0 = v0 < 0 ? 0 : (v0 >= seg ? seg - 1 : v0); v1 = v1 < 0 ? 0 : (v1 >= seg ? seg - 1 : v1); v2 = v2 < 0 ? 0 : (v2 >= seg ? seg - 1 : v2); v3 = v3 < 0 ? 0 : (v3 >= seg ? seg - 1 : v3);
                        ld_issue8(L, kcol + (size_t)v0 * rs, kcol + (size_t)v1 * rs, kcol + (size_t)v2 * rs, kcol + (size_t)v3 * rs, vcol + (size_t)v0 * rs, vcol + (size_t)v1 * rs, vcol + (size_t)v2 * rs, vcol + (size_t)v3 * rs);
                    } else ld_issue(L, kcol + (size_t)kv * rs, vcol + (size_t)kv * rs, 8 * rs); };
                auto dstep = [&](int s) {
                    const Kf kf = kf_read(vl, lq, lg);
                    const int kb = m0 - 64 + 32 * s;
                    f32x4 s0, s1; qk(kf, qf, s0, s1);
                    if (edge || s == 0 || s == 4) {
#pragma unroll
                        for (int e = 0; e < 8; ++e) { const int km = kb + 16 * (e >> 2) + 4 * lg + (e & 3); const int dd = km - qm;
                            const bool ok = (km >= 0) && (km < seg) && (dd >= -64) && (dd <= 64); if (!ok) { if (e < 4) s0[e] = -INFINITY; else s1[e - 4] = -INFINITY; } }
                    }
                    soft_pv(s0, s1, vl, lq, lg, S);
                    asm volatile("" ::: "memory");
                };
                { Ld LA;
                  dload(LA, 0);
#pragma nounroll
                  for (int s = 0; s < 5; ++s) {
                      stage_kv(LA, vl, lane);
                      asm volatile("" ::: "memory");
                      dload(LA, s + 1 < 5 ? s + 1 : 4);
                      dstep(s);
                  } }
                float l = lsum(S.lp);
                LAS u32x2* osr = (LAS u32x2*)(Os + idx * 64 + 4 * lg);
                { const float m1 = Ms[idx], l1 = Ls[idx]; const float mn = vmax2(S.m, m1);
                  const float a1 = __builtin_amdgcn_exp2f(m1 - mn), a2 = __builtin_amdgcn_exp2f(S.m - mn);
#pragma unroll
                  for (int d = 0; d < 4; ++d) { const u32x2 w = osr[4 * d]; const f32x4 o1 = (f32x4){bf_lo(w.x), bf_hi(w.x), bf_lo(w.y), bf_hi(w.y)}; S.o[d] = o1 * a1 + S.o[d] * a2; }
                  l = l1 * a1 + l * a2; S.m = mn; }
                finish(S, l, Y + qrow * D + 384 + h * 64, ssq + (6 + h) * 256 + idx, lg);
            }
            __syncthreads();
        }
    }
    VM_WAIT(); __syncthreads();
    RELANE();
    {
        const float* gm = INP(7) + (size_t)layer * D;
        const int c0 = 8 * lane, c1 = 512 + 8 * lane;
        const int g0 = c0 < 384 ? 0 : 1, g1 = c1 < 768 ? 1 : 2;
        f32x4 ga[2], gb[2];
        ga[0] = *(const f32x4*)(gm + c0); ga[1] = *(const f32x4*)(gm + c0 + 4); gb[0] = *(const f32x4*)(gm + c1); gb[1] = *(const f32x4*)(gm + c1 + 4);
#pragma nounroll
        for (int i0 = 0; i0 < 32; i0 += 4) {
            u32x4 w0[4], w1[4]; float s0v[4], s1v[4];
#pragma unroll
            for (int q = 0; q < 4; ++q) { const bf16* yr = Y + (rowb + t0 + wave * 32 + i0 + q) * D; w0[q] = *(const u32x4*)(yr + c0); w1[q] = *(const u32x4*)(yr + c1); }
#pragma unroll
            for (int q = 0; q < 4; ++q) {
                const int idx = wave * 32 + i0 + q;
                float sa = 0.f, sb = 0.f, sm = 0.f;
#pragma unroll
                for (int hh = 0; hh < 6; ++hh) { sa += ssq[hh * 256 + idx]; sb += ssq[(6 + hh) * 256 + idx]; }
#pragma unroll
                for (int hh = 0; hh < 4; ++hh) sm += ssq[(12 + hh) * 256 + idx];
                const float ra = 1.0f / sqrtf(sa * (1.0f / 384.f) + RMS_EPS), rb = 1.0f / sqrtf(sb * (1.0f / 384.f) + RMS_EPS), rm = 1.0f / sqrtf(sm * (1.0f / 256.f) + RMS_EPS);
                s0v[q] = g0 == 0 ? ra : rb; s1v[q] = g1 == 1 ? rb : rm;
            }
#pragma unroll
            for (int q = 0; q < 4; ++q) {
                bf16* yr = Y + (rowb + t0 + wave * 32 + i0 + q) * D; const float s0 = s0v[q], s1 = s1v[q]; const u32x4 a = w0[q], bb = w1[q];
                u32x4 o0, o1;
                o0.x = pk2(bf_lo(a.x) * s0 * ga[0][0], bf_hi(a.x) * s0 * ga[0][1]); o0.y = pk2(bf_lo(a.y) * s0 * ga[0][2], bf_hi(a.y) * s0 * ga[0][3]);
                o0.z = pk2(bf_lo(a.z) * s0 * ga[1][0], bf_hi(a.z) * s0 * ga[1][1]); o0.w = pk2(bf_lo(a.w) * s0 * ga[1][2], bf_hi(a.w) * s0 * ga[1][3]);
                o1.x = pk2(bf_lo(bb.x) * s1 * gb[0][0], bf_hi(bb.x) * s1 * gb[0][1]); o1.y = pk2(bf_lo(bb.y) * s1 * gb[0][2], bf_hi(bb.y) * s1 * gb[0][3]);
                o1.z = pk2(bf_lo(bb.z) * s1 * gb[1][0], bf_hi(bb.z) * s1 * gb[1][1]); o1.w = pk2(bf_lo(bb.w) * s1 * gb[1][2], bf_hi(bb.w) * s1 * gb[1][3]);
                *(u32x4*)(yr + c0) = o0; *(u32x4*)(yr + c1) = o1;
            }
        }
    }
    __syncthreads();
}
}

#ifdef NO_G1
#define GEMM_SITE1(x)
#else
#define GEMM_SITE1(x) x
#endif
#ifdef NO_G2
#define GEMM_SITE2(x)
#else
#define GEMM_SITE2(x) x
#endif
#ifdef NO_G3
#define GEMM_SITE3(x)
#else
#define GEMM_SITE3(x) x
#endif
#ifdef NO_G4
#define GEMM_SITE4(x)
#else
#define GEMM_SITE4(x) x
#endif
#ifdef NO_G5
#define GEMM_SITE5(x)
#else
#define GEMM_SITE5(x) x
#endif
#ifdef NO_G6
#define GEMM_SITE6(x)
#else
#define GEMM_SITE6(x) x
#endif
#ifdef NO_G7
#define GEMM_SITE7(x)
#else
#define GEMM_SITE7(x) x
#endif
struct Args { const float* in[18]; float* out; unsigned char* ws; int ph_lo, ph_hi, use_bar, pad; };
constexpr int PH_PER_LAYER = 16, SEQ_FINAL = 1 + DEPTH * PH_PER_LAYER, SEQ_END = SEQ_FINAL + 1;

__global__ void __launch_bounds__(NWAVES * 64, 2) fwd_kernel(Args args) {
    extern __shared__ __attribute__((aligned(16))) unsigned char lds_raw[];
    Frame F;
    F.lds = (LAS unsigned char*)lds_raw; F.misc = F.lds + MISC_OFF;
    F.tid = threadIdx.x; F.lane = F.tid & 63; F.wave = __builtin_amdgcn_readfirstlane(F.tid >> 6);
    F.G = gridDim.x; F.bx = blockIdx.x; F.ws = args.ws; F.out = args.out;
    if (F.tid == 0) {
#pragma unroll
        for (int i = 0; i < 18; ++i) ((LAS unsigned long long*)(F.misc + MISC_PTAB))[i] = (unsigned long long)args.in[i];
        ((LAS unsigned long long*)(F.misc + MISC_PTAB))[18] = (unsigned long long)args.ws; ((LAS unsigned long long*)(F.misc + MISC_PTAB))[19] = (unsigned long long)args.out;
    }
    gu32* ctl = (gu32*)(F.ws + WS_CTL);
    if (F.tid < 4) ((LAS unsigned*)(F.misc + MISC_BARW))[F.tid] = 0u;
    __syncthreads();
    XcdBarrier bar; bar.bar = (unsigned*)(ctl + CW_BAR); bar.x = 0; bar.st = nullptr;
    if (args.use_bar) { bar = xcd_barrier_post((unsigned*)(ctl + CW_BAR), (volatile LAS unsigned*)(F.misc + MISC_BARW)); if (F.tid == 0) ((volatile LAS unsigned*)(F.misc + MISC_BARW))[2] = bar.x; __syncthreads(); }
    const int lo = args.ph_lo, hi = args.ph_hi;
#define IN(k) (lo <= (k) && (k) < hi)
#define LAUNDER() do { unsigned lb_ = (unsigned)(uintptr_t)(LAS unsigned char*)lds_raw; asm volatile("" : "+v"(lb_)); lb_ = (unsigned)__builtin_amdgcn_readfirstlane((int)lb_); F.lds = (LAS unsigned char*)(uintptr_t)lb_; F.misc = F.lds + MISC_OFF; \
    F.ws = (unsigned char*)inp_ptr(F.misc, 18); F.out = (float*)inp_ptr(F.misc, 19); asm volatile("" : "+v"(F.tid), "+v"(F.lane)); F.wave = __builtin_amdgcn_readfirstlane(F.tid >> 6); \
    { int bx_ = F.bx, g_ = F.G; asm volatile("" : "+v"(bx_), "+v"(g_)); F.bx = __builtin_amdgcn_readfirstlane(bx_); F.G = __builtin_amdgcn_readfirstlane(g_); } } while (0)
#define SEAM(k) do { if (args.use_bar && (k) + 1 < hi) { XcdBarrier b_; b_.bar = (unsigned*)((unsigned char*)inp_ptr(F.misc, 18) + WS_CTL) + CW_BAR; b_.st = (volatile LAS unsigned*)(F.misc + MISC_BARW); \
        b_.x = (unsigned)__builtin_amdgcn_readfirstlane((int)((volatile LAS unsigned*)(F.misc + MISC_BARW))[2]); xcd_barrier(b_); if (PROBE_BAR2) xcd_barrier(b_); } else { VM_WAIT(); __syncthreads(); } } while (0)

#define HB ((bf16*)(F.ws + WS_HB))
#define QKV ((bf16*)(F.ws + WS_BIG))
    LAS int* texp_l = (LAS int*)(F.misc + MISC_TEXP);

    if (IN(0)) { LAUNDER(); for (int rep = 0; rep < PROBE_CONV_REPS; ++rep) phase_convert(F);
        if (!(args.use_bar && hi > 2)) SEAM(0); }


    for (int L = 0; L < DEPTH; ++L) {
        const int base = 1 + L * PH_PER_LAYER;
        if (hi <= base || lo >= base + PH_PER_LAYER) continue;
        const bool moe = (L & 1) != 0; const int fi = L >> 1;
        const bool f8 = moe || DENSE_UP8(L), f8d = moe || DENSE_DN8(L);
#define wc (F.ws + WS_WC + (size_t)L * WC_STRIDE)
        const int comb = (L > 0 && ((L - 1) & 1)) ? 1 : 0;
        if (IN(base + 0) && (L == 0 || comb)) {
            LAUNDER();
            RowPass P{}; P.xsrc = (L == 0) ? INP(0) : (const float*)nullptr; P.xbf = (const bf16*)F.out; P.combine = comb; P.xdst = comb ? (bf16*)F.out : nullptr; P.gain = INP(2) + (size_t)L * D;
            P.ob = (L == 0) ? (bf16*)F.out : (bf16*)nullptr; P.obp = XP; P.ssq = comb ? (float*)(F.ws + WS_SSQ) : (float*)nullptr; P.ob8 = nullptr; P.of = nullptr; P.router = 0; P.wr = nullptr;
            phase_rows(F, P);
            if (L == 0) phase_memnorm(F);
            SEAM(base + 0);
        }
        if (IN(base + 1)) {
            LAUNDER();
#if QKV_FP8
            { pg8::Gemm g{HB, (const bf16*)(wc + WC_IN), M, NQKV, D / 2, 0}; pg8::TileOrder S; S.init(M, NQKV, F.G, F.bx, nullptr);
              pg8::EpiQKVT<true> E{QKV, (const float*)(F.ws + WS_COS), (const float*)(F.ws + WS_SIN), ACC8_SCALE};
              GEMM_SITE1(pg8::gemm_phase(F.lds, g, S, E, F.tid)); }
#else
            { pg8::Gemm g{(const bf16*)F.out, (const bf16*)(wc + WC_IN), M, NQKV, D, 0}; pg8::TileOrder S; S.init(M, NQKV, F.G, F.bx, nullptr);
              pg8::EpiQKVT<false> E{QKV, (const float*)(F.ws + WS_COS), (const float*)(F.ws + WS_SIN), 1.0f, (const float*)(F.ws + WS_SSQ), (L == 0) ? 0 : 1};
              GEMM_SITE1(pg8::gemm_phase(F.lds, g, S, E, F.tid)); }
#endif
            if (L == 0) {
                LAUNDER();
                __syncthreads();
                for (int i = F.tid; i < MAXTILES + 8; i += 512) texp_l[i] = i >> 3;
                __syncthreads();
                pg8::Gemm g{(const bf16*)(F.ws + WS_MEMN4), (const bf16*)(F.ws + WS_WC + WC_MKV), DEPTH * MROWS, 512, D, WC_STRIDE}; pg8::TileOrder S; S.init(DEPTH * MROWS, 512, F.G, F.bx, texp_l);
                pg8::EpiPlain E{(bf16*)(F.ws + WS_MEMKV4), 512};
                GEMM_SITE2(pg8::gemm_phase(F.lds, g, S, E, F.tid));
            }
            SEAM(base + 1);
        }
        if (IN(base + 2)) {
            LAUNDER();
#ifndef NO_ATT
            for (int rep = 0; rep < PROBE_ATT_REPS; ++rep)
            for (int v = F.bx; v < M / 256; v += F.G) { const int u = (F.G == 256) ? ((v & 7) * 32 + (v >> 3)) : v;
                att::attn_unit(F, u >> 5, (u & 31) * 256, L); }
#endif
            SEAM(base + 2);
        }
        if (IN(base + 3)) {
            LAUNDER();
            pg8::Gemm g{HB, (const bf16*)(wc + WC_OUT), M, D, D, 0}; pg8::TileOrder S; S.init(M, D, F.G, F.bx, nullptr);
            pg8::EpiResT<false> E{(L == 0) ? INP(0) : (const float*)nullptr, (bf16*)F.out, nullptr, D, 0, 1.0f};
            GEMM_SITE3(pg8::gemm_phase(F.lds, g, S, E, F.tid));
            SEAM(base + 3);
        }
        if (IN(base + 4)) {
            LAUNDER();
            RowPass P{}; P.xsrc = nullptr; P.xbf = (const bf16*)F.out; P.xdst = nullptr; P.combine = 0; P.gain = INP(9) + (size_t)L * D; P.ob = f8 ? nullptr : HB; P.obp = D; P.ssq = nullptr; P.ob8 = f8 ? (unsigned char*)(F.ws + WS_HB) : nullptr; P.of = nullptr; P.router = moe ? 1 : 0; P.wr = INP(13) + (size_t)fi * D * NE;
            phase_rows(F, P);
            if (PROBE_PE2) { __syncthreads(); phase_rows(F, P); }
            SEAM(base + 4);
        }
        if (moe && IN(base + 5)) { LAUNDER(); phase_moe_assign(F); SEAM(base + 5); }
        int nT = M / 256;
        if (moe && hi > base + 6 && lo < base + 16) nT = __builtin_amdgcn_readfirstlane(((const int*)(F.ws + WS_TEXP))[MAXTILES]);
        nT = nT < 0 ? 0 : (nT > MAXTILES ? MAXTILES : nT);
        const int ntail = (moe && nT > 2 * CHUNK_TILES) ? nT - 2 * CHUNK_TILES : 0;
        const int nsteps = !moe ? 2 : 4;
        for (int k = 0; k < nsteps; ++k) {
            const int pk = base + 6 + k;
            if (!IN(pk)) continue;
            LAUNDER();
            int dc = -1, uc = -1;
            if (!moe) { if (k == 0) uc = 0; else dc = 0; }
            else {
                if (k == 0) uc = 0; else if (k == 1) { dc = 0; uc = ntail ? 2 : -1; } else if (k == 2) { dc = ntail ? 2 : -1; uc = 1; } else dc = 1; }
            {
                __syncthreads();
                const int* tg = (const int*)(F.ws + WS_TEXP);
                for (int i = F.tid; i < MAXTILES + 8; i += 512) texp_l[i] = (moe && i < nT) ? tg[i] : 0;
                __syncthreads();
            }
#define CH_TILE0(ch) (moe ? (ch) * CHUNK_TILES : 0)
#define CH_NTILE(ch) (moe ? ((nT - CH_TILE0(ch)) < CHUNK_TILES ? (nT - CH_TILE0(ch)) : CHUNK_TILES) : M / 256)
#define CH_HID(ch) (moe ? ((ch) == 2 ? (bf16*)(F.ws + WS_MEMN4) : (bf16*)(F.ws + WS_HIDC)) : (bf16*)(F.ws + WS_BIG))
            if (dc >= 0) {
                const int tile0 = CH_TILE0(dc), ntile = CH_NTILE(dc); bf16* hid = CH_HID(dc);
                if (f8d) {
                    pg8::Gemm g{hid, moe ? (const bf16*)(F.ws + WS_WM + (size_t)fi * WM_STRIDE + WM_DOWN) : (const bf16*)(F.ws + WS_WD + (size_t)fi * WD_STRIDE + 14 * MiB), ntile * 256, D, FF / 2, WD8_ESTRIDE};
                    pg8::TileOrder S; S.init(ntile * 256, D, F.G, F.bx, texp_l + tile0);
                    pg8::EpiResT<true> E{nullptr, (bf16*)F.out, (bf16*)(F.ws + WS_GA) + (size_t)tile0 * 256 * D, D, moe ? 1 : 2, ACCD8_SCALE};
                    GEMM_SITE5(pg8::gemm_phase(F.lds, g, S, E, F.tid));
                } else {
                    pg8::Gemm g{hid, (const bf16*)(F.ws + WS_WD + (size_t)fi * WD_STRIDE + 14 * MiB), ntile * 256, D, FF, 0}; pg8::TileOrder S; S.init(ntile * 256, D, F.G, F.bx, texp_l + tile0);
                    pg8::EpiResT<false> E{nullptr, (bf16*)F.out, nullptr, D, 2, 1.0f};
                    GEMM_SITE7(pg8::gemm_phase(F.lds, g, S, E, F.tid));
                }
            }
            if (dc >= 0 && uc >= 0) { LAUNDER(); __syncthreads(); }
            if (uc >= 0) {
                const int tile0 = CH_TILE0(uc), ntile = CH_NTILE(uc); bf16* hid = CH_HID(uc);
                if (f8) {
                    pg8::Gemm g{moe ? (const bf16*)(F.ws + WS_GA8 + (size_t)tile0 * 256 * D) : (const bf16*)(F.ws + WS_HB),
                                moe ? (const bf16*)(F.ws + WS_WM + (size_t)fi * WM_STRIDE) : (const bf16*)(F.ws + WS_WD + (size_t)fi * WD_STRIDE), ntile * 256, 2 * FF, D / 2, (size_t)7 * MiB};
                    pg8::TileOrderSkew S; S.init(ntile * 256, 2 * FF, F.G, F.bx, texp_l + tile0);
                    const bool sk = moe && (dc == 2) && (ntile == F.G);
                    S.nsk = sk ? 4 * CH_NTILE(dc) : 0; S.kd = 3; S.per = 28;
                    pg8::EpiSwigluT<true> E{hid, ACC8_SCALE, f8d ? 0 : 1};
                    GEMM_SITE4(pg8::gemm_phase(F.lds, g, S, E, F.tid));
                } else {
                    pg8::Gemm g{HB, (const bf16*)(F.ws + WS_WD + (size_t)fi * WD_STRIDE), ntile * 256, 2 * FF, D, 0}; pg8::TileOrder S; S.init(ntile * 256, 2 * FF, F.G, F.bx, texp_l + tile0);
                    pg8::EpiSwigluT<false> E{hid, 1.0f, 1};
                    GEMM_SITE6(pg8::gemm_phase(F.lds, g, S, E, F.tid));
                }
            }
            SEAM(pk);
        }
    }
    if (IN(SEQ_FINAL)) {
        LAUNDER();
        RowPass P{}; P.xsrc = nullptr; P.xbf = (const bf16*)F.out; P.xdst = nullptr; P.combine = 1; P.gain = INP(17); P.ob = nullptr; P.obp = D; P.ssq = nullptr; P.of = F.out; P.router = 0; P.wr = nullptr;
        phase_rows(F, P);
    }
#undef IN
#undef SEAM
}

extern "C" void kernel_launch(void* const* d_in, const int* in_sizes, int n_in, void* d_out, int out_size, void* d_ws, size_t ws_size, hipStream_t stream) {
    static int grid = 0;
    if (grid == 0) {
        if (n_in != 18 || out_size != M * D || ws_size < WS_END) { fprintf(stderr, "kernel_launch: unexpected problem (n_in %d out %d ws %zu)\n", n_in, out_size, ws_size); grid = -1; return; }
        int dev = 0, cus = 0, per_cu = 0;
        if (hipGetDevice(&dev) != hipSuccess || hipDeviceGetAttribute(&cus, hipDeviceAttributeMultiprocessorCount, dev) != hipSuccess) { grid = -1; return; }
        if (hipFuncSetAttribute((const void*)fwd_kernel, hipFuncAttributeMaxDynamicSharedMemorySize, LDS_BYTES) != hipSuccess) { fprintf(stderr, "kernel_launch: hipFuncSetAttribute failed\n"); grid = -1; return; }
        if (hipOccupancyMaxActiveBlocksPerMultiprocessor(&per_cu, (const void*)fwd_kernel, NWAVES * 64, LDS_BYTES) != hipSuccess || per_cu < 1) fprintf(stderr, "kernel_launch: occupancy query says %d\n", per_cu);
        (void)hipGetLastError();
        grid = cus;
    }
    if (grid < 0) return;
    (void)hipMemsetAsync((char*)d_ws + WS_CTL, 0, CTL_ZERO_BYTES, stream);
    Args a{};
    for (int i = 0; i < 18; ++i) a.in[i] = (const float*)d_in[i];
    a.out = (float*)d_out; a.ws = (unsigned char*)d_ws; a.pad = 0;
#if MK_ONE_LAUNCH
    a.ph_lo = 0; a.ph_hi = SEQ_END; a.use_bar = 1;
    hipLaunchKernelGGL(fwd_kernel, dim3(grid), dim3(NWAVES * 64), LDS_BYTES, stream, a);
#else
    a.use_bar = 0;
#ifndef MAXSEQ
#define MAXSEQ 1000
#ifndef PROBE_ATT_REPS
#define PROBE_ATT_REPS 1
#endif
#ifndef PROBE_QKV_REPS
#define PROBE_QKV_REPS 1
#endif
#ifndef PROBE_CONV_REPS
#define PROBE_CONV_REPS 1
#endif
#endif
    auto run = [&](int k) { if (k >= MAXSEQ) return; a.ph_lo = k; a.ph_hi = k + 1; hipLaunchKernelGGL(fwd_kernel, dim3(grid), dim3(NWAVES * 64), LDS_BYTES, stream, a); };
    run(0);
    for (int L = 0; L < DEPTH; ++L) {
        const int base = 1 + L * PH_PER_LAYER; const bool moe = (L & 1) != 0;
        for (int k = 0; k < 5; ++k) run(base + k);
        if (moe) { run(base + 5); for (int c = 0; c < NCHUNK; ++c) { run(base + 6 + 2 * c); run(base + 7 + 2 * c); } }
        else { run(base + 6); run(base + 7); }
    }
    run(SEQ_FINAL);
#endif
}
```

```cpp
#include <hip/hip_runtime.h>
#include <cstdio>
#include <cstdint>

#ifndef MK_ONE_LAUNCH
#define MK_ONE_LAUNCH 1
#endif
#define MAXSEQ 1000
#ifndef PROBE_ATT_REPS
#define PROBE_ATT_REPS 1
#endif
#ifndef PROBE_QKV_REPS
#define PROBE_QKV_REPS 1
#endif
#ifndef DENSE_UP8_MASK
#define DENSE_UP8_MASK 5
#endif
#ifndef DENSE_DN8_MASK
#define DENSE_DN8_MASK 5
#endif
#define DENSE_UP8(L) (((DENSE_UP8_MASK) >> (L)) & 1)
#define DENSE_DN8(L) (((DENSE_DN8_MASK) >> (L)) & 1)
#ifndef QKV_FP8
#define QKV_FP8 0
#endif
#ifndef PROBE_BAR2
#define PROBE_BAR2 0
#endif
#ifndef PROBE_PE2
#define PROBE_PE2 0
#endif
#ifndef PROBE_SAMPLE
#define PROBE_SAMPLE 0
#endif
#ifndef PROBE_CONV_REPS
#define PROBE_CONV_REPS 1
#endif

#define GAS __attribute__((address_space(1)))
#define LAS __attribute__((address_space(3)))
typedef unsigned short bf16;
typedef short bf16x8 __attribute__((ext_vector_type(8)));
typedef float f32x4 __attribute__((ext_vector_type(4)));
typedef float f32x2 __attribute__((ext_vector_type(2)));
typedef unsigned u32x4 __attribute__((ext_vector_type(4)));
typedef unsigned u32x2 __attribute__((ext_vector_type(2)));
typedef short v4i16_t __attribute__((ext_vector_type(4)));

constexpr int BATCH = 8, T = 8192, D = 1024, M = BATCH * T, DEPTH = 4;
constexpr int NQKV = 2560, FF = 3584, NE = 8, NMEM = 256, MROWS = BATCH * NMEM;
constexpr int OFF_QA = 0, OFF_KA = 384, OFF_VA = 768, OFF_QB = 1152, OFF_KB = 1536, OFF_VB = 1920, OFF_QM = 2304;
constexpr float RMS_EPS = 1e-6f;
constexpr float LOG2E = 1.4426950408889634f;
constexpr float QSCALE = 0.125f * LOG2E;
constexpr int XP = 2 * D;
constexpr int NWAVES = 8;
constexpr int MAXTILES = 520;
constexpr int CHUNK_TILES = 256;
constexpr int NCHUNK = 5;

constexpr size_t MiB = 1u << 20;
constexpr size_t WS_CTL = 0, CTL_ZERO_BYTES = 1 * MiB;
constexpr size_t WS_COS = 2 * MiB, WS_SIN = 2 * MiB + 256 * 1024;
constexpr size_t WS_E01 = 4 * MiB;
constexpr size_t WS_GATE = 4 * MiB + 256 * 1024;
constexpr size_t WS_POS = 5 * MiB;
constexpr size_t WS_TCNT = 6 * MiB;
constexpr size_t WS_TEXP = 6 * MiB + 64 * 1024;
constexpr size_t WS_SSQ = 8 * MiB;
constexpr size_t WS_WC = 16 * MiB, WC_STRIDE = 8 * MiB;
constexpr size_t WC_IN = 0, WC_MKV = 5 * MiB, WC_OUT = 6 * MiB;
constexpr size_t WS_WD = 48 * MiB, WD_STRIDE = 21 * MiB;
constexpr size_t WS_WM = 90 * MiB, WM_STRIDE = 112 * MiB;
constexpr size_t WM_DOWN = 56 * MiB;
constexpr size_t WS_HB = 314 * MiB;
constexpr size_t WS_BIG = 442 * MiB;
constexpr size_t WS_GA = WS_BIG, WS_HIDC = WS_BIG + 260 * MiB;
constexpr size_t WS_GA8 = 926 * MiB;
constexpr size_t WS_MEMN4 = 1056 * MiB;
constexpr size_t WS_MEMKV4 = 1072 * MiB;
constexpr size_t WS_END = 1080 * MiB;
static_assert(WS_HIDC + (size_t)CHUNK_TILES * 256 * FF <= WS_GA8 && WS_BIG + (size_t)M * FF * 2 <= WS_GA8 && WS_GA8 + (size_t)MAXTILES * 256 * D <= WS_END, "ws map");
constexpr float A8_SCALE = 32.0f, W8_SCALE = 1024.0f, ACC8_SCALE = 1.0f / 32768.0f;
constexpr float H8_SCALE = 16.0f, WD8_SCALE = 4096.0f, ACCD8_SCALE = 1.0f / 65536.0f;
constexpr size_t WD8_ESTRIDE = (size_t)D * FF;

constexpr int CW_TMO = 0, CW_CODE = 1, CW_BAR = 4096;

constexpr int RING_BYTES = 131072;
constexpr int MISC_OFF = 139264;
constexpr int LDS_BYTES = 155648;
constexpr int MISC_BARW = 0;
constexpr int MISC_TEXP = 64;
constexpr int MISC_PTAB = 2560;
constexpr int MISC_SCR = 4096;

__device__ __forceinline__ float vmax2(float a, float b) { return __builtin_amdgcn_fmed3f(a, b, INFINITY); }
__device__ __forceinline__ float vmax3(float a, float b, float c) { return vmax2(vmax2(a, b), c); }
__device__ __forceinline__ float clamp8(float x) { return __builtin_amdgcn_fmed3f(x, -448.0f, 448.0f); }
__device__ __forceinline__ unsigned cvt4_fp8(float a, float b, float c, float d) {
    unsigned w = 0; w = __builtin_amdgcn_cvt_pk_fp8_f32(clamp8(a), clamp8(b), w, false); w = __builtin_amdgcn_cvt_pk_fp8_f32(clamp8(c), clamp8(d), w, true); return w; }
namespace pg8 {
#define PG8_LAS __attribute__((address_space(3)))
typedef unsigned short bf16_t;
constexpr int BM = 256, BK = 64, HALF = 128, HTB = HALF * BK * 2, STAGE_BYTES = 8 * HTB, NXCD = 8, WGM = 8;

__host__ __device__ __forceinline__ int lds_byte(int r, int c) { const int st = (r >> 4) * 2 + (c >> 5), rr = r & 15, cc = c & 31, ob = rr * 64 + cc * 2; return st * 1024 + (ob ^ (((ob >> 9) & 1) << 5)); }
__host__ __device__ __forceinline__ void stage_rc(int b, int& R, int& C) { const int st = b / 1024, sb = b % 1024, swz = sb ^ (((sb >> 9) & 1) << 5); R = (st >> 1) * 16 + swz / 64; C = (st & 1) * 32 + (swz % 64) / 2; }
__host__ __device__ __forceinline__ int perm32(int rho) { const int n = rho >> 4, i = rho & 15; return 8 * (i >> 2) + 4 * n + (i & 3); }

struct Unit { int pm, pn, e; };
struct Gemm { const bf16_t* A; const bf16_t* Bt; int M, N, K; size_t estride; };

struct TileOrder {
    int nM, nN, nwg, G, c; const PG8_LAS int* texp;
    __device__ void init(int Mr, int N, int G_, int c_, const PG8_LAS int* texp_) { nM = Mr / BM; nN = N / BM; nwg = nM * nN; G = G_; c = c_; texp = texp_; }
    __device__ bool next(int i, Unit& u) const {
        const long L = (long)i * G + c; if (L >= nwg) return false;
        int wgid = (int)L; { const int q = nwg / NXCD, r = nwg % NXCD, xcd = wgid % NXCD, off = wgid / NXCD; wgid = (xcd < r ? xcd * (q + 1) : r * (q + 1) + (xcd - r) * q) + off; }
        const int nig = WGM * nN, gid = wgid / nig, fm = gid * WGM, gsz = (nM - fm) < WGM ? (nM - fm) : WGM;
        u.pm = fm + ((wgid % nig) % gsz); u.pn = (wgid % nig) / gsz; u.e = texp ? __builtin_amdgcn_readfirstlane(texp[u.pm]) : 0; return true;
    }
};

struct TileOrderSkew : TileOrder {
    int nsk, kd, per;
    __device__ bool next(int i, Unit& u) const {
        int cc = c, ii = i;
        if (nsk > 0) {
            if (c < nsk) { if (i >= per - kd) return false; }
            else if (i == per) { const int S = (nsk + 7) & ~7, j = c / S - 1, c2 = c % S; if (c < S || j >= kd || c2 >= nsk) return false; cc = c2; ii = per - kd + j; }
            else if (i > per) return false;
        }
        const long L = (long)ii * G + cc; if (L >= nwg) return false;
        int wgid = (int)L; { const int q = nwg / NXCD, r = nwg % NXCD, xcd = wgid % NXCD, off = wgid / NXCD; wgid = (xcd < r ? xcd * (q + 1) : r * (q + 1) + (xcd - r) * q) + off; }
        const int nig = WGM * nN, gid = wgid / nig, fm = gid * WGM, gsz = (nM - fm) < WGM ? (nM - fm) : WGM;
        u.pm = fm + ((wgid % nig) % gsz); u.pn = (wgid % nig) / gsz; u.e = texp ? __builtin_amdgcn_readfirstlane(texp[u.pm]) : 0; return true;
    }
};

typedef int i32x8 __attribute__((ext_vector_type(8)));
typedef int i32x4 __attribute__((ext_vector_type(4)));
__device__ __forceinline__ i32x8 cat8(bf16x8 a, bf16x8 b) { const i32x4 x = __builtin_bit_cast(i32x4, a), y = __builtin_bit_cast(i32x4, b); return __builtin_shufflevector(x, y, 0, 1, 2, 3, 4, 5, 6, 7); }
__device__ __forceinline__ void mfma8(f32x4& acc, const i32x8 a, const i32x8 b) { int sc = 0x7f7f7f7f;
    asm volatile("v_mfma_scale_f32_16x16x128_f8f6f4 %0, %1, %2, %0, %3, %3 op_sel_hi:[0,0,0]" : "+v"(acc) : "v"(a), "v"(b), "v"(sc)); }
__device__ __forceinline__ unsigned cvt_pk_bf16(float lo, float hi) { unsigned r; asm volatile("v_cvt_pk_bf16_f32 %0, %1, %2" : "=v"(r) : "v"(lo), "v"(hi)); return r; }


struct EpiPlain {
    static constexpr bool PERM = true, FP8 = false; static constexpr int LDA = 0;
    bf16_t* O; int ldc;
    __device__ __forceinline__ void operator()(const f32x4 (&acc)[2][2][4][2], const Unit& u, int wr, int wc, int fr, int fq) const {
        const int row0 = u.pm * BM + wr * 64 + fr, col0 = u.pn * BM + wc * 32 + 8 * fq;
#pragma unroll
        for (int ai = 0; ai < 2; ++ai)
#pragma unroll
            for (int m = 0; m < 4; ++m) { bf16_t* rowp = O + (size_t)(row0 + ai * HALF + m * 16) * ldc + col0;
#pragma unroll
                for (int bj = 0; bj < 2; ++bj) { const f32x4 v0 = acc[ai][bj][m][0], v1 = acc[ai][bj][m][1];
                    u32x4 w; w.x = cvt_pk_bf16(v0[0], v0[1]); w.y = cvt_pk_bf16(v0[2], v0[3]); w.z = cvt_pk_bf16(v1[0], v1[1]); w.w = cvt_pk_bf16(v1[2], v1[3]);
                    *(u32x4*)(rowp + bj * HALF) = w; } }
    }
};
template <bool F8> struct EpiQKVT {
    static constexpr bool PERM = true, FP8 = F8; static constexpr int LDA = F8 ? 0 : XP;
    bf16_t* O; const float* cosT; const float* sinT; float insc;
    const float* ssq; int npart;
    __device__ __forceinline__ void operator()(const f32x4 (&acc)[2][2][4][2], const Unit& u, int wr, int wc, int fr, int fq) const {
        const int row0 = u.pm * BM + wr * 64 + fr, col0 = u.pn * BM + wc * 32 + 8 * fq;
        const bool lane_rot = ((wc & 1) == 0) && (fq < 2);
        float rsv[2][4];
        if (npart) {
            f32x4 pp[2][4];
#pragma unroll
            for (int ai = 0; ai < 2; ++ai)
#pragma unroll
                for (int m = 0; m < 4; ++m) pp[ai][m] = *(const f32x4*)(ssq + (size_t)(row0 + ai * HALF + m * 16) * 16 + 4 * fq);
#pragma unroll
            for (int ai = 0; ai < 2; ++ai)
#pragma unroll
                for (int m = 0; m < 4; ++m) { float sq = (pp[ai][m][0] + pp[ai][m][1]) + (pp[ai][m][2] + pp[ai][m][3]); sq += __shfl_xor(sq, 16); sq += __shfl_xor(sq, 32);
                    rsv[ai][m] = insc / sqrtf(sq * (1.0f / D) + RMS_EPS); }
        } else {
#pragma unroll
            for (int ai = 0; ai < 2; ++ai)
#pragma unroll
                for (int m = 0; m < 4; ++m) rsv[ai][m] = insc;
        }
        const bool anyrot = (u.pn >= 4) && (u.pn <= 7);
#pragma unroll
        for (int ai = 0; ai < 2; ++ai) {
            f32x4 rc[4], rn[4];
#pragma unroll
            for (int m = 0; m < 4; ++m) { rc[m] = (f32x4){0.f, 0.f, 0.f, 0.f}; rn[m] = rc[m]; }
            if (anyrot) {
#pragma unroll
                for (int m = 0; m < 4; ++m) { const int t = (row0 + ai * HALF + m * 16) & (T - 1); rc[m] = *(const f32x4*)(cosT + t * 8 + 4 * (fq & 1)); rn[m] = *(const f32x4*)(sinT + t * 8 + 4 * (fq & 1)); }
            }
#pragma unroll
            for (int m = 0; m < 4; ++m) {
                const int row = row0 + ai * HALF + m * 16;
                const float rs = rsv[ai][m];
#pragma unroll
                for (int bj = 0; bj < 2; ++bj) {
                    const int idx = 2 * u.pn + bj;
                    const float sc = ((idx < 3 || (idx >= 9 && idx < 12) || idx >= 18) ? QSCALE : 1.0f) * rs;
                    const bool rot = (idx >= 9 && idx < 15) && lane_rot;
                    f32x4 v0 = acc[ai][bj][m][0] * sc, v1 = acc[ai][bj][m][1] * sc;
                    if (rot) {
                        const f32x4 c = rc[m], s = rn[m];
                        f32x4 a, b;
                        a[0] = v0[0] * c[0] - v0[1] * s[0]; a[1] = v0[1] * c[0] + v0[0] * s[0];
                        a[2] = v0[2] * c[1] - v0[3] * s[1]; a[3] = v0[3] * c[1] + v0[2] * s[1];
                        b[0] = v1[0] * c[2] - v1[1] * s[2]; b[1] = v1[1] * c[2] + v1[0] * s[2];
                        b[2] = v1[2] * c[3] - v1[3] * s[3]; b[3] = v1[3] * c[3] + v1[2] * s[3];
                        v0 = a; v1 = b;
                    }
                    u32x4 w; w.x = cvt_pk_bf16(v0[0], v0[1]); w.y = cvt_pk_bf16(v0[2], v0[3]); w.z = cvt_pk_bf16(v1[0], v1[1]); w.w = cvt_pk_bf16(v1[2], v1[3]);
                    *(u32x4*)(O + (size_t)row * NQKV + col0 + bj * HALF) = w;
                }
            }
        }
    }
};
template <bool F8> struct EpiSwigluT {
    static constexpr bool PERM = true, FP8 = F8; static constexpr int LDA = 0;
    bf16_t* O; float insc; int out_bf16;
    __device__ __forceinline__ void operator()(const f32x4 (&acc)[2][2][4][2], const Unit& u, int wr, int wc, int fr, int fq) const {
        const int row0 = u.pm * BM + wr * 64 + fr, col0 = u.pn * HALF + wc * 32 + 8 * fq;
#pragma unroll
        for (int ai = 0; ai < 2; ++ai)
#pragma unroll
            for (int m = 0; m < 4; ++m) {
                float h[8];
#pragma unroll
                for (int n = 0; n < 2; ++n)
#pragma unroll
                    for (int j = 0; j < 4; ++j) { const float g = acc[ai][0][m][n][j] * insc, up = acc[ai][1][m][n][j] * insc;
                        const float sg = g * __builtin_amdgcn_rcpf(1.0f + __builtin_amdgcn_exp2f(-g * LOG2E)); h[4 * n + j] = sg * up; }
                if (F8 && !out_bf16) {
                    u32x2 w; w.x = cvt4_fp8(h[0] * H8_SCALE, h[1] * H8_SCALE, h[2] * H8_SCALE, h[3] * H8_SCALE); w.y = cvt4_fp8(h[4] * H8_SCALE, h[5] * H8_SCALE, h[6] * H8_SCALE, h[7] * H8_SCALE);
                    *(u32x2*)((unsigned char*)O + (size_t)(row0 + ai * HALF + m * 16) * FF + col0) = w;
                } else {
                    u32x4 w; w.x = cvt_pk_bf16(h[0], h[1]); w.y = cvt_pk_bf16(h[2], h[3]); w.z = cvt_pk_bf16(h[4], h[5]); w.w = cvt_pk_bf16(h[6], h[7]);
                    *(u32x4*)(O + (size_t)(row0 + ai * HALF + m * 16) * FF + col0) = w;
                }
            }
    }
};
template <bool F8> struct EpiResT {
    static constexpr bool PERM = false, FP8 = F8; static constexpr int LDA = 0;
    const float* src; bf16_t* xbf; bf16_t* ob; int ldc; int as_bf16; float insc;
    __device__ __forceinline__ void operator()(const f32x4 (&acc)[2][2][4][2], const Unit& u, int wr, int wc, int fr, int fq) const {
        const int row0 = u.pm * BM + wr * 64 + fr, col0 = u.pn * BM + wc * 32 + 4 * fq;
        float* ssqp = nullptr;
        if (as_bf16 == 2) {
            extern __shared__ __attribute__((aligned(16))) unsigned char lds_epi[];
            const unsigned long long v = ((const PG8_LAS unsigned long long*)((PG8_LAS unsigned char*)lds_epi + MISC_OFF + MISC_PTAB))[18];
            const unsigned lo = __builtin_amdgcn_readfirstlane((unsigned)v), hi = __builtin_amdgcn_readfirstlane((unsigned)(v >> 32));
            ssqp = (float*)((unsigned char*)(((unsigned long long)hi << 32) | lo) + WS_SSQ); }
        if (as_bf16 == 1) {
#pragma unroll
            for (int ai = 0; ai < 2; ++ai)
#pragma unroll
                for (int m = 0; m < 4; ++m) { bf16_t* rowp = ob + (size_t)(row0 + ai * HALF + m * 16) * ldc + col0;
#pragma unroll
                    for (int bj = 0; bj < 2; ++bj)
#pragma unroll
                        for (int n = 0; n < 2; ++n) { const f32x4 v = acc[ai][bj][m][n] * insc; u32x2 w; w.x = cvt_pk_bf16(v[0], v[1]); w.y = cvt_pk_bf16(v[2], v[3]); *(u32x2*)(rowp + bj * HALF + n * 16) = w; } }
        } else {
            auto fin = [&](int ai, int m, const f32x4 (&b)[2][2]) {
                const size_t xoff = (size_t)(row0 + ai * HALF + m * 16) * XP + col0; float ss = 0.f;
#pragma unroll
                for (int bj = 0; bj < 2; ++bj)
#pragma unroll
                    for (int n = 0; n < 2; ++n) { const f32x4 x = b[bj][n] + acc[ai][bj][m][n] * insc; u32x2 w; w.x = cvt_pk_bf16(x[0], x[1]); w.y = cvt_pk_bf16(x[2], x[3]);
                        ss += (x[0] * x[0] + x[1] * x[1]) + (x[2] * x[2] + x[3] * x[3]);
                        *(u32x2*)(xbf + xoff + bj * HALF + n * 16) = w; }
                if (ssqp) { ss += __shfl_xor(ss, 16); ss += __shfl_xor(ss, 32); if (fq == 0) ssqp[(size_t)(row0 + ai * HALF + m * 16) * 16 + 4 * u.pn + wc] = ss; }
            };
            if (src) {
#pragma unroll
                for (int ai = 0; ai < 2; ++ai) {
                    f32x4 rb[4][2][2];
#pragma unroll
                    for (int m = 0; m < 4; ++m)
#pragma unroll
                        for (int bj = 0; bj < 2; ++bj)
#pragma unroll
                            for (int n = 0; n < 2; ++n) rb[m][bj][n] = *(const f32x4*)(src + (size_t)(row0 + ai * HALF + m * 16) * ldc + col0 + bj * HALF + n * 16);
#pragma unroll
                    for (int m = 0; m < 4; ++m) fin(ai, m, rb[m]);
                    asm volatile("" ::: "memory");
                }
            } else {
#pragma unroll
                for (int ai = 0; ai < 2; ++ai) {
                    u32x2 rw[4][2][2];
#pragma unroll
                    for (int m = 0; m < 4; ++m)
#pragma unroll
                        for (int bj = 0; bj < 2; ++bj)
#pragma unroll
                            for (int n = 0; n < 2; ++n) rw[m][bj][n] = *(const u32x2*)(xbf + (size_t)(row0 + ai * HALF + m * 16) * XP + col0 + bj * HALF + n * 16);
#pragma unroll
                    for (int m = 0; m < 4; ++m) { f32x4 bb[2][2];
#pragma unroll
                        for (int bj = 0; bj < 2; ++bj)
#pragma unroll
                            for (int n = 0; n < 2; ++n) { const u32x2 w = rw[m][bj][n];
                                bb[bj][n] = (f32x4){__builtin_bit_cast(float, w.x << 16), __builtin_bit_cast(float, w.x & 0xffff0000u), __builtin_bit_cast(float, w.y << 16), __builtin_bit_cast(float, w.y & 0xffff0000u)}; }
                        fin(ai, m, bb); }
                    asm volatile("" ::: "memory");
                }
            }
        }
    }
};

template <class Epi, class Sched>
__device__ __forceinline__ void gemm_phase(PG8_LAS unsigned char* lds, const Gemm g, const Sched& S, const Epi& E, const int tid) {
    const int wid = __builtin_amdgcn_readfirstlane(tid >> 6), lane = tid & 63, wr = wid >> 2, wc = wid & 3, fr = lane & 15, fq = lane >> 4;
    const int K = g.K, nt = K / BK;
    const int LDA_ = Epi::LDA ? Epi::LDA : K;
    unsigned voffA[2], voffB[2];
#pragma unroll
    for (int i = 0; i < 2; ++i) { int R, C; stage_rc(tid * 16 + i * 8192, R, C); const int Rb = Epi::PERM ? ((R & ~31) + perm32(R & 31)) : R;
        voffA[i] = (unsigned)(R * LDA_ + C) * 2u; voffB[i] = (unsigned)(Rb * K + C) * 2u; }
    const size_t kstep = (size_t)(BK * 2);
    const size_t hstep = (size_t)HALF * K * 2;
    const size_t tstep = 2 * hstep;
    const size_t hstepA = (size_t)HALF * LDA_ * 2, tstepA = 2 * hstepA;
    const unsigned ldsw = (unsigned)wid * 1024u;
    const int aoff = lds_byte(wr * 64 + fr, fq * 8), boff = lds_byte(wc * 32 + fr, fq * 8);
#define PG8_SA(b, h) (((b) * 2 + (h)) * HTB)
#define PG8_SB(b, h) ((4 + (b) * 2 + (h)) * HTB)
#define PG8_STAGE(bufoff, gbase, voff) do { _Pragma("unroll") for (int _i = 0; _i < 2; ++_i) \
        __builtin_amdgcn_global_load_lds((const unsigned*)((const char*)(gbase) + (voff)[_i]), (PG8_LAS unsigned*)(lds + (bufoff) + ldsw + _i * 8192), 16, 0, 0); } while (0)
#define PG8_LDA(dst, b, h) do { _Pragma("unroll") for (int m = 0; m < 4; ++m) _Pragma("unroll") for (int k = 0; k < 2; ++k) dst[m][k] = *(const PG8_LAS bf16x8*)(lds + PG8_SA(b, h) + aoff + m * 2048 + k * 1024); } while (0)
#define PG8_LDB(dst, b, h) do { _Pragma("unroll") for (int n = 0; n < 2; ++n) _Pragma("unroll") for (int k = 0; k < 2; ++k) dst[n][k] = *(const PG8_LAS bf16x8*)(lds + PG8_SB(b, h) + boff + n * 2048 + k * 1024); } while (0)
#define PG8_MMA(ai, bj, At, Bt) do { __builtin_amdgcn_s_setprio(1); \
        if constexpr (Epi::FP8) { _Pragma("unroll") for (int m = 0; m < 4; ++m) _Pragma("unroll") for (int n = 0; n < 2; ++n) \
            mfma8(acc[ai][bj][m][n], cat8(Bt[n][0], Bt[n][1]), cat8(At[m][0], At[m][1])); } \
        else { _Pragma("unroll") for (int m = 0; m < 4; ++m) _Pragma("unroll") for (int n = 0; n < 2; ++n) _Pragma("unroll") for (int k = 0; k < 2; ++k) \
            acc[ai][bj][m][n] = __builtin_amdgcn_mfma_f32_16x16x32_bf16(Bt[n][k], At[m][k], acc[ai][bj][m][n], 0, 0, 0); } \
        __builtin_amdgcn_s_setprio(0); } while (0)
#define PG8_WAIT_V(n) asm volatile("s_waitcnt vmcnt(" #n ")" ::: "memory")
#define PG8_WAIT_L(n) asm volatile("s_waitcnt lgkmcnt(" #n ")" ::: "memory")
#define PG8_BAR __builtin_amdgcn_s_barrier()
#define PG8_SCHED __builtin_amdgcn_sched_barrier(0)
    Unit cur, nxt; int ui = 0;
    if (!S.next(0, cur)) return;
    f32x4 acc[2][2][4][2];
#pragma unroll
    for (int a = 0; a < 2; ++a)
#pragma unroll
        for (int b = 0; b < 2; ++b)
#pragma unroll
            for (int m = 0; m < 4; ++m)
#pragma unroll
                for (int n = 0; n < 2; ++n) acc[a][b][m][n] = (f32x4){0.f, 0.f, 0.f, 0.f};
    bf16x8 At[4][2], B0[2][2], B1[2][2];
    const char* cA = (const char*)g.A + (size_t)cur.pm * tstepA; const char* cB = (const char*)g.Bt + (size_t)cur.e * g.estride + (size_t)cur.pn * tstep;
    PG8_STAGE(PG8_SB(0, 0), cB, voffB); PG8_STAGE(PG8_SB(0, 1), cB + hstep, voffB); PG8_STAGE(PG8_SA(0, 0), cA, voffA); PG8_STAGE(PG8_SA(0, 1), cA + hstepA, voffA);
    if (wr == 1) PG8_BAR;
    PG8_WAIT_V(2); PG8_BAR;
    PG8_STAGE(PG8_SB(1, 0), cB + kstep, voffB); PG8_STAGE(PG8_SA(1, 0), cA + kstep, voffA); PG8_STAGE(PG8_SB(1, 1), cB + hstep + kstep, voffB);
    PG8_WAIT_V(6); PG8_BAR;
    for (;;) {
        const bool has_next = S.next(ui + 1, nxt);
        const char* nA = has_next ? (const char*)g.A + (size_t)nxt.pm * tstepA : cA; const char* nB = has_next ? (const char*)g.Bt + (size_t)nxt.e * g.estride + (size_t)nxt.pn * tstep : cB;
        for (int t = 0; t < nt; t += 2) {
            const bool last = (t == nt - 2);
            const char* a1 = cA + (size_t)(t + 1) * kstep;
            const char* a2 = last ? nA : cA + (size_t)(t + 2) * kstep; const char* b2 = last ? nB : cB + (size_t)(t + 2) * kstep;
            const char* a3 = a2 + kstep; const char* b3 = b2 + kstep;
            PG8_LDB(B0, 0, 0); PG8_LDB(B1, 0, 1); PG8_SCHED; PG8_LDA(At, 0, 0); PG8_STAGE(PG8_SA(1, 1), a1 + hstepA, voffA);
            PG8_WAIT_V(8); PG8_WAIT_L(0); PG8_BAR; PG8_MMA(0, 0, At, B0); PG8_MMA(0, 1, At, B1); PG8_BAR; PG8_SCHED;
            PG8_LDA(At, 0, 1); PG8_STAGE(PG8_SB(0, 0), b2, voffB); PG8_STAGE(PG8_SB(0, 1), b2 + hstep, voffB); PG8_STAGE(PG8_SA(0, 0), a2, voffA);
            PG8_WAIT_V(8); PG8_WAIT_L(0); PG8_BAR; PG8_MMA(1, 0, At, B0); PG8_MMA(1, 1, At, B1); PG8_BAR; PG8_SCHED;
            PG8_LDB(B0, 1, 0); PG8_LDB(B1, 1, 1); PG8_SCHED; PG8_LDA(At, 1, 0); PG8_STAGE(PG8_SA(0, 1), a2 + hstepA, voffA);
            PG8_WAIT_V(8); PG8_WAIT_L(0); PG8_BAR; PG8_MMA(0, 0, At, B0); PG8_MMA(0, 1, At, B1); PG8_BAR; PG8_SCHED;
            PG8_LDA(At, 1, 1); PG8_STAGE(PG8_SB(1, 0), b3, voffB); PG8_STAGE(PG8_SB(1, 1), b3 + hstep, voffB); PG8_STAGE(PG8_SA(1, 0), a3, voffA);
            PG8_WAIT_V(8); PG8_WAIT_L(0); PG8_BAR; PG8_MMA(1, 0, At, B0); PG8_MMA(1, 1, At, B1); PG8_BAR; PG8_SCHED;
        }
        if (wr == 0) PG8_BAR;
        if constexpr (Epi::FP8) {
#pragma unroll
            for (int a = 0; a < 2; ++a)
#pragma unroll
                for (int b = 0; b < 2; ++b)
                    asm volatile("s_nop 15\n\ts_nop 15" : "+v"(acc[a][b][0][0]), "+v"(acc[a][b][0][1]), "+v"(acc[a][b][1][0]), "+v"(acc[a][b][1][1]), "+v"(acc[a][b][2][0]), "+v"(acc[a][b][2][1]), "+v"(acc[a][b][3][0]), "+v"(acc[a][b][3][1]));
        }
        E(acc, cur, wr, wc, fr, fq);
        if (!has_next) break;
#pragma unroll
        for (int a = 0; a < 2; ++a)
#pragma unroll
            for (int b = 0; b < 2; ++b)
#pragma unroll
                for (int m = 0; m < 4; ++m)
#pragma unroll
                    for (int n = 0; n < 2; ++n) acc[a][b][m][n] = (f32x4){0.f, 0.f, 0.f, 0.f};
        cur = nxt; cA = nA; cB = nB; ++ui;
        if (wr == 1) PG8_BAR;
    }
    PG8_WAIT_V(0);
    PG8_BAR;
#undef PG8_SA
#undef PG8_SB
#undef PG8_STAGE
#undef PG8_LDA
#undef PG8_LDB
#undef PG8_MMA
#undef PG8_WAIT_V
#undef PG8_WAIT_L
#undef PG8_BAR
#undef PG8_SCHED
}
}

typedef GAS unsigned gu32;
#define RLX_AGENT __ATOMIC_RELAXED, __HIP_MEMORY_SCOPE_AGENT
#define LDS_WAIT() asm volatile("s_waitcnt lgkmcnt(0)" ::: "memory")
#define VM_WAIT() asm volatile("s_waitcnt vmcnt(0)" ::: "memory")
__device__ __forceinline__ unsigned f2bf(float f) { unsigned u = __builtin_bit_cast(unsigned, f); return (u + 0x7fffu + ((u >> 16) & 1u)) >> 16; }
__device__ __forceinline__ unsigned pk2(float lo, float hi) { return f2bf(lo) | (f2bf(hi) << 16); }
__device__ __forceinline__ float bf_lo(unsigned w) { return __builtin_bit_cast(float, w << 16); }
__device__ __forceinline__ float bf_hi(unsigned w) { return __builtin_bit_cast(float, w & 0xffff0000u); }

#define XB_TMO      128
#define XB_XCNT(j)  (256  + 64 * (j))
#define XB_XSUB(j)  (1280 + 64 * (j))
#define XB_XGEN(j)  (2304 + 64 * (j))
#define XB_TOP      3328
#define XB_TOPGEN   3392
#define XCD_BAR_WORDS 3456
#define XB_SPIN_CAP (1u << 18)

__device__ __forceinline__ unsigned xb_ld(unsigned* p)              { return __hip_atomic_load(p, __ATOMIC_RELAXED, __HIP_MEMORY_SCOPE_AGENT); }
__device__ __forceinline__ unsigned xb_add(unsigned* p, unsigned v) { return __hip_atomic_fetch_add(p, v, __ATOMIC_RELAXED, __HIP_MEMORY_SCOPE_AGENT); }
__device__ __forceinline__ unsigned xb_xcc_id() { return (unsigned)__builtin_amdgcn_s_getreg((3 << 11) | 20) & 0xFu; }
#define XB_SPIN(cond, bar) do { unsigned _sp = 0; while (cond) { __builtin_amdgcn_s_sleep(1); \
    if ((++_sp & 255u) == 0u) { if (xb_ld(&(bar)[XB_TMO])) break; if (_sp > XB_SPIN_CAP) { atomicAdd(&(bar)[XB_TMO], 1u); break; } } } } while (0)

struct XcdBarrier { unsigned* bar; unsigned x; volatile LAS unsigned* st; };

__device__ __forceinline__ XcdBarrier xcd_barrier_post(unsigned* bar, volatile LAS unsigned* st) {
    XcdBarrier b; b.bar = bar; b.x = xb_xcc_id(); b.st = st;
    if (threadIdx.x == 0) (void)xb_add(&bar[XB_XCNT(b.x)], 1u);
    return b;
}
__device__ __forceinline__ void xcd_barrier_complete(unsigned* bar, unsigned x, unsigned& nloc, unsigned& nx) {
    const unsigned G = gridDim.x * gridDim.y * gridDim.z;
    unsigned sum, cnt, mine, sp = 0u;
    for (;;) {
        sum = 0u; cnt = 0u; mine = 0u;
#pragma unroll
        for (unsigned j = 0; j < 16; ++j) { const unsigned c = xb_ld(&bar[XB_XCNT(j)]); sum += c; cnt += (c > 0u) ? 1u : 0u; mine = (j == x) ? c : mine; }
        if (sum == G) break;
        __builtin_amdgcn_s_sleep(1);
        if ((++sp & 255u) == 0u) { if (xb_ld(&bar[XB_TMO])) break; if (sp > XB_SPIN_CAP) { atomicAdd(&bar[XB_TMO], 1u); break; } }
    }
    nloc = mine > 0u ? mine : 1u; nx = cnt > 0u ? cnt : 1u;
}
__device__ __forceinline__ void xcd_barrier(const XcdBarrier& b) {
    asm volatile("s_waitcnt vmcnt(0)" ::: "memory");
    __syncthreads();
    if (threadIdx.x == 0) {
        unsigned* bar = b.bar;
        __builtin_amdgcn_s_waitcnt(0);
        unsigned nloc = b.st[0], nx = b.st[1];
        if (nloc == 0u) { xcd_barrier_complete(bar, b.x, nloc, nx); b.st[0] = nloc; b.st[1] = nx; }
        const unsigned old = xb_add(&bar[XB_XSUB(b.x)], 1u);
        const unsigned gen = old / nloc;
        if (old + 1u == (gen + 1u) * nloc) {
            __builtin_amdgcn_fence(__ATOMIC_RELEASE, "agent");
            asm volatile("s_waitcnt vmcnt(0)" ::: "memory");
            const unsigned og = xb_add(&bar[XB_TOP], 1u);
            const unsigned tg = og / nx;
            if (og + 1u == (tg + 1u) * nx) xb_add(&bar[XB_TOPGEN], 1u);
            else XB_SPIN(xb_ld(&bar[XB_TOPGEN]) == tg, bar);
            __builtin_amdgcn_fence(__ATOMIC_ACQUIRE, "agent");
            xb_add(&bar[XB_XGEN(b.x)], 1u);
            asm volatile("s_waitcnt vmcnt(0)" ::: "memory");
        } else {
            XB_SPIN(xb_ld(&bar[XB_XGEN(b.x)]) == gen, bar);
            __builtin_amdgcn_fence(__ATOMIC_ACQUIRE, "agent");
            asm volatile("s_waitcnt vmcnt(0)" ::: "memory");
        }
    }
    __syncthreads();
}

struct Frame {
    LAS unsigned char* lds;
    LAS unsigned char* misc;
    unsigned char* ws;
    int tid, lane, wave, G, bx;
    float* out;
};
__device__ __forceinline__ const float* inp_ptr(LAS unsigned char* misc, int i) {
    const unsigned long long v = ((const LAS unsigned long long*)(misc + MISC_PTAB))[i];
    const unsigned lo = __builtin_amdgcn_readfirstlane((unsigned)v), hi = __builtin_amdgcn_readfirstlane((unsigned)(v >> 32));
    return (const float*)(GAS const float*)(((unsigned long long)hi << 32) | lo);
}
#define INP(i) inp_ptr(F.misc, (i))

__device__ __forceinline__ void lds_add(LAS int* p, int v) { (void)__hip_atomic_fetch_add(p, v, __ATOMIC_RELAXED, __HIP_MEMORY_SCOPE_WORKGROUP); }
__device__ __forceinline__ float wave_sum(float v) {
#pragma unroll
    for (int o = 1; o < 64; o <<= 1) v += __shfl_xor(v, o);
    return v;
}

__device__ __forceinline__ int map_row(int n, int mode) {
    if (mode == 1) { if (n >= OFF_QB && n < OFF_VB) { const int d = (n - OFF_QB) & 63; if (d < 16) { const int dn = d < 8 ? 2 * d : 2 * (d - 8) + 1; return n - d + dn; } } return n; }
    if (mode == 2) return ((n >> 7) << 8) + (n & 127);
    if (mode == 3) return ((n >> 7) << 8) + 128 + (n & 127);
    return n;
}
template <bool F8>
__device__ __forceinline__ void convert_mat(const float* W, int K, int N, unsigned char* WT, int mode, float wscale, int& base, int gw, int NGW, int lane, const float* kgain = nullptr) {
    constexpr int KI = F8 ? 128 : 64;
    const int nblk = N >> 6, nitems = (K / KI) * nblk;
    int r = gw - (base % NGW); if (r < 0) r += NGW;
    base += nitems;
    const int q = lane >> 4, c4 = lane & 15;
#pragma nounroll
    for (; r < nitems; r += NGW) {
        const int kb = r / nblk, nb = r - kb * nblk, k0 = kb * KI, n = nb * 64 + 4 * c4;
        const GAS float* src = (const GAS float*)W + (size_t)k0 * N + n;
        size_t drow[4];
#pragma unroll
        for (int c = 0; c < 4; ++c) drow[c] = (size_t)map_row(n + c, mode) * K + k0;
#pragma nounroll
        for (int sgm = 0; sgm < 2; ++sgm) {
            f32x4 v[16];
            if (F8) {
                const int kq = 64 * sgm + 16 * q;
#pragma unroll
                for (int j = 0; j < 16; ++j) v[j] = *(const GAS f32x4*)(src + (size_t)(kq + j) * N) * wscale;
#pragma unroll
                for (int c = 0; c < 4; ++c) { u32x4 o; o.x = cvt4_fp8(v[0][c], v[1][c], v[2][c], v[3][c]); o.y = cvt4_fp8(v[4][c], v[5][c], v[6][c], v[7][c]);
                    o.z = cvt4_fp8(v[8][c], v[9][c], v[10][c], v[11][c]); o.w = cvt4_fp8(v[12][c], v[13][c], v[14][c], v[15][c]);
                    *(GAS u32x4*)(WT + drow[c] + kq) = o; }
            } else {
                const int kq = 32 * sgm + 8 * q;
#pragma unroll
                for (int j = 0; j < 8; ++j) v[j] = *(const GAS f32x4*)(src + (size_t)(kq + j) * N);
                if (kgain) {
#pragma unroll
                    for (int j = 0; j < 8; ++j) v[j] = v[j] * kgain[k0 + kq + j]; }
#pragma unroll
                for (int c = 0; c < 4; ++c) { u32x4 o; o.x = pk2(v[0][c], v[1][c]); o.y = pk2(v[2][c], v[3][c]); o.z = pk2(v[4][c], v[5][c]); o.w = pk2(v[6][c], v[7][c]);
                    *(GAS u32x4*)((bf16*)WT + drow[c] + kq) = o; }
            }
        }
    }
}
__device__ __forceinline__ void phase_convert(Frame& F) {
    const int gw = F.bx * NWAVES + F.wave, NGW = F.G * NWAVES;
    int base = 0;
#pragma nounroll
    for (int L = 0; L < DEPTH; ++L) { unsigned char* wc = F.ws + WS_WC + (size_t)L * WC_STRIDE;
#if QKV_FP8
        convert_mat<true>(INP(3) + (size_t)L * D * NQKV, D, NQKV, wc + WC_IN, 1, W8_SCALE, base, gw, NGW, F.lane);
#else
        convert_mat<false>(INP(3) + (size_t)L * D * NQKV, D, NQKV, wc + WC_IN, 1, 1.0f, base, gw, NGW, F.lane, INP(2) + (size_t)L * D);
#endif
        convert_mat<false>(INP(6) + (size_t)L * D * 512, D, 512, wc + WC_MKV, 0, 1.0f, base, gw, NGW, F.lane);
        convert_mat<false>(INP(8) + (size_t)L * D * D, D, D, wc + WC_OUT, 0, 1.0f, base, gw, NGW, F.lane); }
#pragma nounroll
    for (int i = 0; i < 2; ++i) { unsigned char* wd = F.ws + WS_WD + (size_t)i * WD_STRIDE;
        if (DENSE_UP8(2 * i)) { convert_mat<true>(INP(10) + (size_t)i * D * FF, D, FF, wd, 2, W8_SCALE, base, gw, NGW, F.lane); convert_mat<true>(INP(11) + (size_t)i * D * FF, D, FF, wd, 3, W8_SCALE, base, gw, NGW, F.lane); }
        else { convert_mat<false>(INP(10) + (size_t)i * D * FF, D, FF, wd, 2, 1.0f, base, gw, NGW, F.lane); convert_mat<false>(INP(11) + (size_t)i * D * FF, D, FF, wd, 3, 1.0f, base, gw, NGW, F.lane); }
        if (DENSE_DN8(2 * i)) convert_mat<true>(INP(12) + (size_t)i * FF * D, FF, D, wd + 14 * MiB, 0, WD8_SCALE, base, gw, NGW, F.lane);
        else convert_mat<false>(INP(12) + (size_t)i * FF * D, FF, D, wd + 14 * MiB, 0, 1.0f, base, gw, NGW, F.lane); }
#pragma nounroll
    for (int ie = 0; ie < 2 * NE; ++ie) { const int i = ie >> 3, e = ie & 7; unsigned char* wm = F.ws + WS_WM + (size_t)i * WM_STRIDE; const size_t eo = (size_t)ie * D * FF;
        convert_mat<true>(INP(14) + eo, D, FF, wm + (size_t)e * 7 * MiB, 2, W8_SCALE, base, gw, NGW, F.lane);
        convert_mat<true>(INP(15) + eo, D, FF, wm + (size_t)e * 7 * MiB, 3, W8_SCALE, base, gw, NGW, F.lane);
        convert_mat<true>(INP(16) + eo, FF, D, wm + WM_DOWN + (size_t)e * WD8_ESTRIDE, 0, WD8_SCALE, base, gw, NGW, F.lane); }
    float* cosT = (float*)(F.ws + WS_COS); float* sinT = (float*)(F.ws + WS_SIN);
    for (int idx = F.bx * 512 + F.tid; idx < T * 8; idx += F.G * 512) {
        const int t = idx >> 3, i = idx & 7;
        const double f = (i == 0) ? 0.15915494309189535 : (i == 1) ? 0.03086376340470123 : (i == 2) ? 0.005985185712713705 : (i == 3) ? 0.001160663641240061
                       : (i == 4) ? 0.00022507907903927653 : (i == 5) ? 4.364795279280289e-05 : (i == 6) ? 8.464330808241401e-06 : 1.6414262627950345e-06;
        double rev = (double)t * f; rev -= (double)(long long)rev;
        const float rf = (float)rev;
        cosT[idx] = __builtin_amdgcn_cosf(rf); sinT[idx] = __builtin_amdgcn_sinf(rf);
    }
}

struct RowPass {
    const float* xsrc; const bf16* xbf; bf16* xdst;
    const float* gain;
    bf16* ob; float* of;
    int obp; float* ssq;
    unsigned char* ob8;
    int combine;
    int router; const float* wr;
};
constexpr int RG = 2;
__device__ __forceinline__ void phase_rows(Frame& F, const RowPass P) {
    LAS float* wrl = (LAS float*)F.lds;
    LAS int* hist = (LAS int*)(F.misc + MISC_SCR);
    const bf16* YS = (const bf16*)(F.ws + WS_GA);
    const int* posg = (const int*)(F.ws + WS_POS); const float* gateg = (const float*)(F.ws + WS_GATE);
    int* e01g = (int*)(F.ws + WS_E01); float* gatew = (float*)(F.ws + WS_GATE); int* tcnt = (int*)(F.ws + WS_TCNT);
    if (P.router) { for (int i = F.tid; i < D * 8; i += 512) wrl[i] = P.wr[i]; }
    f32x4 gv[4];
#pragma unroll
    for (int j = 0; j < 4; ++j) gv[j] = *(const f32x4*)(P.gain + 4 * F.lane + 256 * j);
    const int tstart = (F.G == 256) ? ((F.bx & 7) * 32 + (F.bx >> 3)) : F.bx, tstride = (F.G == 256) ? M / 256 : F.G;
    for (int tile = tstart; tile < M / 256; tile += tstride) {
        if (P.router) { if (F.tid < 8) hist[F.tid] = 0; }
        __syncthreads();
        f32x4 buf[RG][4]; u32x2 bub[RG][4];
#pragma unroll
        for (int q = 0; q < RG; ++q) {
            if (P.xsrc) { const float* xr = P.xsrc + (size_t)(tile * 256 + F.wave * 32 + q) * D + 4 * F.lane;
#pragma unroll
                for (int j = 0; j < 4; ++j) buf[q][j] = *(const f32x4*)(xr + 256 * j); }
            else { const bf16* xr = P.xbf + (size_t)(tile * 256 + F.wave * 32 + q) * XP + 4 * F.lane;
#pragma unroll
                for (int j = 0; j < 4; ++j) bub[q][j] = *(const u32x2*)(xr + 256 * j); } }
#pragma nounroll
        for (int i0 = 0; i0 < 32; i0 += RG) {
            const int rowb = tile * 256 + F.wave * 32 + i0;
            f32x4 v[RG][4];
#pragma unroll
            for (int q = 0; q < RG; ++q)
#pragma unroll
                for (int j = 0; j < 4; ++j) v[q][j] = P.xsrc ? buf[q][j] : (f32x4){bf_lo(bub[q][j].x), bf_hi(bub[q][j].x), bf_lo(bub[q][j].y), bf_hi(bub[q][j].y)};
            if (i0 + RG < 32) {
#pragma unroll
                for (int q = 0; q < RG; ++q) {
                    if (P.xsrc) { const float* xr = P.xsrc + (size_t)(rowb + RG + q) * D + 4 * F.lane;
#pragma unroll
                        for (int j = 0; j < 4; ++j) buf[q][j] = *(const f32x4*)(xr + 256 * j); }
                    else { const bf16* xr = P.xbf + (size_t)(rowb + RG + q) * XP + 4 * F.lane;
#pragma unroll
                        for (int j = 0; j < 4; ++j) bub[q][j] = *(const u32x2*)(xr + 256 * j); } }
            }
#pragma unroll
            for (int q = 0; q < RG; ++q) {
                const int row = rowb + q;
                if (P.combine) {
                    const int p0 = posg[2 * row], p1 = posg[2 * row + 1]; const float g0 = gateg[2 * row], g1 = gateg[2 * row + 1];
                    const bf16* y0 = YS + (size_t)p0 * D + 4 * F.lane; const bf16* y1 = YS + (size_t)p1 * D + 4 * F.lane;
#pragma unroll
                    for (int j = 0; j < 4; ++j) { const u32x2 a = *(const u32x2*)(y0 + 256 * j), b = *(const u32x2*)(y1 + 256 * j);
                        v[q][j][0] += g0 * bf_lo(a.x) + g1 * bf_lo(b.x); v[q][j][1] += g0 * bf_hi(a.x) + g1 * bf_hi(b.x);
                        v[q][j][2] += g0 * bf_lo(a.y) + g1 * bf_lo(b.y); v[q][j][3] += g0 * bf_hi(a.y) + g1 * bf_hi(b.y); }
                }
                if (P.xdst) {
                    bf16* xw = P.xdst + (size_t)row * XP + 4 * F.lane;
#pragma unroll
                    for (int j = 0; j < 4; ++j) { u32x2 w; w.x = pk2(v[q][j][0], v[q][j][1]); w.y = pk2(v[q][j][2], v[q][j][3]); *(u32x2*)(xw + 256 * j) = w; }
                }
                float s = 0.f;
#pragma unroll
                for (int j = 0; j < 4; ++j) s += (v[q][j][0] * v[q][j][0] + v[q][j][1] * v[q][j][1]) + (v[q][j][2] * v[q][j][2] + v[q][j][3] * v[q][j][3]);
                const float wsum = wave_sum(s);
                if (P.ssq) { if (F.lane < 4) *(f32x4*)(P.ssq + (size_t)row * 16 + 4 * F.lane) = (f32x4){F.lane == 0 ? wsum : 0.f, 0.f, 0.f, 0.f}; }
                const float rstd = 1.0f / sqrtf(wsum * (1.0f / D) + RMS_EPS);
#pragma unroll
                for (int j = 0; j < 4; ++j) v[q][j] = v[q][j] * rstd * gv[j];
                if (P.ob) {
                    bf16* o = P.ob + (size_t)row * P.obp + 4 * F.lane;
#pragma unroll
                    for (int j = 0; j < 4; ++j) { u32x2 w; w.x = pk2(v[q][j][0], v[q][j][1]); w.y = pk2(v[q][j][2], v[q][j][3]); *(u32x2*)(o + 256 * j) = w; }
                }
                if (P.ob8) {
                    unsigned char* o = P.ob8 + (size_t)row * D + 4 * F.lane;
#pragma unroll
                    for (int j = 0; j < 4; ++j) *(unsigned*)(o + 256 * j) = cvt4_fp8(v[q][j][0] * A8_SCALE, v[q][j][1] * A8_SCALE, v[q][j][2] * A8_SCALE, v[q][j][3] * A8_SCALE);
                }
                if (P.of) {
                    float* o = P.of + (size_t)row * D + 4 * F.lane;
#pragma unroll
                    for (int j = 0; j < 4; ++j) *(f32x4*)(o + 256 * j) = v[q][j];
                }
            }
            if (P.router) {
                float lg[RG][8];
#pragma unroll
                for (int q = 0; q < RG; ++q)
#pragma unroll
                    for (int e = 0; e < 8; ++e) lg[q][e] = 0.f;
#pragma unroll
                for (int j = 0; j < 4; ++j)
#pragma unroll
                    for (int c = 0; c < 4; ++c) { const LAS f32x4* w = (const LAS f32x4*)(wrl + (4 * F.lane + 256 * j + c) * 8); const f32x4 w0 = w[0], w1 = w[1];
#pragma unroll
                        for (int q = 0; q < RG; ++q) { const float h = v[q][j][c];
                            lg[q][0] += h * w0[0]; lg[q][1] += h * w0[1]; lg[q][2] += h * w0[2]; lg[q][3] += h * w0[3]; lg[q][4] += h * w1[0]; lg[q][5] += h * w1[1]; lg[q][6] += h * w1[2]; lg[q][7] += h * w1[3]; } }
#pragma unroll
                for (int q = 0; q < RG; ++q) {
                    const int row = rowb + q;
#pragma unroll
                    for (int e = 0; e < 8; ++e) lg[q][e] = wave_sum(lg[q][e]);
                    int e0 = 0; float b0 = lg[q][0];
#pragma unroll
                    for (int e = 1; e < 8; ++e) if (lg[q][e] > b0) { b0 = lg[q][e]; e0 = e; }
                    int e1 = -1; float b1 = -INFINITY;
#pragma unroll
                    for (int e = 0; e < 8; ++e) if (e != e0 && lg[q][e] > b1) { b1 = lg[q][e]; e1 = e; }
                    if (e1 < 0) { e1 = (e0 + 1) & 7; b1 = b0; }
                    const float g0 = 1.0f / (1.0f + expf(b1 - b0));
                    if (F.lane == 0) { e01g[row] = e0 | (e1 << 8); gatew[2 * row] = g0; gatew[2 * row + 1] = 1.0f - g0; lds_add(&hist[e0], 1); lds_add(&hist[e1], 1); }
                }
            }
        }
        __syncthreads();
        if (P.router) { if (F.tid < 8) tcnt[tile * 8 + F.tid] = hist[F.tid]; }
    }
}
__device__ __forceinline__ void phase_memnorm(Frame& F) {
    const int gw = F.bx * NWAVES + F.wave, NGW = F.G * NWAVES;
    bf16* MN = (bf16*)(F.ws + WS_MEMN4);
    const float* memp = INP(1); const float* gbase = INP(5);
    for (int r = gw; r < DEPTH * MROWS; r += NGW) {
        const int L = r / MROWS, row = r - L * MROWS;
        const float* xr = memp + (size_t)row * D + 4 * F.lane; const float* gain = gbase + (size_t)L * D + 4 * F.lane;
        f32x4 v[4]; float s = 0.f;
#pragma unroll
        for (int j = 0; j < 4; ++j) { v[j] = *(const f32x4*)(xr + 256 * j); s += (v[j][0] * v[j][0] + v[j][1] * v[j][1]) + (v[j][2] * v[j][2] + v[j][3] * v[j][3]); }
        const float rstd = 1.0f / sqrtf(wave_sum(s) * (1.0f / D) + RMS_EPS);
        bf16* o = MN + (size_t)r * D + 4 * F.lane;
#pragma unroll
        for (int j = 0; j < 4; ++j) { const f32x4 y = v[j] * rstd * *(const f32x4*)(gain + 256 * j); u32x2 w; w.x = pk2(y[0], y[1]); w.y = pk2(y[2], y[3]); *(u32x2*)(o + 256 * j) = w; }
    }
}

__device__ __forceinline__ void phase_moe_assign(Frame& F) {
    LAS int* sc = (LAS int*)(F.misc + MISC_SCR);
    LAS int* dst = (LAS int*)(F.lds);
    const int* tcnt = (const int*)(F.ws + WS_TCNT); const int* e01g = (const int*)(F.ws + WS_E01);
    int* posg = (int*)(F.ws + WS_POS); int* texp = (int*)(F.ws + WS_TEXP);
    const unsigned char* HB8 = F.ws + WS_HB; unsigned char* GA8 = F.ws + WS_GA8;
    const int tstart = (F.G == 256) ? ((F.bx & 7) * 32 + (F.bx >> 3)) : F.bx, tstride = (F.G == 256) ? M / 256 : F.G;
    for (int tile = tstart; tile < M / 256; tile += tstride) {
        __syncthreads();
        if (F.tid < 80) sc[F.tid] = 0;
        __syncthreads();
        if (F.tid < 256) {
            const int j = F.tid;
#pragma unroll
            for (int e = 0; e < 8; ++e) { const int c = tcnt[j * 8 + e]; lds_add(&sc[e], c); if (j < tile) lds_add(&sc[8 + e], c); }
        }
        __syncthreads();
        if (F.tid == 0) { int ps = 0; for (int e = 0; e < 8; ++e) { sc[64 + e] = ps; sc[16 + e] = ps + sc[8 + e]; ps += (sc[e] + 255) & ~255; } sc[72] = ps; }
        __syncthreads();
        if (tile == 0 && F.tid < 8) {
            const int e = F.tid; const int t0 = sc[64 + e] >> 8, t1 = (e == 7 ? sc[72] : sc[64 + e + 1]) >> 8;
            for (int t = t0; t < t1; ++t) texp[t] = e;
            if (e == 7) texp[MAXTILES] = sc[72] >> 8;
        }
        int e0 = 0, e1 = 0, r0 = 0, r1 = 0;
        if (F.tid < 256) {
            const int w = F.tid >> 6; const int pk = e01g[tile * 256 + F.tid]; e0 = pk & 255; e1 = pk >> 8;
            const unsigned long long below = (1ull << F.lane) - 1ull;
#pragma unroll
            for (int e = 0; e < 8; ++e) {
                const unsigned long long m0 = __ballot(e0 == e), m1 = __ballot(e1 == e);
                const int rk = __popcll(m0 & below) + __popcll(m1 & below);
                if (e0 == e) r0 = rk; if (e1 == e) r1 = rk;
                if (F.lane == 0) sc[32 + w * 8 + e] = __popcll(m0) + __popcll(m1);
            }
        }
        __syncthreads();
        if (F.tid < 256) {
            const int w = F.tid >> 6; int b0 = sc[16 + e0], b1 = sc[16 + e1];
            for (int ww = 0; ww < w; ++ww) { b0 += sc[32 + ww * 8 + e0]; b1 += sc[32 + ww * 8 + e1]; }
            const int d0 = b0 + r0, d1 = b1 + r1;
            dst[2 * F.tid] = d0; dst[2 * F.tid + 1] = d1;
            posg[2 * (tile * 256 + F.tid)] = d0; posg[2 * (tile * 256 + F.tid) + 1] = d1;
        }
        __syncthreads();
#pragma nounroll
        for (int t0 = F.wave * 32; t0 < F.wave * 32 + 32; t0 += 16) {
            u32x4 v[16];
#pragma unroll
            for (int j = 0; j < 16; ++j) v[j] = ((const u32x4*)(HB8 + (size_t)(tile * 256 + t0 + j) * D))[F.lane];
#pragma unroll
            for (int j = 0; j < 16; ++j) { const int d0 = dst[2 * (t0 + j)], d1 = dst[2 * (t0 + j) + 1];
                ((u32x4*)(GA8 + (size_t)d0 * D))[F.lane] = v[j]; ((u32x4*)(GA8 + (size_t)d1 * D))[F.lane] = v[j]; }
        }
    }
}

namespace att {
constexpr int L_OS = 0, L_MS = 32768, L_LS = 33792, L_SSQ = 34816, L_RPB = 51200, L_KV = 62976, KV_WAVE = 8832, KT_BYTES = 4608;
static_assert(L_KV + 8 * KV_WAVE <= MISC_OFF, "attention LDS map");
__device__ __forceinline__ f32x4 mfma16(bf16x8 a, bf16x8 b, f32x4 c) { return __builtin_amdgcn_mfma_f32_16x16x32_bf16(a, b, c, 0, 0, 0); }
__device__ __forceinline__ v4i16_t vtr(const LAS unsigned char* p) { return __builtin_amdgcn_ds_read_tr16_b64_v4i16((LAS v4i16_t*)p); }

struct St { float m, lp; f32x4 o[4]; };
__device__ __forceinline__ void st_init(St& s) { s.m = -1e30f; s.lp = 0.f;
#pragma unroll
    for (int d = 0; d < 4; ++d) s.o[d] = (f32x4){0.f, 0.f, 0.f, 0.f}; }

struct Ld { u32x4 k0, k1, k2, k3, v0, v1, v2, v3; };
__device__ __forceinline__ void ld_issue8(Ld& L, const bf16* k0p, const bf16* k1p, const bf16* k2p, const bf16* k3p, const bf16* v0p, const bf16* v1p, const bf16* v2p, const bf16* v3p) {
    L.k0 = *(const u32x4*)(k0p); L.k1 = *(const u32x4*)(k1p); L.k2 = *(const u32x4*)(k2p); L.k3 = *(const u32x4*)(k3p);
    L.v0 = *(const u32x4*)(v0p); L.v1 = *(const u32x4*)(v1p); L.v2 = *(const u32x4*)(v2p); L.v3 = *(const u32x4*)(v3p);
}
__device__ __forceinline__ void ld_issue(Ld& L, const bf16* kp, const bf16* vp, size_t r8) { ld_issue8(L, kp, kp + r8, kp + 2 * r8, kp + 3 * r8, vp, vp + r8, vp + 2 * r8, vp + 3 * r8); }
constexpr int VPL = 1056;
struct Kf { bf16x8 k00, k01, k10, k11; };
__device__ __forceinline__ void stage_kv(const Ld& L, LAS unsigned char* kvl, int lane) {
    LAS unsigned char* kw = kvl + (lane >> 3) * 144 + (lane & 7) * 16;
    *(LAS u32x4*)(kw) = L.k0; *(LAS u32x4*)(kw + 1152) = L.k1; *(LAS u32x4*)(kw + 2304) = L.k2; *(LAS u32x4*)(kw + 3456) = L.k3;
    const int c = lane & 7; LAS unsigned char* vw = kvl + KT_BYTES + (c >> 1) * VPL + (lane >> 3) * 32 + (c & 1) * 16;
    *(LAS u32x4*)(vw) = L.v0; *(LAS u32x4*)(vw + 256) = L.v1; *(LAS u32x4*)(vw + 512) = L.v2; *(LAS u32x4*)(vw + 768) = L.v3;
}
__device__ __forceinline__ Kf kf_read(const LAS unsigned char* kvl, int lq, int lg) {
    const LAS unsigned char* p = kvl + lq * 144 + lg * 16; Kf k;
    k.k00 = *(const LAS bf16x8*)(p); k.k01 = *(const LAS bf16x8*)(p + 64); k.k10 = *(const LAS bf16x8*)(p + 16 * 144); k.k11 = *(const LAS bf16x8*)(p + 16 * 144 + 64); return k;
}
__device__ __forceinline__ void qk(const Kf& L, const bf16x8 (&q)[2], f32x4& s0, f32x4& s1) {
    const f32x4 z = (f32x4){0.f, 0.f, 0.f, 0.f};
    s0 = mfma16(L.k00, q[0], z); s0 = mfma16(L.k01, q[1], s0); s1 = mfma16(L.k10, q[0], z); s1 = mfma16(L.k11, q[1], s1);
}
__device__ __forceinline__ void soft_pv(f32x4 s0, f32x4 s1, const LAS unsigned char* vl, int lq, int lg, St& S) {
    const float mx = vmax2(vmax3(s0[0], s0[1], s0[2]), vmax3(vmax3(s0[3], s1[0], s1[1]), s1[2], s1[3]));
    if (__any(mx > S.m + 8.0f)) {
        float mf = vmax2(mx, __shfl_xor(mx, 16)); mf = vmax2(mf, __shfl_xor(mf, 32));
        const float mn = vmax2(S.m, mf); const float alpha = __builtin_amdgcn_exp2f(S.m - mn); S.m = mn;
        S.lp *= alpha;
#pragma unroll
        for (int d = 0; d < 4; ++d) S.o[d] = S.o[d] * alpha;
    }
    const float mn = S.m;
    float p[8];
#pragma unroll
    for (int r = 0; r < 4; ++r) { p[r] = __builtin_amdgcn_exp2f(s0[r] - mn); p[4 + r] = __builtin_amdgcn_exp2f(s1[r] - mn); }
    S.lp += ((p[0] + p[1]) + (p[2] + p[3])) + ((p[4] + p[5]) + (p[6] + p[7]));
    u32x4 pw; pw.x = pg8::cvt_pk_bf16(p[0], p[1]); pw.y = pg8::cvt_pk_bf16(p[2], p[3]); pw.z = pg8::cvt_pk_bf16(p[4], p[5]); pw.w = pg8::cvt_pk_bf16(p[6], p[7]);
    const bf16x8 pf = __builtin_bit_cast(bf16x8, pw);
    const LAS unsigned char* tb = vl + KT_BYTES + (4 * lg + (lq >> 2)) * 32 + 8 * (lq & 3);
#pragma unroll
    for (int d = 0; d < 4; ++d) {
        const v4i16_t lo = vtr(tb + d * VPL), hi = vtr(tb + d * VPL + 512);
        const bf16x8 vf = (bf16x8){lo[0], lo[1], lo[2], lo[3], hi[0], hi[1], hi[2], hi[3]};
        S.o[d] = mfma16(vf, pf, S.o[d]);
    }
}
template <int NT>
__device__ __forceinline__ void multi_soft_pv(f32x4 (&s0)[NT], f32x4 (&s1)[NT], const LAS unsigned char* vl, int lq, int lg, St (&S)[NT], const int am = -1) {
    float mx[NT]; bool trig = false;
#pragma unroll
    for (int t = 0; t < NT; ++t) if (am & (1 << t)) { mx[t] = vmax2(vmax3(s0[t][0], s0[t][1], s0[t][2]), vmax3(vmax3(s0[t][3], s1[t][0], s1[t][1]), s1[t][2], s1[t][3])); trig = trig || (mx[t] > S[t].m + 8.0f); }
    if (__any(trig)) {
#pragma unroll
        for (int t = 0; t < NT; ++t) if (am & (1 << t)) {
            float mf = vmax2(mx[t], __shfl_xor(mx[t], 16)); mf = vmax2(mf, __shfl_xor(mf, 32));
            const float mn = vmax2(S[t].m, mf); const float alpha = __builtin_amdgcn_exp2f(S[t].m - mn); S[t].m = mn; S[t].lp *= alpha;
#pragma unroll
            for (int d = 0; d < 4; ++d) S[t].o[d] = S[t].o[d] * alpha;
        }
    }
    bf16x8 pf[NT];
#pragma unroll
    for (int t = 0; t < NT; ++t) if (am & (1 << t)) {
        const float mn = S[t].m; float p[8];
#pragma unroll
        for (int r = 0; r < 4; ++r) { p[r] = __builtin_amdgcn_exp2f(s0[t][r] - mn); p[4 + r] = __builtin_amdgcn_exp2f(s1[t][r] - mn); }
        S[t].lp += ((p[0] + p[1]) + (p[2] + p[3])) + ((p[4] + p[5]) + (p[6] + p[7]));
        u32x4 pw; pw.x = pg8::cvt_pk_bf16(p[0], p[1]); pw.y = pg8::cvt_pk_bf16(p[2], p[3]); pw.z = pg8::cvt_pk_bf16(p[4], p[5]); pw.w = pg8::cvt_pk_bf16(p[6], p[7]);
        pf[t] = __builtin_bit_cast(bf16x8, pw);
    }
    const LAS unsigned char* tb = vl + KT_BYTES + (4 * lg + (lq >> 2)) * 32 + 8 * (lq & 3);
#pragma unroll
    for (int d = 0; d < 4; ++d) {
        const v4i16_t lo = vtr(tb + d * VPL), hi = vtr(tb + d * VPL + 512);
        const bf16x8 vf = (bf16x8){lo[0], lo[1], lo[2], lo[3], hi[0], hi[1], hi[2], hi[3]};
#pragma unroll
        for (int t = 0; t < NT; ++t) if (am & (1 << t)) S[t].o[d] = mfma16(vf, pf[t], S[t].o[d]);
    }
}
__device__ __forceinline__ float lsum(float lp) { lp += __shfl_xor(lp, 16); lp += __shfl_xor(lp, 32); return lp; }

__device__ __forceinline__ void finish(const St& S, float l, bf16* yrow  , LAS float* ssq_slot, int lg) {
    const float inv = 1.0f / l; float ss = 0.f;
#pragma unroll
    for (int d = 0; d < 4; ++d) { const f32x4 v = S.o[d] * inv; ss += (v[0] * v[0] + v[1] * v[1]) + (v[2] * v[2] + v[3] * v[3]);
        u32x2 w; w.x = pg8::cvt_pk_bf16(v[0], v[1]); w.y = pg8::cvt_pk_bf16(v[2], v[3]); *(u32x2*)(yrow + 16 * d + 4 * lg) = w; }
    ss += __shfl_xor(ss, 16); ss += __shfl_xor(ss, 32);
    if (lg == 0) *ssq_slot = ss;
}

__device__ __forceinline__ void attn_unit(Frame& F, int b, int t0, int layer) {
    LAS unsigned char* lds = F.lds;
    int lane = F.lane, lq = lane & 15, lg = lane >> 4; const int wave = F.wave;
#define RELANE() do { asm volatile("" : "+v"(lane)); lq = lane & 15; lg = lane >> 4; } while (0)
    const bf16* QKV = (const bf16*)(F.ws + WS_BIG); const bf16* MKV = (const bf16*)(F.ws + WS_MEMKV4) + (size_t)layer * MROWS * 512; bf16* Y = (bf16*)(F.ws + WS_HB);
    LAS bf16* Os = (LAS bf16*)(lds + L_OS); LAS float* Ms = (LAS float*)(lds + L_MS); LAS float* Ls = (LAS float*)(lds + L_LS);
    LAS float* ssq = (LAS float*)(lds + L_SSQ); LAS float* rpb = (LAS float*)(lds + L_RPB);
    LAS unsigned char* vl = lds + L_KV + wave * KV_WAVE;
    const size_t rowb = (size_t)b * T;
    { const float* rp = INP(4) + (size_t)layer * 6 * 465; for (int i = F.tid; i < 6 * 480; i += 512) { const int hh = i / 480, rem = i - hh * 480, ro = rem >> 5, co = rem & 31; rpb[i] = co < 31 ? rp[hh * 465 + ro * 31 + co] * LOG2E : -INFINITY; } }
    __syncthreads();
    const int R0 = t0 >> 6;
#pragma nounroll
    for (int pass = 0; pass < 3; ++pass) {
        RELANE();
        const int h = 2 * pass + (wave >> 2), kq = wave & 3;
        const int qc = 16 * kq + lq, cs = (kq == 0) ? 0 : (kq == 1) ? 8 : (kq == 2) ? 24 : 32;
        int c0q = qc - 8; c0q = c0q < 0 ? 0 : (c0q > 48 ? 48 : c0q);
        unsigned bcol[8];
#pragma unroll
        for (int e = 0; e < 8; ++e) { const int c = cs + 16 * (e >> 2) + 4 * lg + (e & 3); const bool ok = (c >= c0q) && (c <= c0q + 15);
            bcol[e] = (unsigned)(uintptr_t)(rpb + h * 480) + 4u * (unsigned)(ok ? (c - qc + 15) : 31); }
        int r0v[4]; bf16x8 qf[4][2]; St S[4];
#pragma unroll
        for (int rr = 0; rr < 4; ++rr) { const int r = R0 + rr; int r0 = r - 4; r0 = r0 < 0 ? 0 : (r0 > 120 ? 120 : r0); r0v[rr] = r0;
            const size_t qrow = rowb + (size_t)r * 64 + qc;
            qf[rr][0] = *(const bf16x8*)(QKV + qrow * NQKV + OFF_QA + h * 64 + lg * 8); qf[rr][1] = *(const bf16x8*)(QKV + qrow * NQKV + OFF_QA + h * 64 + 32 + lg * 8);
            st_init(S[rr]); }
        const int krmin = r0v[0], nrows = r0v[3] + 8 - krmin;
        const bf16* kbase = QKV + (rowb + (size_t)krmin * 64 + cs + (lane >> 3)) * NQKV + OFF_KA + h * 64 + (lane & 7) * 8;
        const bf16* vbase = kbase + (OFF_VA - OFF_KA);
        const size_t v8 = (size_t)8 * NQKV;
        const size_t rstep = (size_t)64 * NQKV;
        auto na_row = [&](int kr) {
            const Kf kf = kf_read(vl, lq, lg);
            f32x4 s0[4], s1[4];
            int am = 0;
#pragma unroll
            for (int rr = 0; rr < 4; ++rr) am |= (kr >= r0v[rr] && kr < r0v[rr] + 8) ? (1 << rr) : 0;
            am = __builtin_amdgcn_readfirstlane(am);
#pragma unroll
            for (int rr = 0; rr < 4; ++rr) if (am & (1 << rr)) {
                const unsigned ro = (unsigned)(kr - (R0 + rr) + 7) * 128u;
                f32x4 a0, a1;
#pragma unroll
                for (int e = 0; e < 4; ++e) { a0[e] = *(const LAS float*)(uintptr_t)(bcol[e] + ro); a1[e] = *(const LAS float*)(uintptr_t)(bcol[4 + e] + ro); }
                qk(kf, qf[rr], s0[rr], s1[rr]);
                s0[rr] = s0[rr] + a0; s1[rr] = s1[rr] + a1;
            }
            multi_soft_pv<4>(s0, s1, vl, lq, lg, S, am);
            asm volatile("" ::: "memory");
        };
        Ld LA;
        ld_issue(LA, kbase, vbase, v8);
#pragma nounroll
        for (int j = 0; j < nrows; ++j) {
            stage_kv(LA, vl, lane);
            asm volatile("" ::: "memory");
            { const int jn = (j + 1 < nrows) ? j + 1 : nrows - 1; ld_issue(LA, kbase + (size_t)jn * rstep, vbase + (size_t)jn * rstep, v8); }
            na_row(krmin + j);
        }
#pragma unroll
        for (int rr = 0; rr < 4; ++rr) { const float l = lsum(S[rr].lp);
            finish(S[rr], l, Y + (rowb + (size_t)(R0 + rr) * 64 + qc) * D + h * 64, ssq + h * 256 + (rr * 64 + qc), lg); }
    }
#pragma nounroll
    for (int pass = 0; pass < 2; ++pass) {
        RELANE();
        const int h = 2 * pass + (wave >> 2), j0 = 4 * (wave & 3);
        bf16x8 qf[4][2]; St S[4];
#pragma unroll
        for (int t = 0; t < 4; ++t) { const size_t qrow = rowb + t0 + 16 * (j0 + t) + lq;
            qf[t][0] = *(const bf16x8*)(QKV + qrow * NQKV + OFF_QM + h * 64 + lg * 8); qf[t][1] = *(const bf16x8*)(QKV + qrow * NQKV + OFF_QM + h * 64 + 32 + lg * 8);
            st_init(S[t]); }
        const bf16* kbase = MKV + ((size_t)b * NMEM + (lane >> 3)) * 512 + h * 64 + (lane & 7) * 8;
        const bf16* vbase = kbase + 256;
        Ld LA;
        ld_issue(LA, kbase, vbase, (size_t)8 * 512);
#pragma nounroll
        for (int s = 0; s < 8; ++s) {
            stage_kv(LA, vl, lane);
            asm volatile("" ::: "memory");
            { const int sn = (s + 1 < 8) ? s + 1 : 7; ld_issue(LA, kbase + sn * 32 * 512, vbase + sn * 32 * 512, (size_t)8 * 512); }
            const Kf kf = kf_read(vl, lq, lg);
            f32x4 s0[4], s1[4];
#pragma unroll
            for (int t = 0; t < 4; ++t) qk(kf, qf[t], s0[t], s1[t]);
            multi_soft_pv<4>(s0, s1, vl, lq, lg, S);
            asm volatile("" ::: "memory");
        }
#pragma unroll
        for (int t = 0; t < 4; ++t) { const int idx = 16 * (j0 + t) + lq; const float l = lsum(S[t].lp);
            finish(S[t], l, Y + (rowb + t0 + idx) * D + 768 + h * 64, ssq + (12 + h) * 256 + idx, lg); }
    }
    __syncthreads();
    for (int h = 0; h < 6; ++h) {
#pragma nounroll
        for (int br = 0; br < 2; ++br) {
            RELANE();
            const int sh = 2 * br, dl = 1 << sh, seg = T >> sh;
            const int res = br ? (wave >> 1) : 0, m0 = br ? ((t0 >> 2) + 32 * (wave & 1)) : (t0 + 32 * wave);
            bf16x8 qf[2][2]; St S[2]; int idxv[2];
#pragma unroll
            for (int t = 0; t < 2; ++t) { const size_t qrow = rowb + (size_t)(m0 + 16 * t + lq) * dl + res;
                qf[t][0] = *(const bf16x8*)(QKV + qrow * NQKV + OFF_QB + h * 64 + lg * 8); qf[t][1] = *(const bf16x8*)(QKV + qrow * NQKV + OFF_QB + h * 64 + 32 + lg * 8);
                st_init(S[t]); idxv[t] = br ? (128 * (wave & 1) + 64 * t + 4 * lq + res) : (32 * wave + 16 * t + lq); }
            const bool edge = (m0 - 64 < 0) || (m0 + 95 >= seg);
            auto dload = [&](Ld& L, int s) {
                const int kb = m0 - 64 + 32 * s;
                int kv = kb + (lane >> 3);
                const bf16* kcol = QKV + (rowb + res) * NQKV + OFF_KB + h * 64 + (lane & 7) * 8; const bf16* vcol = kcol + (OFF_VB - OFF_KB);
                const size_t rs = (size_t)dl * NQKV;
                if (edge) {
                    int v0 = kv, v1 = kv + 8, v2 = kv + 16, v3 = kv + 24;
                    v0 = v0 < 0 ? 0 : (v0 >= seg ? seg - 1 : v0); v1 = v1 < 0 ? 0 : (v1 >= seg ? seg - 1 : v1); v2 = v2 < 0 ? 0 : (v2 >= seg ? seg - 1 : v2); v3 = v3 < 0 ? 0 : (v3 >= seg ? seg - 1 : v3);
                    ld_issue8(L, kcol + (size_t)v0 * rs, kcol + (size_t)v1 * rs, kcol + (size_t)v2 * rs, kcol + (size_t)v3 * rs, vcol + (size_t)v0 * rs, vcol + (size_t)v1 * rs, vcol + (size_t)v2 * rs, vcol + (size_t)v3 * rs);
                } else ld_issue(L, kcol + (size_t)kv * rs, vcol + (size_t)kv * rs, 8 * rs); };
            auto dstep = [&](int s) {
                const Kf kf = kf_read(vl, lq, lg);
                const int kb = m0 - 64 + 32 * s;
                f32x4 s0[2], s1[2];
#pragma unroll
                for (int t = 0; t < 2; ++t) {
                    qk(kf, qf[t], s0[t], s1[t]);
                    if (edge || s == 0 || s == 4) {
                        const int qm = m0 + 16 * t + lq;
#pragma unroll
                        for (int e = 0; e < 8; ++e) { const int km = kb + 16 * (e >> 2) + 4 * lg + (e & 3); const int dd = km - qm;
                            const bool ok = (km >= 0) && (km < seg) && (dd >= -64) && (dd <= 64); if (!ok) { if (e < 4) s0[t][e] = -INFINITY; else s1[t][e - 4] = -INFINITY; } }
                    }
                }
                multi_soft_pv<2>(s0, s1, vl, lq, lg, S);
                asm volatile("" ::: "memory");
            };
            { Ld LA;
              dload(LA, 0);
#pragma nounroll
              for (int s = 0; s < 5; ++s) {
                  stage_kv(LA, vl, lane);
                  asm volatile("" ::: "memory");
                  dload(LA, s + 1 < 5 ? s + 1 : 4);
                  dstep(s);
              } }
#pragma unroll
            for (int t = 0; t < 2; ++t) {
                const int idx = idxv[t]; float l = lsum(S[t].lp);
                LAS u32x2* osr = (LAS u32x2*)(Os + idx * 64 + 4 * lg);
                if (br > 0) {
                    const float m1 = Ms[idx], l1 = Ls[idx]; const float mn = vmax2(S[t].m, m1);
                    const float a1 = __builtin_amdgcn_exp2f(m1 - mn), a2 = __builtin_amdgcn_exp2f(S[t].m - mn);
#pragma unroll
                    for (int d = 0; d < 4; ++d) { const u32x2 w = osr[4 * d]; const f32x4 o1 = (f32x4){bf_lo(w.x), bf_hi(w.x), bf_lo(w.y), bf_hi(w.y)}; S[t].o[d] = o1 * a1 + S[t].o[d] * a2; }
                    l = l1 * a1 + l * a2; S[t].m = mn;
                }
#pragma unroll
                for (int d = 0; d < 4; ++d) { u32x2 w; w.x = pg8::cvt_pk_bf16(S[t].o[d][0], S[t].o[d][1]); w.y = pg8::cvt_pk_bf16(S[t].o[d][2], S[t].o[d][3]); osr[4 * d] = w; }
                if (lg == 0) { Ms[idx] = S[t].m; Ls[idx] = l; }
            }
            __syncthreads();
        }
        {
            constexpr int dl = 16, seg = T >> 4;
#pragma nounroll
            for (int tix = wave; tix < 16; tix += 8) {
                RELANE();
                const int res = tix, m0 = t0 >> 4, idx = 16 * lq + res;
                const size_t qrow = rowb + (size_t)(m0 + lq) * dl + res;
                bf16x8 qf[2];
                qf[0] = *(const bf16x8*)(QKV + qrow * NQKV + OFF_QB + h * 64 + lg * 8); qf[1] = *(const bf16x8*)(QKV + qrow * NQKV + OFF_QB + h * 64 + 32 + lg * 8);
                St S; st_init(S);
                const int qm = m0 + lq;
                const bool edge = (m0 - 64 < 0) || (m0 + 95 >= seg);
                auto dload = [&](Ld& L, int s) {
                    const int kb = m0 - 64 + 32 * s;
                    int kv = kb + (lane >> 3);
                    const bf16* kcol = QKV + (rowb + res) * NQKV + OFF_KB + h * 64 + (lane & 7) * 8; const bf16* vcol = kcol + (OFF_VB - OFF_KB);
                    const size_t rs = (size_t)dl * NQKV;
                    if (edge) {
                        int v0 = kv, v1 = kv + 8, v2 = kv + 16, v3 = kv + 24;
                        v0 = v0 < 0 ? 0 : (v0 >= seg ? seg - 1 : v0); v1 = v1 < 0 ? 0 : (v1 >= seg ? seg - 1 : v1); v2 = v2 < 0 ? 0 : (v2 >= seg ? seg - 1 : v2); v3 = v3 < 0 ? 0 : (v3 >= seg ? seg - 1 : v3);
                        ld_issue8(L, kcol + (size_t)v0 * rs, kcol + (size_t)v1 * rs, kcol + (size_t)v2 * rs, kcol + (size_t)v3 * rs, vcol + (size_t)v0 * rs, vcol + (size_t)v1 * rs, vcol + (size_t)v2 * rs, vcol + (size_t)v3 * rs);
                    } else ld_issue(L, kcol + (size_t)kv * rs, vcol + (size_t)kv * rs, 8 * rs); };
                auto dstep = [&](int s) {
                    const Kf kf = kf_read(vl, lq, lg);
                    const int kb = m0 - 64 + 32 * s;
                    f32x4 s0, s1; qk(kf, qf, s0, s1);
                    if (edge || s == 0 || s == 4) {
#pragma unroll
                        for (int e = 0; e < 8; ++e) { const int km = kb + 16 * (e >> 2) + 4 * lg + (e & 3); const int dd = km - qm;
                            const bool ok = (km >= 0) && (km < seg) && (dd >= -64) && (dd <= 64); if (!ok) { if (e < 4) s0[e] = -INFINITY; else s1[e - 4] = -INFINITY; } }
                    }
                    soft_pv(s0, s1, vl, lq, lg, S);
                    asm volatile("" ::: "memory");
                };
                { Ld LA;
                  dload(LA, 0);
#pragma nounroll
                  for (int s = 0; s < 5; ++s) {
                      stage_kv(LA, vl, lane);
                      asm volatile("" ::: "memory");
                      dload(LA, s + 1 < 5 ? s + 1 : 4);
                      dstep(s);
                  } }
                float l = lsum(S.lp);
                LAS u32x2* osr = (LAS u32x2*)(Os + idx * 64 + 4 * lg);
                { const float m1 = Ms[idx], l1 = Ls[idx]; const float mn = vmax2(S.m, m1);
                  const float a1 = __builtin_amdgcn_exp2f(m1 - mn), a2 = __builtin_amdgcn_exp2f(S.m - mn);
#pragma unroll
                  for (int d = 0; d < 4; ++d) { const u32x2 w = osr[4 * d]; const f32x4 o1 = (f32x4){bf_lo(w.x), bf_hi(w.x), bf_lo(w.y), bf_hi(w.y)}; S.o[d] = o1 * a1 + S.o[d] * a2; }
                  l = l1 * a1 + l * a2; S.m = mn; }
                finish(S, l, Y + qrow * D + 384 + h * 64, ssq + (6 + h) * 256 + idx, lg);
            }
            __syncthreads();
        }
    }
    VM_WAIT(); __syncthreads();
    RELANE();
    {
        const float* gm = INP(7) + (size_t)layer * D;
        const int c0 = 8 * lane, c1 = 512 + 8 * lane;
        const int g0 = c0 < 384 ? 0 : 1, g1 = c1 < 768 ? 1 : 2;
        f32x4 ga[2], gb[2];
        ga[0] = *(const f32x4*)(gm + c0); ga[1] = *(const f32x4*)(gm + c0 + 4); gb[0] = *(const f32x4*)(gm + c1); gb[1] = *(const f32x4*)(gm + c1 + 4);
#pragma nounroll
        for (int i0 = 0; i0 < 32; i0 += 4) {
            u32x4 w0[4], w1[4]; float s0v[4], s1v[4];
#pragma unroll
            for (int q = 0; q < 4; ++q) { const bf16* yr = Y + (rowb + t0 + wave * 32 + i0 + q) * D; w0[q] = *(const u32x4*)(yr + c0); w1[q] = *(const u32x4*)(yr + c1); }
#pragma unroll
            for (int q = 0; q < 4; ++q) {
                const int idx = wave * 32 + i0 + q;
                float sa = 0.f, sb = 0.f, sm = 0.f;
#pragma unroll
                for (int hh = 0; hh < 6; ++hh) { sa += ssq[hh * 256 + idx]; sb += ssq[(6 + hh) * 256 + idx]; }
#pragma unroll
                for (int hh = 0; hh < 4; ++hh) sm += ssq[(12 + hh) * 256 + idx];
                const float ra = 1.0f / sqrtf(sa * (1.0f / 384.f) + RMS_EPS), rb = 1.0f / sqrtf(sb * (1.0f / 384.f) + RMS_EPS), rm = 1.0f / sqrtf(sm * (1.0f / 256.f) + RMS_EPS);
                s0v[q] = g0 == 0 ? ra : rb; s1v[q] = g1 == 1 ? rb : rm;
            }
#pragma unroll
            for (int q = 0; q < 4; ++q) {
                bf16* yr = Y + (rowb + t0 + wave * 32 + i0 + q) * D; const float s0 = s0v[q], s1 = s1v[q]; const u32x4 a = w0[q], bb = w1[q];
                u32x4 o0, o1;
                o0.x = pk2(bf_lo(a.x) * s0 * ga[0][0], bf_hi(a.x) * s0 * ga[0][1]); o0.y = pk2(bf_lo(a.y) * s0 * ga[0][2], bf_hi(a.y) * s0 * ga[0][3]);
                o0.z = pk2(bf_lo(a.z) * s0 * ga[1][0], bf_hi(a.z) * s0 * ga[1][1]); o0.w = pk2(bf_lo(a.w) * s0 * ga[1][2], bf_hi(a.w) * s0 * ga[1][3]);
                o1.x = pk2(bf_lo(bb.x) * s1 * gb[0][0], bf_hi(bb.x) * s1 * gb[0][1]); o1.y = pk2(bf_lo(bb.y) * s1 * gb[0][2], bf_hi(bb.y) * s1 * gb[0][3]);
                o1.z = pk2(bf_lo(bb.z) * s1 * gb[1][0], bf_hi(bb.z) * s1 * gb[1][1]); o1.w = pk2(bf_lo(bb.w) * s1 * gb[1][2], bf_hi(bb.w) * s1 * gb[1][3]);
                *(u32x4*)(yr + c0) = o0; *(u32x4*)(yr + c1) = o1;
            }
        }
    }
    __syncthreads();
}
}

#ifdef NO_G1
#define GEMM_SITE1(x)
#else
#define GEMM_SITE1(x) x
#endif
#ifdef NO_G2
#define GEMM_SITE2(x)
#else
#define GEMM_SITE2(x) x
#endif
#ifdef NO_G3
#define GEMM_SITE3(x)
#else
#define GEMM_SITE3(x) x
#endif
#ifdef NO_G4
#define GEMM_SITE4(x)
#else
#define GEMM_SITE4(x) x
#endif
#ifdef NO_G5
#define GEMM_SITE5(x)
#else
#define GEMM_SITE5(x) x
#endif
#ifdef NO_G6
#define GEMM_SITE6(x)
#else
#define GEMM_SITE6(x) x
#endif
#ifdef NO_G7
#define GEMM_SITE7(x)
#else
#define GEMM_SITE7(x) x
#endif
struct Args { const float* in[18]; float* out; unsigned char* ws; int ph_lo, ph_hi, use_bar, pad; };
constexpr int PH_PER_LAYER = 16, SEQ_FINAL = 1 + DEPTH * PH_PER_LAYER, SEQ_END = SEQ_FINAL + 1;

__global__ void __launch_bounds__(NWAVES * 64, 2) fwd_kernel(Args args) {
    extern __shared__ __attribute__((aligned(16))) unsigned char lds_raw[];
    Frame F;
    F.lds = (LAS unsigned char*)lds_raw; F.misc = F.lds + MISC_OFF;
    F.tid = threadIdx.x; F.lane = F.tid & 63; F.wave = __builtin_amdgcn_readfirstlane(F.tid >> 6);
    F.G = gridDim.x; F.bx = blockIdx.x; F.ws = args.ws; F.out = args.out;
    if (F.tid == 0) {
#pragma unroll
        for (int i = 0; i < 18; ++i) ((LAS unsigned long long*)(F.misc + MISC_PTAB))[i] = (unsigned long long)args.in[i];
        ((LAS unsigned long long*)(F.misc + MISC_PTAB))[18] = (unsigned long long)args.ws; ((LAS unsigned long long*)(F.misc + MISC_PTAB))[19] = (unsigned long long)args.out;
    }
    gu32* ctl = (gu32*)(F.ws + WS_CTL);
    if (F.tid < 4) ((LAS unsigned*)(F.misc + MISC_BARW))[F.tid] = 0u;
    __syncthreads();
    XcdBarrier bar; bar.bar = (unsigned*)(ctl + CW_BAR); bar.x = 0; bar.st = nullptr;
    if (args.use_bar) { bar = xcd_barrier_post((unsigned*)(ctl + CW_BAR), (volatile LAS unsigned*)(F.misc + MISC_BARW)); if (F.tid == 0) ((volatile LAS unsigned*)(F.misc + MISC_BARW))[2] = bar.x; __syncthreads(); }
    const int lo = args.ph_lo, hi = args.ph_hi;
#define IN(k) (lo <= (k) && (k) < hi)
#define LAUNDER() do { unsigned lb_ = (unsigned)(uintptr_t)(LAS unsigned char*)lds_raw; asm volatile("" : "+v"(lb_)); lb_ = (unsigned)__builtin_amdgcn_readfirstlane((int)lb_); F.lds = (LAS unsigned char*)(uintptr_t)lb_; F.misc = F.lds + MISC_OFF; \
    F.ws = (unsigned char*)inp_ptr(F.misc, 18); F.out = (float*)inp_ptr(F.misc, 19); asm volatile("" : "+v"(F.tid), "+v"(F.lane)); F.wave = __builtin_amdgcn_readfirstlane(F.tid >> 6); \
    { int bx_ = F.bx, g_ = F.G; asm volatile("" : "+v"(bx_), "+v"(g_)); F.bx = __builtin_amdgcn_readfirstlane(bx_); F.G = __builtin_amdgcn_readfirstlane(g_); } } while (0)
#define SEAM(k) do { if (args.use_bar && (k) + 1 < hi) { XcdBarrier b_; b_.bar = (unsigned*)((unsigned char*)inp_ptr(F.misc, 18) + WS_CTL) + CW_BAR; b_.st = (volatile LAS unsigned*)(F.misc + MISC_BARW); \
        b_.x = (unsigned)__builtin_amdgcn_readfirstlane((int)((volatile LAS unsigned*)(F.misc + MISC_BARW))[2]); xcd_barrier(b_); if (PROBE_BAR2) xcd_barrier(b_); } else { VM_WAIT(); __syncthreads(); } } while (0)

#define HB ((bf16*)(F.ws + WS_HB))
#define QKV ((bf16*)(F.ws + WS_BIG))
    LAS int* texp_l = (LAS int*)(F.misc + MISC_TEXP);

    if (IN(0)) { LAUNDER(); for (int rep = 0; rep < PROBE_CONV_REPS; ++rep) phase_convert(F);
        if (!(args.use_bar && hi > 2)) SEAM(0); }


    for (int L = 0; L < DEPTH; ++L) {
        const int base = 1 + L * PH_PER_LAYER;
        if (hi <= base || lo >= base + PH_PER_LAYER) continue;
        const bool moe = (L & 1) != 0; const int fi = L >> 1;
        const bool f8 = moe || DENSE_UP8(L), f8d = moe || DENSE_DN8(L);
#define wc (F.ws + WS_WC + (size_t)L * WC_STRIDE)
        const int comb = (L > 0 && ((L - 1) & 1)) ? 1 : 0;
        if (IN(base + 0) && (L == 0 || comb)) {
            LAUNDER();
            RowPass P{}; P.xsrc = (L == 0) ? INP(0) : (const float*)nullptr; P.xbf = (const bf16*)F.out; P.combine = comb; P.xdst = (bf16*)F.out; P.gain = INP(2) + (size_t)L * D;
            P.ob = nullptr; P.obp = XP; P.ssq = (float*)(F.ws + WS_SSQ); P.ob8 = nullptr; P.of = nullptr; P.router = 0; P.wr = nullptr;
            phase_rows(F, P);
            if (L == 0) phase_memnorm(F);
            SEAM(base + 0);
        }
        if (IN(base + 1)) {
            LAUNDER();
#if QKV_FP8
            { pg8::Gemm g{HB, (const bf16*)(wc + WC_IN), M, NQKV, D / 2, 0}; pg8::TileOrder S; S.init(M, NQKV, F.G, F.bx, nullptr);
              pg8::EpiQKVT<true> E{QKV, (const float*)(F.ws + WS_COS), (const float*)(F.ws + WS_SIN), ACC8_SCALE};
              GEMM_SITE1(pg8::gemm_phase(F.lds, g, S, E, F.tid)); }
#else
            { pg8::Gemm g{(const bf16*)F.out, (const bf16*)(wc + WC_IN), M, NQKV, D, 0}; pg8::TileOrder S; S.init(M, NQKV, F.G, F.bx, nullptr);
              pg8::EpiQKVT<false> E{QKV, (const float*)(F.ws + WS_COS), (const float*)(F.ws + WS_SIN), 1.0f, (const float*)(F.ws + WS_SSQ), 1};
              GEMM_SITE1(pg8::gemm_phase(F.lds, g, S, E, F.tid)); }
#endif
            if (L == 0) {
                LAUNDER();
                __syncthreads();
                for (int i = F.tid; i < MAXTILES + 8; i += 512) texp_l[i] = i >> 3;
                __syncthreads();
                pg8::Gemm g{(const bf16*)(F.ws + WS_MEMN4), (const bf16*)(F.ws + WS_WC + WC_MKV), DEPTH * MROWS, 512, D, WC_STRIDE}; pg8::TileOrder S; S.init(DEPTH * MROWS, 512, F.G, F.bx, texp_l);
                pg8::EpiPlain E{(bf16*)(F.ws + WS_MEMKV4), 512};
                GEMM_SITE2(pg8::gemm_phase(F.lds, g, S, E, F.tid));
            }
            SEAM(base + 1);
        }
        if (IN(base + 2)) {
            LAUNDER();
#ifndef NO_ATT
            for (int rep = 0; rep < PROBE_ATT_REPS; ++rep)
            for (int v = F.bx; v < M / 256; v += F.G) { const int u = (F.G == 256) ? ((v & 7) * 32 + (v >> 3)) : v;
                att::attn_unit(F, u >> 5, (u & 31) * 256, L); }
#endif
            SEAM(base + 2);
        }
        if (IN(base + 3)) {
            LAUNDER();
            pg8::Gemm g{HB, (const bf16*)(wc + WC_OUT), M, D, D, 0}; pg8::TileOrder S; S.init(M, D, F.G, F.bx, nullptr);
            pg8::EpiResT<false> E{(const float*)nullptr, (bf16*)F.out, nullptr, D, 0, 1.0f};
            GEMM_SITE3(pg8::gemm_phase(F.lds, g, S, E, F.tid));
            SEAM(base + 3);
        }
        if (IN(base + 4)) {
            LAUNDER();
            RowPass P{}; P.xsrc = nullptr; P.xbf = (const bf16*)F.out; P.xdst = nullptr; P.combine = 0; P.gain = INP(9) + (size_t)L * D; P.ob = f8 ? nullptr : HB; P.obp = D; P.ssq = nullptr; P.ob8 = f8 ? (unsigned char*)(F.ws + WS_HB) : nullptr; P.of = nullptr; P.router = moe ? 1 : 0; P.wr = INP(13) + (size_t)fi * D * NE;
            phase_rows(F, P);
            if (PROBE_PE2) { __syncthreads(); phase_rows(F, P); }
            SEAM(base + 4);
        }
        if (moe && IN(base + 5)) { LAUNDER(); phase_moe_assign(F); SEAM(base + 5); }
        int nT = M / 256;
        if (moe && hi > base + 6 && lo < base + 16) nT = __builtin_amdgcn_readfirstlane(((const int*)(F.ws + WS_TEXP))[MAXTILES]);
        nT = nT < 0 ? 0 : (nT > MAXTILES ? MAXTILES : nT);
        const int ntail = (moe && nT > 2 * CHUNK_TILES) ? nT - 2 * CHUNK_TILES : 0;
        const int nsteps = !moe ? 2 : 4;
        for (int k = 0; k < nsteps; ++k) {
            const int pk = base + 6 + k;
            if (!IN(pk)) continue;
            LAUNDER();
            int dc = -1, uc = -1;
            if (!moe) { if (k == 0) uc = 0; else dc = 0; }
            else {
                if (k == 0) uc = 0; else if (k == 1) { dc = 0; uc = ntail ? 2 : -1; } else if (k == 2) { dc = ntail ? 2 : -1; uc = 1; } else dc = 1; }
            {
                __syncthreads();
                const int* tg = (const int*)(F.ws + WS_TEXP);
                for (int i = F.tid; i < MAXTILES + 8; i += 512) texp_l[i] = (moe && i < nT) ? tg[i] : 0;
                __syncthreads();
            }
#define CH_TILE0(ch) (moe ? (ch) * CHUNK_TILES : 0)
#define CH_NTILE(ch) (moe ? ((nT - CH_TILE0(ch)) < CHUNK_TILES ? (nT - CH_TILE0(ch)) : CHUNK_TILES) : M / 256)
#define CH_HID(ch) (moe ? ((ch) == 2 ? (bf16*)(F.ws + WS_MEMN4) : (bf16*)(F.ws + WS_HIDC)) : (bf16*)(F.ws + WS_BIG))
            if (dc >= 0) {
                const int tile0 = CH_TILE0(dc), ntile = CH_NTILE(dc); bf16* hid = CH_HID(dc);
                if (f8d) {
                    pg8::Gemm g{hid, moe ? (const bf16*)(F.ws + WS_WM + (size_t)fi * WM_STRIDE + WM_DOWN) : (const bf16*)(F.ws + WS_WD + (size_t)fi * WD_STRIDE + 14 * MiB), ntile * 256, D, FF / 2, WD8_ESTRIDE};
                    pg8::TileOrder S; S.init(ntile * 256, D, F.G, F.bx, texp_l + tile0);
                    pg8::EpiResT<true> E{nullptr, (bf16*)F.out, (bf16*)(F.ws + WS_GA) + (size_t)tile0 * 256 * D, D, moe ? 1 : 2, ACCD8_SCALE};
                    GEMM_SITE5(pg8::gemm_phase(F.lds, g, S, E, F.tid));
                } else {
                    pg8::Gemm g{hid, (const bf16*)(F.ws + WS_WD + (size_t)fi * WD_STRIDE + 14 * MiB), ntile * 256, D, FF, 0}; pg8::TileOrder S; S.init(ntile * 256, D, F.G, F.bx, texp_l + tile0);
                    pg8::EpiResT<false> E{nullptr, (bf16*)F.out, nullptr, D, 2, 1.0f};
                    GEMM_SITE7(pg8::gemm_phase(F.lds, g, S, E, F.tid));
                }
            }
            if (dc >= 0 && uc >= 0) { LAUNDER(); __syncthreads(); }
            if (uc >= 0) {
                const int tile0 = CH_TILE0(uc), ntile = CH_NTILE(uc); bf16* hid = CH_HID(uc);
                if (f8) {
                    pg8::Gemm g{moe ? (const bf16*)(F.ws + WS_GA8 + (size_t)tile0 * 256 * D) : (const bf16*)(F.ws + WS_HB),
                                moe ? (const bf16*)(F.ws + WS_WM + (size_t)fi * WM_STRIDE) : (const bf16*)(F.ws + WS_WD + (size_t)fi * WD_STRIDE), ntile * 256, 2 * FF, D / 2, (size_t)7 * MiB};
                    pg8::TileOrderSkew S; S.init(ntile * 256, 2 * FF, F.G, F.bx, texp_l + tile0);
                    const bool sk = moe && (dc == 2) && (ntile == F.G);
                    S.nsk = sk ? 4 * CH_NTILE(dc) : 0; S.kd = 3; S.per = 28;
                    pg8::EpiSwigluT<true> E{hid, ACC8_SCALE, f8d ? 0 : 1};
                    GEMM_SITE4(pg8::gemm_phase(F.lds, g, S, E, F.tid));
                } else {
                    pg8::Gemm g{HB, (const bf16*)(F.ws + WS_WD + (size_t)fi * WD_STRIDE), ntile * 256, 2 * FF, D, 0}; pg8::TileOrder S; S.init(ntile * 256, 2 * FF, F.G, F.bx, texp_l + tile0);
                    pg8::EpiSwigluT<false> E{hid, 1.0f, 1};
                    GEMM_SITE6(pg8::gemm_phase(F.lds, g, S, E, F.tid));
                }
            }
            SEAM(pk);
        }
    }
    if (IN(SEQ_FINAL)) {
        LAUNDER();
        RowPass P{}; P.xsrc = nullptr; P.xbf = (const bf16*)F.out; P.xdst = nullptr; P.combine = 1; P.gain = INP(17); P.ob = nullptr; P.obp = D; P.ssq = nullptr; P.of = F.out; P.router = 0; P.wr = nullptr;
        phase_rows(F, P);
    }
#undef IN
#undef SEAM
}

extern "C" void kernel_launch(void* const* d_in, const int* in_sizes, int n_in, void* d_out, int out_size, void* d_ws, size_t ws_size, hipStream_t stream) {
    static int grid = 0;
    if (grid == 0) {
        if (n_in != 18 || out_size != M * D || ws_size < WS_END) { fprintf(stderr, "kernel_launch: unexpected problem (n_in %d out %d ws %zu)\n", n_in, out_size, ws_size); grid = -1; return; }
        int dev = 0, cus = 0, per_cu = 0;
        if (hipGetDevice(&dev) != hipSuccess || hipDeviceGetAttribute(&cus, hipDeviceAttributeMultiprocessorCount, dev) != hipSuccess) { grid = -1; return; }
        if (hipFuncSetAttribute((const void*)fwd_kernel, hipFuncAttributeMaxDynamicSharedMemorySize, LDS_BYTES) != hipSuccess) { fprintf(stderr, "kernel_launch: hipFuncSetAttribute failed\n"); grid = -1; return; }
        if (hipOccupancyMaxActiveBlocksPerMultiprocessor(&per_cu, (const void*)fwd_kernel, NWAVES * 64, LDS_BYTES) != hipSuccess || per_cu < 1) fprintf(stderr, "kernel_launch: occupancy query says %d\n", per_cu);
        (void)hipGetLastError();
        grid = cus;
    }
    if (grid < 0) return;
    (void)hipMemsetAsync((char*)d_ws + WS_CTL, 0, CTL_ZERO_BYTES, stream);
    Args a{};
    for (int i = 0; i < 18; ++i) a.in[i] = (const float*)d_in[i];
    a.out = (float*)d_out; a.ws = (unsigned char*)d_ws; a.pad = 0;
#if MK_ONE_LAUNCH
    a.ph_lo = 0; a.ph_hi = SEQ_END; a.use_bar = 1;
    hipLaunchKernelGGL(fwd_kernel, dim3(grid), dim3(NWAVES * 64), LDS_BYTES, stream, a);
#else
    a.use_bar = 0;
#ifndef MAXSEQ
#define MAXSEQ 1000
#ifndef PROBE_ATT_REPS
#define PROBE_ATT_REPS 1
#endif
#ifndef PROBE_QKV_REPS
#define PROBE_QKV_REPS 1
#endif
#ifndef PROBE_CONV_REPS
#define PROBE_CONV_REPS 1
#endif
#endif
    auto run = [&](int k) { if (k >= MAXSEQ) return; a.ph_lo = k; a.ph_hi = k + 1; hipLaunchKernelGGL(fwd_kernel, dim3(grid), dim3(NWAVES * 64), LDS_BYTES, stream, a); };
    run(0);
    for (int L = 0; L < DEPTH; ++L) {
        const int base = 1 + L * PH_PER_LAYER; const bool moe = (L & 1) != 0;
        for (int k = 0; k < 5; ++k) run(base + k);
        if (moe) { run(base + 5); for (int c = 0; c < NCHUNK; ++c) { run(base + 6 + 2 * c); run(base + 7 + 2 * c); } }
        else { run(base + 6); run(base + 7); }
    }
    run(SEQ_FINAL);
#endif
}
```

```cpp
#include <hip/hip_runtime.h>
#include <cstdio>
#include <cstdint>

#ifndef MK_ONE_LAUNCH
#define MK_ONE_LAUNCH 1
#endif
#define MAXSEQ 1000
#ifndef PROBE_ATT_REPS
#define PROBE_ATT_REPS 1
#endif
#ifndef PROBE_QKV_REPS
#define PROBE_QKV_REPS 1
#endif
#ifndef DENSE_UP8_MASK
#define DENSE_UP8_MASK 5
#endif
#ifndef DENSE_DN8_MASK
#define DENSE_DN8_MASK 5
#endif
#define DENSE_UP8(L) (((DENSE_UP8_MASK) >> (L)) & 1)
#define DENSE_DN8(L) (((DENSE_DN8_MASK) >> (L)) & 1)
#ifndef QKV_FP8
#define QKV_FP8 0
#endif
#ifndef PROBE_BAR2
#define PROBE_BAR2 0
#endif
#ifndef PROBE_PE2
#define PROBE_PE2 0
#endif
#ifndef PROBE_SAMPLE
#define PROBE_SAMPLE 0
#endif
#ifndef PROBE_CONV_REPS
#define PROBE_CONV_REPS 1
#endif

#define GAS __attribute__((address_space(1)))
#define LAS __attribute__((address_space(3)))
typedef unsigned short bf16;
typedef short bf16x8 __attribute__((ext_vector_type(8)));
typedef float f32x4 __attribute__((ext_vector_type(4)));
typedef float f32x2 __attribute__((ext_vector_type(2)));
typedef unsigned u32x4 __attribute__((ext_vector_type(4)));
typedef unsigned u32x2 __attribute__((ext_vector_type(2)));
typedef short v4i16_t __attribute__((ext_vector_type(4)));

constexpr int BATCH = 8, T = 8192, D = 1024, M = BATCH * T, DEPTH = 4;
constexpr int NQKV = 2560, FF = 3584, NE = 8, NMEM = 256, MROWS = BATCH * NMEM;
constexpr int OFF_QA = 0, OFF_KA = 384, OFF_VA = 768, OFF_QB = 1152, OFF_KB = 1536, OFF_VB = 1920, OFF_QM = 2304;
constexpr float RMS_EPS = 1e-6f;
constexpr float LOG2E = 1.4426950408889634f;
constexpr float QSCALE = 0.125f * LOG2E;
constexpr int XP = 2 * D;
constexpr int NWAVES = 8;
constexpr int MAXTILES = 520;
constexpr int CHUNK_TILES = 256;
constexpr int NCHUNK = 5;

constexpr size_t MiB = 1u << 20;
constexpr size_t WS_CTL = 0, CTL_ZERO_BYTES = 1 * MiB;
constexpr size_t WS_COS = 2 * MiB, WS_SIN = 2 * MiB + 256 * 1024;
constexpr size_t WS_E01 = 4 * MiB;
constexpr size_t WS_GATE = 4 * MiB + 256 * 1024;
constexpr size_t WS_POS = 5 * MiB;
constexpr size_t WS_TCNT = 6 * MiB;
constexpr size_t WS_TEXP = 6 * MiB + 64 * 1024;
constexpr size_t WS_SSQ = 8 * MiB;
constexpr size_t WS_WC = 16 * MiB, WC_STRIDE = 8 * MiB;
constexpr size_t WC_IN = 0, WC_MKV = 5 * MiB, WC_OUT = 6 * MiB;
constexpr size_t WS_WD = 48 * MiB, WD_STRIDE = 21 * MiB;
constexpr size_t WS_WM = 90 * MiB, WM_STRIDE = 112 * MiB;
constexpr size_t WM_DOWN = 56 * MiB;
constexpr size_t WS_HB = 314 * MiB;
constexpr size_t WS_BIG = 442 * MiB;
constexpr size_t WS_GA = WS_BIG, WS_HIDC = WS_BIG + 260 * MiB;
constexpr size_t WS_GA8 = 926 * MiB;
constexpr size_t WS_MEMN4 = 1056 * MiB;
constexpr size_t WS_MEMKV4 = 1072 * MiB;
constexpr size_t WS_END = 1080 * MiB;
static_assert(WS_HIDC + (size_t)CHUNK_TILES * 256 * FF <= WS_GA8 && WS_BIG + (size_t)M * FF * 2 <= WS_GA8 && WS_GA8 + (size_t)MAXTILES * 256 * D <= WS_END, "ws map");
constexpr float A8_SCALE = 32.0f, W8_SCALE = 1024.0f, ACC8_SCALE = 1.0f / 32768.0f;
constexpr float H8_SCALE = 16.0f, WD8_SCALE = 4096.0f, ACCD8_SCALE = 1.0f / 65536.0f;
constexpr size_t WD8_ESTRIDE = (size_t)D * FF;

constexpr int CW_TMO = 0, CW_CODE = 1, CW_BAR = 4096;

constexpr int RING_BYTES = 131072;
constexpr int MISC_OFF = 139264;
constexpr int LDS_BYTES = 155648;
constexpr int MISC_BARW = 0;
constexpr int MISC_TEXP = 64;
constexpr int MISC_PTAB = 2560;
constexpr int MISC_SCR = 4096;

__device__ __forceinline__ float vmax2(float a, float b) { return __builtin_amdgcn_fmed3f(a, b, INFINITY); }
__device__ __forceinline__ float vmax3(float a, float b, float c) { return vmax2(vmax2(a, b), c); }
__device__ __forceinline__ float clamp8(float x) { return __builtin_amdgcn_fmed3f(x, -448.0f, 448.0f); }
__device__ __forceinline__ unsigned cvt4_fp8(float a, float b, float c, float d) {
    unsigned w = 0; w = __builtin_amdgcn_cvt_pk_fp8_f32(clamp8(a), clamp8(b), w, false); w = __builtin_amdgcn_cvt_pk_fp8_f32(clamp8(c), clamp8(d), w, true); return w; }
namespace pg8 {
#define PG8_LAS __attribute__((address_space(3)))
typedef unsigned short bf16_t;
constexpr int BM = 256, BK = 64, HALF = 128, HTB = HALF * BK * 2, STAGE_BYTES = 8 * HTB, NXCD = 8, WGM = 8;

__host__ __device__ __forceinline__ int lds_byte(int r, int c) { const int st = (r >> 4) * 2 + (c >> 5), rr = r & 15, cc = c & 31, ob = rr * 64 + cc * 2; return st * 1024 + (ob ^ (((ob >> 9) & 1) << 5)); }
__host__ __device__ __forceinline__ void stage_rc(int b, int& R, int& C) { const int st = b / 1024, sb = b % 1024, swz = sb ^ (((sb >> 9) & 1) << 5); R = (st >> 1) * 16 + swz / 64; C = (st & 1) * 32 + (swz % 64) / 2; }
__host__ __device__ __forceinline__ int perm32(int rho) { const int n = rho >> 4, i = rho & 15; return 8 * (i >> 2) + 4 * n + (i & 3); }

struct Unit { int pm, pn, e; };
struct Gemm { const bf16_t* A; const bf16_t* Bt; int M, N, K; size_t estride; };

struct TileOrder {
    int nM, nN, nwg, G, c; const PG8_LAS int* texp;
    __device__ void init(int Mr, int N, int G_, int c_, const PG8_LAS int* texp_) { nM = Mr / BM; nN = N / BM; nwg = nM * nN; G = G_; c = c_; texp = texp_; }
    __device__ bool next(int i, Unit& u) const {
        const long L = (long)i * G + c; if (L >= nwg) return false;
        int wgid = (int)L; { const int q = nwg / NXCD, r = nwg % NXCD, xcd = wgid % NXCD, off = wgid / NXCD; wgid = (xcd < r ? xcd * (q + 1) : r * (q + 1) + (xcd - r) * q) + off; }
        const int nig = WGM * nN, gid = wgid / nig, fm = gid * WGM, gsz = (nM - fm) < WGM ? (nM - fm) : WGM;
        u.pm = fm + ((wgid % nig) % gsz); u.pn = (wgid % nig) / gsz; u.e = texp ? __builtin_amdgcn_readfirstlane(texp[u.pm]) : 0; return true;
    }
};

struct TileOrderSkew : TileOrder {
    int nsk, kd, per;
    __device__ bool next(int i, Unit& u) const {
        int cc = c, ii = i;
        if (nsk > 0) {
            if (c < nsk) { if (i >= per - kd) return false; }
            else if (i == per) { const int S = (nsk + 7) & ~7, j = c / S - 1, c2 = c % S; if (c < S || j >= kd || c2 >= nsk) return false; cc = c2; ii = per - kd + j; }
            else if (i > per) return false;
        }
        const long L = (long)ii * G + cc; if (L >= nwg) return false;
        int wgid = (int)L; { const int q = nwg / NXCD, r = nwg % NXCD, xcd = wgid % NXCD, off = wgid / NXCD; wgid = (xcd < r ? xcd * (q + 1) : r * (q + 1) + (xcd - r) * q) + off; }
        const int nig = WGM * nN, gid = wgid / nig, fm = gid * WGM, gsz = (nM - fm) < WGM ? (nM - fm) : WGM;
        u.pm = fm + ((wgid % nig) % gsz); u.pn = (wgid % nig) / gsz; u.e = texp ? __builtin_amdgcn_readfirstlane(texp[u.pm]) : 0; return true;
    }
};

typedef int i32x8 __attribute__((ext_vector_type(8)));
typedef int i32x4 __attribute__((ext_vector_type(4)));
__device__ __forceinline__ i32x8 cat8(bf16x8 a, bf16x8 b) { const i32x4 x = __builtin_bit_cast(i32x4, a), y = __builtin_bit_cast(i32x4, b); return __builtin_shufflevector(x, y, 0, 1, 2, 3, 4, 5, 6, 7); }
__device__ __forceinline__ void mfma8(f32x4& acc, const i32x8 a, const i32x8 b) { int sc = 0x7f7f7f7f;
    asm volatile("v_mfma_scale_f32_16x16x128_f8f6f4 %0, %1, %2, %0, %3, %3 op_sel_hi:[0,0,0]" : "+v"(acc) : "v"(a), "v"(b), "v"(sc)); }
__device__ __forceinline__ unsigned cvt_pk_bf16(float lo, float hi) { unsigned r; asm volatile("v_cvt_pk_bf16_f32 %0, %1, %2" : "=v"(r) : "v"(lo), "v"(hi)); return r; }


struct EpiPlain {
    static constexpr bool PERM = true, FP8 = false; static constexpr int LDA = 0;
    bf16_t* O; int ldc;
    __device__ __forceinline__ void operator()(const f32x4 (&acc)[2][2][4][2], const Unit& u, int wr, int wc, int fr, int fq) const {
        const int row0 = u.pm * BM + wr * 64 + fr, col0 = u.pn * BM + wc * 32 + 8 * fq;
#pragma unroll
        for (int ai = 0; ai < 2; ++ai)
#pragma unroll
            for (int m = 0; m < 4; ++m) { bf16_t* rowp = O + (size_t)(row0 + ai * HALF + m * 16) * ldc + col0;
#pragma unroll
                for (int bj = 0; bj < 2; ++bj) { const f32x4 v0 = acc[ai][bj][m][0], v1 = acc[ai][bj][m][1];
                    u32x4 w; w.x = cvt_pk_bf16(v0[0], v0[1]); w.y = cvt_pk_bf16(v0[2], v0[3]); w.z = cvt_pk_bf16(v1[0], v1[1]); w.w = cvt_pk_bf16(v1[2], v1[3]);
                    *(u32x4*)(rowp + bj * HALF) = w; } }
    }
};
template <bool F8> struct EpiQKVT {
    static constexpr bool PERM = true, FP8 = F8; static constexpr int LDA = F8 ? 0 : XP;
    bf16_t* O; const float* cosT; const float* sinT; float insc;
    const float* ssq; int npart;
    __device__ __forceinline__ void operator()(const f32x4 (&acc)[2][2][4][2], const Unit& u, int wr, int wc, int fr, int fq) const {
        const int row0 = u.pm * BM + wr * 64 + fr, col0 = u.pn * BM + wc * 32 + 8 * fq;
        const bool lane_rot = ((wc & 1) == 0) && (fq < 2);
        float rsv[2][4];
        if (npart) {
            f32x4 pp[2][4];
#pragma unroll
            for (int ai = 0; ai < 2; ++ai)
#pragma unroll
                for (int m = 0; m < 4; ++m) pp[ai][m] = *(const f32x4*)(ssq + (size_t)(row0 + ai * HALF + m * 16) * 16 + 4 * fq);
#pragma unroll
            for (int ai = 0; ai < 2; ++ai)
#pragma unroll
                for (int m = 0; m < 4; ++m) { float sq = (pp[ai][m][0] + pp[ai][m][1]) + (pp[ai][m][2] + pp[ai][m][3]); sq += __shfl_xor(sq, 16); sq += __shfl_xor(sq, 32);
                    rsv[ai][m] = insc / sqrtf(sq * (1.0f / D) + RMS_EPS); }
        } else {
#pragma unroll
            for (int ai = 0; ai < 2; ++ai)
#pragma unroll
                for (int m = 0; m < 4; ++m) rsv[ai][m] = insc;
        }
        const bool anyrot = (u.pn >= 4) && (u.pn <= 7);
#pragma unroll
        for (int ai = 0; ai < 2; ++ai) {
            f32x4 rc[4], rn[4];
#pragma unroll
            for (int m = 0; m < 4; ++m) { rc[m] = (f32x4){0.f, 0.f, 0.f, 0.f}; rn[m] = rc[m]; }
            if (anyrot) {
#pragma unroll
                for (int m = 0; m < 4; ++m) { const int t = (row0 + ai * HALF + m * 16) & (T - 1); rc[m] = *(const f32x4*)(cosT + t * 8 + 4 * (fq & 1)); rn[m] = *(const f32x4*)(sinT + t * 8 + 4 * (fq & 1)); }
            }
#pragma unroll
            for (int m = 0; m < 4; ++m) {
                const int row = row0 + ai * HALF + m * 16;
                const float rs = rsv[ai][m];
#pragma unroll
                for (int bj = 0; bj < 2; ++bj) {
                    const int idx = 2 * u.pn + bj;
                    const float sc = ((idx < 3 || (idx >= 9 && idx < 12) || idx >= 18) ? QSCALE : 1.0f) * rs;
                    const bool rot = (idx >= 9 && idx < 15) && lane_rot;
                    f32x4 v0 = acc[ai][bj][m][0] * sc, v1 = acc[ai][bj][m][1] * sc;
                    if (rot) {
                        const f32x4 c = rc[m], s = rn[m];
                        f32x4 a, b;
                        a[0] = v0[0] * c[0] - v0[1] * s[0]; a[1] = v0[1] * c[0] + v0[0] * s[0];
                        a[2] = v0[2] * c[1] - v0[3] * s[1]; a[3] = v0[3] * c[1] + v0[2] * s[1];
                        b[0] = v1[0] * c[2] - v1[1] * s[2]; b[1] = v1[1] * c[2] + v1[0] * s[2];
                        b[2] = v1[2] * c[3] - v1[3] * s[3]; b[3] = v1[3] * c[3] + v1[2] * s[3];
                        v0 = a; v1 = b;
                    }
                    u32x4 w; w.x = cvt_pk_bf16(v0[0], v0[1]); w.y = cvt_pk_bf16(v0[2], v0[3]); w.z = cvt_pk_bf16(v1[0], v1[1]); w.w = cvt_pk_bf16(v1[2], v1[3]);
                    *(u32x4*)(O + (size_t)row * NQKV + col0 + bj * HALF) = w;
                }
            }
        }
    }
};
template <bool F8> struct EpiSwigluT {
    static constexpr bool PERM = true, FP8 = F8; static constexpr int LDA = 0;
    bf16_t* O; float insc; int out_bf16;
    __device__ __forceinline__ void operator()(const f32x4 (&acc)[2][2][4][2], const Unit& u, int wr, int wc, int fr, int fq) const {
        const int row0 = u.pm * BM + wr * 64 + fr, col0 = u.pn * HALF + wc * 32 + 8 * fq;
#pragma unroll
        for (int ai = 0; ai < 2; ++ai)
#pragma unroll
            for (int m = 0; m < 4; ++m) {
                float h[8];
#pragma unroll
                for (int n = 0; n < 2; ++n)
#pragma unroll
                    for (int j = 0; j < 4; ++j) { const float g = acc[ai][0][m][n][j] * insc, up = acc[ai][1][m][n][j] * insc;
                        const float sg = g * __builtin_amdgcn_rcpf(1.0f + __builtin_amdgcn_exp2f(-g * LOG2E)); h[4 * n + j] = sg * up; }
                if (F8 && !out_bf16) {
                    u32x2 w; w.x = cvt4_fp8(h[0] * H8_SCALE, h[1] * H8_SCALE, h[2] * H8_SCALE, h[3] * H8_SCALE); w.y = cvt4_fp8(h[4] * H8_SCALE, h[5] * H8_SCALE, h[6] * H8_SCALE, h[7] * H8_SCALE);
                    *(u32x2*)((unsigned char*)O + (size_t)(row0 + ai * HALF + m * 16) * FF + col0) = w;
                } else {
                    u32x4 w; w.x = cvt_pk_bf16(h[0], h[1]); w.y = cvt_pk_bf16(h[2], h[3]); w.z = cvt_pk_bf16(h[4], h[5]); w.w = cvt_pk_bf16(h[6], h[7]);
                    *(u32x4*)(O + (size_t)(row0 + ai * HALF + m * 16) * FF + col0) = w;
                }
            }
    }
};
template <bool F8> struct EpiResT {
    static constexpr bool PERM = true, FP8 = F8; static constexpr int LDA = 0;
    const float* src; bf16_t* xbf; bf16_t* ob; int ldc; int as_bf16; float insc;
    __device__ __forceinline__ void operator()(const f32x4 (&acc)[2][2][4][2], const Unit& u, int wr, int wc, int fr, int fq) const {
        const int row0 = u.pm * BM + wr * 64 + fr, col0 = u.pn * BM + wc * 32 + 8 * fq;
        float* ssqp = nullptr;
        if (as_bf16 == 2) {
            extern __shared__ __attribute__((aligned(16))) unsigned char lds_epi[];
            const unsigned long long v = ((const PG8_LAS unsigned long long*)((PG8_LAS unsigned char*)lds_epi + MISC_OFF + MISC_PTAB))[18];
            const unsigned lo = __builtin_amdgcn_readfirstlane((unsigned)v), hi = __builtin_amdgcn_readfirstlane((unsigned)(v >> 32));
            ssqp = (float*)((unsigned char*)(((unsigned long long)hi << 32) | lo) + WS_SSQ); }
        if (as_bf16 == 1) {
#pragma unroll
            for (int ai = 0; ai < 2; ++ai)
#pragma unroll
                for (int m = 0; m < 4; ++m) { bf16_t* rowp = ob + (size_t)(row0 + ai * HALF + m * 16) * ldc + col0;
#pragma unroll
                    for (int bj = 0; bj < 2; ++bj) { const f32x4 v0 = acc[ai][bj][m][0] * insc, v1 = acc[ai][bj][m][1] * insc;
                        u32x4 w; w.x = cvt_pk_bf16(v0[0], v0[1]); w.y = cvt_pk_bf16(v0[2], v0[3]); w.z = cvt_pk_bf16(v1[0], v1[1]); w.w = cvt_pk_bf16(v1[2], v1[3]); *(u32x4*)(rowp + bj * HALF) = w; } }
        } else {
#pragma unroll
            for (int ai = 0; ai < 2; ++ai) {
                u32x4 rw[4][2];
#pragma unroll
                for (int m = 0; m < 4; ++m)
#pragma unroll
                    for (int bj = 0; bj < 2; ++bj) rw[m][bj] = *(const u32x4*)(xbf + (size_t)(row0 + ai * HALF + m * 16) * XP + col0 + bj * HALF);
#pragma unroll
                for (int m = 0; m < 4; ++m) { const size_t xoff = (size_t)(row0 + ai * HALF + m * 16) * XP + col0; float ss = 0.f;
#pragma unroll
                    for (int bj = 0; bj < 2; ++bj) { const u32x4 r = rw[m][bj];
                        const f32x4 b0 = (f32x4){__builtin_bit_cast(float, r.x << 16), __builtin_bit_cast(float, r.x & 0xffff0000u), __builtin_bit_cast(float, r.y << 16), __builtin_bit_cast(float, r.y & 0xffff0000u)};
                        const f32x4 b1 = (f32x4){__builtin_bit_cast(float, r.z << 16), __builtin_bit_cast(float, r.z & 0xffff0000u), __builtin_bit_cast(float, r.w << 16), __builtin_bit_cast(float, r.w & 0xffff0000u)};
                        const f32x4 x0 = b0 + acc[ai][bj][m][0] * insc, x1 = b1 + acc[ai][bj][m][1] * insc;
                        ss += ((x0[0] * x0[0] + x0[1] * x0[1]) + (x0[2] * x0[2] + x0[3] * x0[3])) + ((x1[0] * x1[0] + x1[1] * x1[1]) + (x1[2] * x1[2] + x1[3] * x1[3]));
                        u32x4 w; w.x = cvt_pk_bf16(x0[0], x0[1]); w.y = cvt_pk_bf16(x0[2], x0[3]); w.z = cvt_pk_bf16(x1[0], x1[1]); w.w = cvt_pk_bf16(x1[2], x1[3]);
                        *(u32x4*)(xbf + xoff + bj * HALF) = w; }
                    if (ssqp) { ss += __shfl_xor(ss, 16); ss += __shfl_xor(ss, 32); if (fq == 0) ssqp[(size_t)(row0 + ai * HALF + m * 16) * 16 + 4 * u.pn + wc] = ss; } }
                asm volatile("" ::: "memory");
            }
        }
    }
};

template <class Epi, class Sched>
__device__ __forceinline__ void gemm_phase(PG8_LAS unsigned char* lds, const Gemm g, const Sched& S, const Epi& E, const int tid) {
    const int wid = __builtin_amdgcn_readfirstlane(tid >> 6), lane = tid & 63, wr = wid >> 2, wc = wid & 3, fr = lane & 15, fq = lane >> 4;
    const int K = g.K, nt = K / BK;
    const int LDA_ = Epi::LDA ? Epi::LDA : K;
    unsigned voffA[2], voffB[2];
#pragma unroll
    for (int i = 0; i < 2; ++i) { int R, C; stage_rc(tid * 16 + i * 8192, R, C); const int Rb = Epi::PERM ? ((R & ~31) + perm32(R & 31)) : R;
        voffA[i] = (unsigned)(R * LDA_ + C) * 2u; voffB[i] = (unsigned)(Rb * K + C) * 2u; }
    const size_t kstep = (size_t)(BK * 2);
    const size_t hstep = (size_t)HALF * K * 2;
    const size_t tstep = 2 * hstep;
    const size_t hstepA = (size_t)HALF * LDA_ * 2, tstepA = 2 * hstepA;
    const unsigned ldsw = (unsigned)wid * 1024u;
    const int aoff = lds_byte(wr * 64 + fr, fq * 8), boff = lds_byte(wc * 32 + fr, fq * 8);
#define PG8_SA(b, h) (((b) * 2 + (h)) * HTB)
#define PG8_SB(b, h) ((4 + (b) * 2 + (h)) * HTB)
#define PG8_STAGE(bufoff, gbase, voff) do { _Pragma("unroll") for (int _i = 0; _i < 2; ++_i) \
        __builtin_amdgcn_global_load_lds((const unsigned*)((const char*)(gbase) + (voff)[_i]), (PG8_LAS unsigned*)(lds + (bufoff) + ldsw + _i * 8192), 16, 0, 0); } while (0)
#define PG8_LDA(dst, b, h) do { _Pragma("unroll") for (int m = 0; m < 4; ++m) _Pragma("unroll") for (int k = 0; k < 2; ++k) dst[m][k] = *(const PG8_LAS bf16x8*)(lds + PG8_SA(b, h) + aoff + m * 2048 + k * 1024); } while (0)
#define PG8_LDB(dst, b, h) do { _Pragma("unroll") for (int n = 0; n < 2; ++n) _Pragma("unroll") for (int k = 0; k < 2; ++k) dst[n][k] = *(const PG8_LAS bf16x8*)(lds + PG8_SB(b, h) + boff + n * 2048 + k * 1024); } while (0)
#define PG8_MMA(ai, bj, At, Bt) do { __builtin_amdgcn_s_setprio(1); \
        if constexpr (Epi::FP8) { _Pragma("unroll") for (int m = 0; m < 4; ++m) _Pragma("unroll") for (int n = 0; n < 2; ++n) \
            mfma8(acc[ai][bj][m][n], cat8(Bt[n][0], Bt[n][1]), cat8(At[m][0], At[m][1])); } \
        else { _Pragma("unroll") for (int m = 0; m < 4; ++m) _Pragma("unroll") for (int n = 0; n < 2; ++n) _Pragma("unroll") for (int k = 0; k < 2; ++k) \
            acc[ai][bj][m][n] = __builtin_amdgcn_mfma_f32_16x16x32_bf16(Bt[n][k], At[m][k], acc[ai][bj][m][n], 0, 0, 0); } \
        __builtin_amdgcn_s_setprio(0); } while (0)
#define PG8_WAIT_V(n) asm volatile("s_waitcnt vmcnt(" #n ")" ::: "memory")
#define PG8_WAIT_L(n) asm volatile("s_waitcnt lgkmcnt(" #n ")" ::: "memory")
#define PG8_BAR __builtin_amdgcn_s_barrier()
#define PG8_SCHED __builtin_amdgcn_sched_barrier(0)
    Unit cur, nxt; int ui = 0;
    if (!S.next(0, cur)) return;
    f32x4 acc[2][2][4][2];
#pragma unroll
    for (int a = 0; a < 2; ++a)
#pragma unroll
        for (int b = 0; b < 2; ++b)
#pragma unroll
            for (int m = 0; m < 4; ++m)
#pragma unroll
                for (int n = 0; n < 2; ++n) acc[a][b][m][n] = (f32x4){0.f, 0.f, 0.f, 0.f};
    bf16x8 At[4][2], B0[2][2], B1[2][2];
    const char* cA = (const char*)g.A + (size_t)cur.pm * tstepA; const char* cB = (const char*)g.Bt + (size_t)cur.e * g.estride + (size_t)cur.pn * tstep;
    PG8_STAGE(PG8_SB(0, 0), cB, voffB); PG8_STAGE(PG8_SB(0, 1), cB + hstep, voffB); PG8_STAGE(PG8_SA(0, 0), cA, voffA); PG8_STAGE(PG8_SA(0, 1), cA + hstepA, voffA);
    if (wr == 1) PG8_BAR;
    PG8_WAIT_V(2); PG8_BAR;
    PG8_STAGE(PG8_SB(1, 0), cB + kstep, voffB); PG8_STAGE(PG8_SA(1, 0), cA + kstep, voffA); PG8_STAGE(PG8_SB(1, 1), cB + hstep + kstep, voffB);
    PG8_WAIT_V(6); PG8_BAR;
    for (;;) {
        const bool has_next = S.next(ui + 1, nxt);
        const char* nA = has_next ? (const char*)g.A + (size_t)nxt.pm * tstepA : cA; const char* nB = has_next ? (const char*)g.Bt + (size_t)nxt.e * g.estride + (size_t)nxt.pn * tstep : cB;
        for (int t = 0; t < nt; t += 2) {
            const bool last = (t == nt - 2);
            const char* a1 = cA + (size_t)(t + 1) * kstep;
            const char* a2 = last ? nA : cA + (size_t)(t + 2) * kstep; const char* b2 = last ? nB : cB + (size_t)(t + 2) * kstep;
            const char* a3 = a2 + kstep; const char* b3 = b2 + kstep;
            PG8_LDB(B0, 0, 0); PG8_LDB(B1, 0, 1); PG8_SCHED; PG8_LDA(At, 0, 0); PG8_STAGE(PG8_SA(1, 1), a1 + hstepA, voffA);
            PG8_WAIT_V(8); PG8_WAIT_L(0); PG8_BAR; PG8_MMA(0, 0, At, B0); PG8_MMA(0, 1, At, B1); PG8_BAR; PG8_SCHED;
            PG8_LDA(At, 0, 1); PG8_STAGE(PG8_SB(0, 0), b2, voffB); PG8_STAGE(PG8_SB(0, 1), b2 + hstep, voffB); PG8_STAGE(PG8_SA(0, 0), a2, voffA);
            PG8_WAIT_V(8); PG8_WAIT_L(0); PG8_BAR; PG8_MMA(1, 0, At, B0); PG8_MMA(1, 1, At, B1); PG8_BAR; PG8_SCHED;
            PG8_LDB(B0, 1, 0); PG8_LDB(B1, 1, 1); PG8_SCHED; PG8_LDA(At, 1, 0); PG8_STAGE(PG8_SA(0, 1), a2 + hstepA, voffA);
            PG8_WAIT_V(8); PG8_WAIT_L(0); PG8_BAR; PG8_MMA(0, 0, At, B0); PG8_MMA(0, 1, At, B1); PG8_BAR; PG8_SCHED;
            PG8_LDA(At, 1, 1); PG8_STAGE(PG8_SB(1, 0), b3, voffB); PG8_STAGE(PG8_SB(1, 1), b3 + hstep, voffB); PG8_STAGE(PG8_SA(1, 0), a3, voffA);
            PG8_WAIT_V(8); PG8_WAIT_L(0); PG8_BAR; PG8_MMA(1, 0, At, B0); PG8_MMA(1, 1, At, B1); PG8_BAR; PG8_SCHED;
        }
        if (wr == 0) PG8_BAR;
        if constexpr (Epi::FP8) {
#pragma unroll
            for (int a = 0; a < 2; ++a)
#pragma unroll
                for (int b = 0; b < 2; ++b)
                    asm volatile("s_nop 15\n\ts_nop 15" : "+v"(acc[a][b][0][0]), "+v"(acc[a][b][0][1]), "+v"(acc[a][b][1][0]), "+v"(acc[a][b][1][1]), "+v"(acc[a][b][2][0]), "+v"(acc[a][b][2][1]), "+v"(acc[a][b][3][0]), "+v"(acc[a][b][3][1]));
        }
        E(acc, cur, wr, wc, fr, fq);
        if (!has_next) break;
#pragma unroll
        for (int a = 0; a < 2; ++a)
#pragma unroll
            for (int b = 0; b < 2; ++b)
#pragma unroll
                for (int m = 0; m < 4; ++m)
#pragma unroll
                    for (int n = 0; n < 2; ++n) acc[a][b][m][n] = (f32x4){0.f, 0.f, 0.f, 0.f};
        cur = nxt; cA = nA; cB = nB; ++ui;
        if (wr == 1) PG8_BAR;
    }
    PG8_WAIT_V(0);
    PG8_BAR;
#undef PG8_SA
#undef PG8_SB
#undef PG8_STAGE
#undef PG8_LDA
#undef PG8_LDB
#undef PG8_MMA
#undef PG8_WAIT_V
#undef PG8_WAIT_L
#undef PG8_BAR
#undef PG8_SCHED
}
}

typedef GAS unsigned gu32;
#define RLX_AGENT __ATOMIC_RELAXED, __HIP_MEMORY_SCOPE_AGENT
#define LDS_WAIT() asm volatile("s_waitcnt lgkmcnt(0)" ::: "memory")
#define VM_WAIT() asm volatile("s_waitcnt vmcnt(0)" ::: "memory")
__device__ __forceinline__ unsigned f2bf(float f) { unsigned u = __builtin_bit_cast(unsigned, f); return (u + 0x7fffu + ((u >> 16) & 1u)) >> 16; }
__device__ __forceinline__ unsigned pk2(float lo, float hi) { return f2bf(lo) | (f2bf(hi) << 16); }
__device__ __forceinline__ float bf_lo(unsigned w) { return __builtin_bit_cast(float, w << 16); }
__device__ __forceinline__ float bf_hi(unsigned w) { return __builtin_bit_cast(float, w & 0xffff0000u); }

#define XB_TMO      128
#define XB_XCNT(j)  (256  + 64 * (j))
#define XB_XSUB(j)  (1280 + 64 * (j))
#define XB_XGEN(j)  (2304 + 64 * (j))
#define XB_TOP      3328
#define XB_TOPGEN   3392
#define XCD_BAR_WORDS 3456
#define XB_SPIN_CAP (1u << 18)

__device__ __forceinline__ unsigned xb_ld(unsigned* p)              { return __hip_atomic_load(p, __ATOMIC_RELAXED, __HIP_MEMORY_SCOPE_AGENT); }
__device__ __forceinline__ unsigned xb_add(unsigned* p, unsigned v) { return __hip_atomic_fetch_add(p, v, __ATOMIC_RELAXED, __HIP_MEMORY_SCOPE_AGENT); }
__device__ __forceinline__ unsigned xb_xcc_id() { return (unsigned)__builtin_amdgcn_s_getreg((3 << 11) | 20) & 0xFu; }
#define XB_SPIN(cond, bar) do { unsigned _sp = 0; while (cond) { __builtin_amdgcn_s_sleep(1); \
    if ((++_sp & 255u) == 0u) { if (xb_ld(&(bar)[XB_TMO])) break; if (_sp > XB_SPIN_CAP) { atomicAdd(&(bar)[XB_TMO], 1u); break; } } } } while (0)

struct XcdBarrier { unsigned* bar; unsigned x; volatile LAS unsigned* st; };

__device__ __forceinline__ XcdBarrier xcd_barrier_post(unsigned* bar, volatile LAS unsigned* st) {
    XcdBarrier b; b.bar = bar; b.x = xb_xcc_id(); b.st = st;
    if (threadIdx.x == 0) (void)xb_add(&bar[XB_XCNT(b.x)], 1u);
    return b;
}
__device__ __forceinline__ void xcd_barrier_complete(unsigned* bar, unsigned x, unsigned& nloc, unsigned& nx) {
    const unsigned G = gridDim.x * gridDim.y * gridDim.z;
    unsigned sum, cnt, mine, sp = 0u;
    for (;;) {
        sum = 0u; cnt = 0u; mine = 0u;
#pragma unroll
        for (unsigned j = 0; j < 16; ++j) { const unsigned c = xb_ld(&bar[XB_XCNT(j)]); sum += c; cnt += (c > 0u) ? 1u : 0u; mine = (j == x) ? c : mine; }
        if (sum == G) break;
        __builtin_amdgcn_s_sleep(1);
        if ((++sp & 255u) == 0u) { if (xb_ld(&bar[XB_TMO])) break; if (sp > XB_SPIN_CAP) { atomicAdd(&bar[XB_TMO], 1u); break; } }
    }
    nloc = mine > 0u ? mine : 1u; nx = cnt > 0u ? cnt : 1u;
}
__device__ __forceinline__ void xcd_barrier(const XcdBarrier& b) {
    asm volatile("s_waitcnt vmcnt(0)" ::: "memory");
    __syncthreads();
    if (threadIdx.x == 0) {
        unsigned* bar = b.bar;
        __builtin_amdgcn_s_waitcnt(0);
        unsigned nloc = b.st[0], nx = b.st[1];
        if (nloc == 0u) { xcd_barrier_complete(bar, b.x, nloc, nx); b.st[0] = nloc; b.st[1] = nx; }
        const unsigned old = xb_add(&bar[XB_XSUB(b.x)], 1u);
        const unsigned gen = old / nloc;
        if (old + 1u == (gen + 1u) * nloc) {
            __builtin_amdgcn_fence(__ATOMIC_RELEASE, "agent");
            asm volatile("s_waitcnt vmcnt(0)" ::: "memory");
            const unsigned og = xb_add(&bar[XB_TOP], 1u);
            const unsigned tg = og / nx;
            if (og + 1u == (tg + 1u) * nx) xb_add(&bar[XB_TOPGEN], 1u);
            else XB_SPIN(xb_ld(&bar[XB_TOPGEN]) == tg, bar);
            __builtin_amdgcn_fence(__ATOMIC_ACQUIRE, "agent");
            xb_add(&bar[XB_XGEN(b.x)], 1u);
            asm volatile("s_waitcnt vmcnt(0)" ::: "memory");
        } else {
            XB_SPIN(xb_ld(&bar[XB_XGEN(b.x)]) == gen, bar);
            __builtin_amdgcn_fence(__ATOMIC_ACQUIRE, "agent");
            asm volatile("s_waitcnt vmcnt(0)" ::: "memory");
        }
    }
    __syncthreads();
}

struct Frame {
    LAS unsigned char* lds;
    LAS unsigned char* misc;
    unsigned char* ws;
    int tid, lane, wave, G, bx;
    float* out;
};
__device__ __forceinline__ const float* inp_ptr(LAS unsigned char* misc, int i) {
    const unsigned long long v = ((const LAS unsigned long long*)(misc + MISC_PTAB))[i];
    const unsigned lo = __builtin_amdgcn_readfirstlane((unsigned)v), hi = __builtin_amdgcn_readfirstlane((unsigned)(v >> 32));
    return (const float*)(GAS const float*)(((unsigned long long)hi << 32) | lo);
}
#define INP(i) inp_ptr(F.misc, (i))

__device__ __forceinline__ void lds_add(LAS int* p, int v) { (void)__hip_atomic_fetch_add(p, v, __ATOMIC_RELAXED, __HIP_MEMORY_SCOPE_WORKGROUP); }
__device__ __forceinline__ float wave_sum(float v) {
#pragma unroll
    for (int o = 1; o < 64; o <<= 1) v += __shfl_xor(v, o);
    return v;
}

__device__ __forceinline__ int map_row(int n, int mode) {
    if (mode == 1) { if (n >= OFF_QB && n < OFF_VB) { const int d = (n - OFF_QB) & 63; if (d < 16) { const int dn = d < 8 ? 2 * d : 2 * (d - 8) + 1; return n - d + dn; } } return n; }
    if (mode == 2) return ((n >> 7) << 8) + (n & 127);
    if (mode == 3) return ((n >> 7) << 8) + 128 + (n & 127);
    return n;
}
template <bool F8>
__device__ __forceinline__ void convert_mat(const float* W, int K, int N, unsigned char* WT, int mode, float wscale, int& base, int gw, int NGW, int lane, const float* kgain = nullptr) {
    constexpr int KI = F8 ? 128 : 64;
    const int nblk = N >> 6, nitems = (K / KI) * nblk;
    int r = gw - (base % NGW); if (r < 0) r += NGW;
    base += nitems;
    const int q = lane >> 4, c4 = lane & 15;
#pragma nounroll
    for (; r < nitems; r += NGW) {
        const int kb = r / nblk, nb = r - kb * nblk, k0 = kb * KI, n = nb * 64 + 4 * c4;
        const GAS float* src = (const GAS float*)W + (size_t)k0 * N + n;
        size_t drow[4];
#pragma unroll
        for (int c = 0; c < 4; ++c) drow[c] = (size_t)map_row(n + c, mode) * K + k0;
#pragma nounroll
        for (int sgm = 0; sgm < 2; ++sgm) {
            f32x4 v[16];
            if (F8) {
                const int kq = 64 * sgm + 16 * q;
#pragma unroll
                for (int j = 0; j < 16; ++j) v[j] = *(const GAS f32x4*)(src + (size_t)(kq + j) * N) * wscale;
#pragma unroll
                for (int c = 0; c < 4; ++c) { u32x4 o; o.x = cvt4_fp8(v[0][c], v[1][c], v[2][c], v[3][c]); o.y = cvt4_fp8(v[4][c], v[5][c], v[6][c], v[7][c]);
                    o.z = cvt4_fp8(v[8][c], v[9][c], v[10][c], v[11][c]); o.w = cvt4_fp8(v[12][c], v[13][c], v[14][c], v[15][c]);
                    *(GAS u32x4*)(WT + drow[c] + kq) = o; }
            } else {
                const int kq = 32 * sgm + 8 * q;
#pragma unroll
                for (int j = 0; j < 8; ++j) v[j] = *(const GAS f32x4*)(src + (size_t)(kq + j) * N);
                if (kgain) {
#pragma unroll
                    for (int j = 0; j < 8; ++j) v[j] = v[j] * kgain[k0 + kq + j]; }
#pragma unroll
                for (int c = 0; c < 4; ++c) { u32x4 o; o.x = pk2(v[0][c], v[1][c]); o.y = pk2(v[2][c], v[3][c]); o.z = pk2(v[4][c], v[5][c]); o.w = pk2(v[6][c], v[7][c]);
                    *(GAS u32x4*)((bf16*)WT + drow[c] + kq) = o; }
            }
        }
    }
}
__device__ __forceinline__ void phase_convert(Frame& F) {
    const int gw = F.bx * NWAVES + F.wave, NGW = F.G * NWAVES;
    int base = 0;
#pragma nounroll
    for (int L = 0; L < DEPTH; ++L) { unsigned char* wc = F.ws + WS_WC + (size_t)L * WC_STRIDE;
#if QKV_FP8
        convert_mat<true>(INP(3) + (size_t)L * D * NQKV, D, NQKV, wc + WC_IN, 1, W8_SCALE, base, gw, NGW, F.lane);
#else
        convert_mat<false>(INP(3) + (size_t)L * D * NQKV, D, NQKV, wc + WC_IN, 1, 1.0f, base, gw, NGW, F.lane, INP(2) + (size_t)L * D);
#endif
        convert_mat<false>(INP(6) + (size_t)L * D * 512, D, 512, wc + WC_MKV, 0, 1.0f, base, gw, NGW, F.lane);
        convert_mat<false>(INP(8) + (size_t)L * D * D, D, D, wc + WC_OUT, 0, 1.0f, base, gw, NGW, F.lane); }
#pragma nounroll
    for (int i = 0; i < 2; ++i) { unsigned char* wd = F.ws + WS_WD + (size_t)i * WD_STRIDE;
        if (DENSE_UP8(2 * i)) { convert_mat<true>(INP(10) + (size_t)i * D * FF, D, FF, wd, 2, W8_SCALE, base, gw, NGW, F.lane); convert_mat<true>(INP(11) + (size_t)i * D * FF, D, FF, wd, 3, W8_SCALE, base, gw, NGW, F.lane); }
        else { convert_mat<false>(INP(10) + (size_t)i * D * FF, D, FF, wd, 2, 1.0f, base, gw, NGW, F.lane); convert_mat<false>(INP(11) + (size_t)i * D * FF, D, FF, wd, 3, 1.0f, base, gw, NGW, F.lane); }
        if (DENSE_DN8(2 * i)) convert_mat<true>(INP(12) + (size_t)i * FF * D, FF, D, wd + 14 * MiB, 0, WD8_SCALE, base, gw, NGW, F.lane);
        else convert_mat<false>(INP(12) + (size_t)i * FF * D, FF, D, wd + 14 * MiB, 0, 1.0f, base, gw, NGW, F.lane); }
#pragma nounroll
    for (int ie = 0; ie < 2 * NE; ++ie) { const int i = ie >> 3, e = ie & 7; unsigned char* wm = F.ws + WS_WM + (size_t)i * WM_STRIDE; const size_t eo = (size_t)ie * D * FF;
        convert_mat<true>(INP(14) + eo, D, FF, wm + (size_t)e * 7 * MiB, 2, W8_SCALE, base, gw, NGW, F.lane);
        convert_mat<true>(INP(15) + eo, D, FF, wm + (size_t)e * 7 * MiB, 3, W8_SCALE, base, gw, NGW, F.lane);
        convert_mat<true>(INP(16) + eo, FF, D, wm + WM_DOWN + (size_t)e * WD8_ESTRIDE, 0, WD8_SCALE, base, gw, NGW, F.lane); }
    float* cosT = (float*)(F.ws + WS_COS); float* sinT = (float*)(F.ws + WS_SIN);
    for (int idx = F.bx * 512 + F.tid; idx < T * 8; idx += F.G * 512) {
        const int t = idx >> 3, i = idx & 7;
        const double f = (i == 0) ? 0.15915494309189535 : (i == 1) ? 0.03086376340470123 : (i == 2) ? 0.005985185712713705 : (i == 3) ? 0.001160663641240061
                       : (i == 4) ? 0.00022507907903927653 : (i == 5) ? 4.364795279280289e-05 : (i == 6) ? 8.464330808241401e-06 : 1.6414262627950345e-06;
        double rev = (double)t * f; rev -= (double)(long long)rev;
        const float rf = (float)rev;
        cosT[idx] = __builtin_amdgcn_cosf(rf); sinT[idx] = __builtin_amdgcn_sinf(rf);
    }
}

struct RowPass {
    const float* xsrc; const bf16* xbf; bf16* xdst;
    const float* gain;
    bf16* ob; float* of;
    int obp; float* ssq;
    unsigned char* ob8;
    int combine;
    int router; const float* wr;
};
constexpr int RG = 2;
__device__ __forceinline__ void phase_rows(Frame& F, const RowPass P) {
    LAS float* wrl = (LAS float*)F.lds;
    LAS int* hist = (LAS int*)(F.misc + MISC_SCR);
    const bf16* YS = (const bf16*)(F.ws + WS_GA);
    const int* posg = (const int*)(F.ws + WS_POS); const float* gateg = (const float*)(F.ws + WS_GATE);
    int* e01g = (int*)(F.ws + WS_E01); float* gatew = (float*)(F.ws + WS_GATE); int* tcnt = (int*)(F.ws + WS_TCNT);
    if (P.router) { for (int i = F.tid; i < D * 8; i += 512) wrl[i] = P.wr[i]; }
    f32x4 gv[4];
#pragma unroll
    for (int j = 0; j < 4; ++j) gv[j] = *(const f32x4*)(P.gain + 4 * F.lane + 256 * j);
    const int tstart = (F.G == 256) ? ((F.bx & 7) * 32 + (F.bx >> 3)) : F.bx, tstride = (F.G == 256) ? M / 256 : F.G;
    for (int tile = tstart; tile < M / 256; tile += tstride) {
        if (P.router) { if (F.tid < 8) hist[F.tid] = 0; }
        __syncthreads();
        f32x4 buf[RG][4]; u32x2 bub[RG][4];
#pragma unroll
        for (int q = 0; q < RG; ++q) {
            if (P.xsrc) { const float* xr = P.xsrc + (size_t)(tile * 256 + F.wave * 32 + q) * D + 4 * F.lane;
#pragma unroll
                for (int j = 0; j < 4; ++j) buf[q][j] = *(const f32x4*)(xr + 256 * j); }
            else { const bf16* xr = P.xbf + (size_t)(tile * 256 + F.wave * 32 + q) * XP + 4 * F.lane;
#pragma unroll
                for (int j = 0; j < 4; ++j) bub[q][j] = *(const u32x2*)(xr + 256 * j); } }
#pragma nounroll
        for (int i0 = 0; i0 < 32; i0 += RG) {
            const int rowb = tile * 256 + F.wave * 32 + i0;
            f32x4 v[RG][4];
#pragma unroll
            for (int q = 0; q < RG; ++q)
#pragma unroll
                for (int j = 0; j < 4; ++j) v[q][j] = P.xsrc ? buf[q][j] : (f32x4){bf_lo(bub[q][j].x), bf_hi(bub[q][j].x), bf_lo(bub[q][j].y), bf_hi(bub[q][j].y)};
            if (i0 + RG < 32) {
#pragma unroll
                for (int q = 0; q < RG; ++q) {
                    if (P.xsrc) { const float* xr = P.xsrc + (size_t)(rowb + RG + q) * D + 4 * F.lane;
#pragma unroll
                        for (int j = 0; j < 4; ++j) buf[q][j] = *(const f32x4*)(xr + 256 * j); }
                    else { const bf16* xr = P.xbf + (size_t)(rowb + RG + q) * XP + 4 * F.lane;
#pragma unroll
                        for (int j = 0; j < 4; ++j) bub[q][j] = *(const u32x2*)(xr + 256 * j); } }
            }
#pragma unroll
            for (int q = 0; q < RG; ++q) {
                const int row = rowb + q;
                if (P.combine) {
                    const int p0 = posg[2 * row], p1 = posg[2 * row + 1]; const float g0 = gateg[2 * row], g1 = gateg[2 * row + 1];
                    const bf16* y0 = YS + (size_t)p0 * D + 4 * F.lane; const bf16* y1 = YS + (size_t)p1 * D + 4 * F.lane;
#pragma unroll
                    for (int j = 0; j < 4; ++j) { const u32x2 a = *(const u32x2*)(y0 + 256 * j), b = *(const u32x2*)(y1 + 256 * j);
                        v[q][j][0] += g0 * bf_lo(a.x) + g1 * bf_lo(b.x); v[q][j][1] += g0 * bf_hi(a.x) + g1 * bf_hi(b.x);
                        v[q][j][2] += g0 * bf_lo(a.y) + g1 * bf_lo(b.y); v[q][j][3] += g0 * bf_hi(a.y) + g1 * bf_hi(b.y); }
                }
                if (P.xdst) {
                    bf16* xw = P.xdst + (size_t)row * XP + 4 * F.lane;
#pragma unroll
                    for (int j = 0; j < 4; ++j) { u32x2 w; w.x = pk2(v[q][j][0], v[q][j][1]); w.y = pk2(v[q][j][2], v[q][j][3]); *(u32x2*)(xw + 256 * j) = w; }
                }
                float s = 0.f;
#pragma unroll
                for (int j = 0; j < 4; ++j) s += (v[q][j][0] * v[q][j][0] + v[q][j][1] * v[q][j][1]) + (v[q][j][2] * v[q][j][2] + v[q][j][3] * v[q][j][3]);
                const float wsum = wave_sum(s);
                if (P.ssq) { if (F.lane < 4) *(f32x4*)(P.ssq + (size_t)row * 16 + 4 * F.lane) = (f32x4){F.lane == 0 ? wsum : 0.f, 0.f, 0.f, 0.f}; }
                const float rstd = 1.0f / sqrtf(wsum * (1.0f / D) + RMS_EPS);
#pragma unroll
                for (int j = 0; j < 4; ++j) v[q][j] = v[q][j] * rstd * gv[j];
                if (P.ob) {
                    bf16* o = P.ob + (size_t)row * P.obp + 4 * F.lane;
#pragma unroll
                    for (int j = 0; j < 4; ++j) { u32x2 w; w.x = pk2(v[q][j][0], v[q][j][1]); w.y = pk2(v[q][j][2], v[q][j][3]); *(u32x2*)(o + 256 * j) = w; }
                }
                if (P.ob8) {
                    unsigned char* o = P.ob8 + (size_t)row * D + 4 * F.lane;
#pragma unroll
                    for (int j = 0; j < 4; ++j) *(unsigned*)(o + 256 * j) = cvt4_fp8(v[q][j][0] * A8_SCALE, v[q][j][1] * A8_SCALE, v[q][j][2] * A8_SCALE, v[q][j][3] * A8_SCALE);
                }
                if (P.of) {
                    float* o = P.of + (size_t)row * D + 4 * F.lane;
#pragma unroll
                    for (int j = 0; j < 4; ++j) *(f32x4*)(o + 256 * j) = v[q][j];
                }
            }
            if (P.router) {
                float lg[RG][8];
#pragma unroll
                for (int q = 0; q < RG; ++q)
#pragma unroll
                    for (int e = 0; e < 8; ++e) lg[q][e] = 0.f;
#pragma unroll
                for (int j = 0; j < 4; ++j)
#pragma unroll
                    for (int c = 0; c < 4; ++c) { const LAS f32x4* w = (const LAS f32x4*)(wrl + (4 * F.lane + 256 * j + c) * 8); const f32x4 w0 = w[0], w1 = w[1];
#pragma unroll
                        for (int q = 0; q < RG; ++q) { const float h = v[q][j][c];
                            lg[q][0] += h * w0[0]; lg[q][1] += h * w0[1]; lg[q][2] += h * w0[2]; lg[q][3] += h * w0[3]; lg[q][4] += h * w1[0]; lg[q][5] += h * w1[1]; lg[q][6] += h * w1[2]; lg[q][7] += h * w1[3]; } }
#pragma unroll
                for (int q = 0; q < RG; ++q) {
                    const int row = rowb + q;
#pragma unroll
                    for (int e = 0; e < 8; ++e) lg[q][e] = wave_sum(lg[q][e]);
                    int e0 = 0; float b0 = lg[q][0];
#pragma unroll
                    for (int e = 1; e < 8; ++e) if (lg[q][e] > b0) { b0 = lg[q][e]; e0 = e; }
                    int e1 = -1; float b1 = -INFINITY;
#pragma unroll
                    for (int e = 0; e < 8; ++e) if (e != e0 && lg[q][e] > b1) { b1 = lg[q][e]; e1 = e; }
                    if (e1 < 0) { e1 = (e0 + 1) & 7; b1 = b0; }
                    const float g0 = 1.0f / (1.0f + expf(b1 - b0));
                    if (F.lane == 0) { e01g[row] = e0 | (e1 << 8); gatew[2 * row] = g0; gatew[2 * row + 1] = 1.0f - g0; lds_add(&hist[e0], 1); lds_add(&hist[e1], 1); }
                }
            }
        }
        __syncthreads();
        if (P.router) { if (F.tid < 8) tcnt[tile * 8 + F.tid] = hist[F.tid]; }
    }
}
__device__ __forceinline__ void phase_memnorm(Frame& F) {
    const int gw = F.bx * NWAVES + F.wave, NGW = F.G * NWAVES;
    bf16* MN = (bf16*)(F.ws + WS_MEMN4);
    const float* memp = INP(1); const float* gbase = INP(5);
    for (int r = gw; r < DEPTH * MROWS; r += NGW) {
        const int L = r / MROWS, row = r - L * MROWS;
        const float* xr = memp + (size_t)row * D + 4 * F.lane; const float* gain = gbase + (size_t)L * D + 4 * F.lane;
        f32x4 v[4]; float s = 0.f;
#pragma unroll
        for (int j = 0; j < 4; ++j) { v[j] = *(const f32x4*)(xr + 256 * j); s += (v[j][0] * v[j][0] + v[j][1] * v[j][1]) + (v[j][2] * v[j][2] + v[j][3] * v[j][3]); }
        const float rstd = 1.0f / sqrtf(wave_sum(s) * (1.0f / D) + RMS_EPS);
        bf16* o = MN + (size_t)r * D + 4 * F.lane;
#pragma unroll
        for (int j = 0; j < 4; ++j) { const f32x4 y = v[j] * rstd * *(const f32x4*)(gain + 256 * j); u32x2 w; w.x = pk2(y[0], y[1]); w.y = pk2(y[2], y[3]); *(u32x2*)(o + 256 * j) = w; }
    }
}

__device__ __forceinline__ void phase_moe_assign(Frame& F) {
    LAS int* sc = (LAS int*)(F.misc + MISC_SCR);
    LAS int* dst = (LAS int*)(F.lds);
    const int* tcnt = (const int*)(F.ws + WS_TCNT); const int* e01g = (const int*)(F.ws + WS_E01);
    int* posg = (int*)(F.ws + WS_POS); int* texp = (int*)(F.ws + WS_TEXP);
    const unsigned char* HB8 = F.ws + WS_HB; unsigned char* GA8 = F.ws + WS_GA8;
    const int tstart = (F.G == 256) ? ((F.bx & 7) * 32 + (F.bx >> 3)) : F.bx, tstride = (F.G == 256) ? M / 256 : F.G;
    for (int tile = tstart; tile < M / 256; tile += tstride) {
        __syncthreads();
        if (F.tid < 80) sc[F.tid] = 0;
        __syncthreads();
        if (F.tid < 256) {
            const int j = F.tid;
#pragma unroll
            for (int e = 0; e < 8; ++e) { const int c = tcnt[j * 8 + e]; lds_add(&sc[e], c); if (j < tile) lds_add(&sc[8 + e], c); }
        }
        __syncthreads();
        if (F.tid == 0) { int ps = 0; for (int e = 0; e < 8; ++e) { sc[64 + e] = ps; sc[16 + e] = ps + sc[8 + e]; ps += (sc[e] + 255) & ~255; } sc[72] = ps; }
        __syncthreads();
        if (tile == 0 && F.tid < 8) {
            const int e = F.tid; const int t0 = sc[64 + e] >> 8, t1 = (e == 7 ? sc[72] : sc[64 + e + 1]) >> 8;
            for (int t = t0; t < t1; ++t) texp[t] = e;
            if (e == 7) texp[MAXTILES] = sc[72] >> 8;
        }
        int e0 = 0, e1 = 0, r0 = 0, r1 = 0;
        if (F.tid < 256) {
            const int w = F.tid >> 6; const int pk = e01g[tile * 256 + F.tid]; e0 = pk & 255; e1 = pk >> 8;
            const unsigned long long below = (1ull << F.lane) - 1ull;
#pragma unroll
            for (int e = 0; e < 8; ++e) {
                const unsigned long long m0 = __ballot(e0 == e), m1 = __ballot(e1 == e);
                const int rk = __popcll(m0 & below) + __popcll(m1 & below);
                if (e0 == e) r0 = rk; if (e1 == e) r1 = rk;
                if (F.lane == 0) sc[32 + w * 8 + e] = __popcll(m0) + __popcll(m1);
            }
        }
        __syncthreads();
        if (F.tid < 256) {
            const int w = F.tid >> 6; int b0 = sc[16 + e0], b1 = sc[16 + e1];
            for (int ww = 0; ww < w; ++ww) { b0 += sc[32 + ww * 8 + e0]; b1 += sc[32 + ww * 8 + e1]; }
            const int d0 = b0 + r0, d1 = b1 + r1;
            dst[2 * F.tid] = d0; dst[2 * F.tid + 1] = d1;
            posg[2 * (tile * 256 + F.tid)] = d0; posg[2 * (tile * 256 + F.tid) + 1] = d1;
        }
        __syncthreads();
#pragma nounroll
        for (int t0 = F.wave * 32; t0 < F.wave * 32 + 32; t0 += 16) {
            u32x4 v[16];
#pragma unroll
            for (int j = 0; j < 16; ++j) v[j] = ((const u32x4*)(HB8 + (size_t)(tile * 256 + t0 + j) * D))[F.lane];
#pragma unroll
            for (int j = 0; j < 16; ++j) { const int d0 = dst[2 * (t0 + j)], d1 = dst[2 * (t0 + j) + 1];
                ((u32x4*)(GA8 + (size_t)d0 * D))[F.lane] = v[j]; ((u32x4*)(GA8 + (size_t)d1 * D))[F.lane] = v[j]; }
        }
    }
}

namespace att {
constexpr int L_OS = 0, L_MS = 32768, L_LS = 33792, L_SSQ = 34816, L_RPB = 51200, L_KV = 62976, KV_WAVE = 8832, KT_BYTES = 4608;
static_assert(L_KV + 8 * KV_WAVE <= MISC_OFF, "attention LDS map");
__device__ __forceinline__ f32x4 mfma16(bf16x8 a, bf16x8 b, f32x4 c) { return __builtin_amdgcn_mfma_f32_16x16x32_bf16(a, b, c, 0, 0, 0); }
__device__ __forceinline__ v4i16_t vtr(const LAS unsigned char* p) { return __builtin_amdgcn_ds_read_tr16_b64_v4i16((LAS v4i16_t*)p); }

struct St { float m, lp; f32x4 o[4]; };
__device__ __forceinline__ void st_init(St& s) { s.m = -1e30f; s.lp = 0.f;
#pragma unroll
    for (int d = 0; d < 4; ++d) s.o[d] = (f32x4){0.f, 0.f, 0.f, 0.f}; }

struct Ld { u32x4 k0, k1, k2, k3, v0, v1, v2, v3; };
__device__ __forceinline__ void ld_issue8(Ld& L, const bf16* k0p, const bf16* k1p, const bf16* k2p, const bf16* k3p, const bf16* v0p, const bf16* v1p, const bf16* v2p, const bf16* v3p) {
    L.k0 = *(const u32x4*)(k0p); L.k1 = *(const u32x4*)(k1p); L.k2 = *(const u32x4*)(k2p); L.k3 = *(const u32x4*)(k3p);
    L.v0 = *(const u32x4*)(v0p); L.v1 = *(const u32x4*)(v1p); L.v2 = *(const u32x4*)(v2p); L.v3 = *(const u32x4*)(v3p);
}
__device__ __forceinline__ void ld_issue(Ld& L, const bf16* kp, const bf16* vp, size_t r8) { ld_issue8(L, kp, kp + r8, kp + 2 * r8, kp + 3 * r8, vp, vp + r8, vp + 2 * r8, vp + 3 * r8); }
constexpr int VPL = 1056;
struct Kf { bf16x8 k00, k01, k10, k11; };
__device__ __forceinline__ void stage_kv(const Ld& L, LAS unsigned char* kvl, int lane) {
    LAS unsigned char* kw = kvl + (lane >> 3) * 144 + (lane & 7) * 16;
    *(LAS u32x4*)(kw) = L.k0; *(LAS u32x4*)(kw + 1152) = L.k1; *(LAS u32x4*)(kw + 2304) = L.k2; *(LAS u32x4*)(kw + 3456) = L.k3;
    const int c = lane & 7; LAS unsigned char* vw = kvl + KT_BYTES + (c >> 1) * VPL + (lane >> 3) * 32 + (c & 1) * 16;
    *(LAS u32x4*)(vw) = L.v0; *(LAS u32x4*)(vw + 256) = L.v1; *(LAS u32x4*)(vw + 512) = L.v2; *(LAS u32x4*)(vw + 768) = L.v3;
}
__device__ __forceinline__ Kf kf_read(const LAS unsigned char* kvl, int lq, int lg) {
    const LAS unsigned char* p = kvl + lq * 144 + lg * 16; Kf k;
    k.k00 = *(const LAS bf16x8*)(p); k.k01 = *(const LAS bf16x8*)(p + 64); k.k10 = *(const LAS bf16x8*)(p + 16 * 144); k.k11 = *(const LAS bf16x8*)(p + 16 * 144 + 64); return k;
}
__device__ __forceinline__ void qk(const Kf& L, const bf16x8 (&q)[2], f32x4& s0, f32x4& s1) {
    const f32x4 z = (f32x4){0.f, 0.f, 0.f, 0.f};
    s0 = mfma16(L.k00, q[0], z); s0 = mfma16(L.k01, q[1], s0); s1 = mfma16(L.k10, q[0], z); s1 = mfma16(L.k11, q[1], s1);
}
__device__ __forceinline__ void soft_pv(f32x4 s0, f32x4 s1, const LAS unsigned char* vl, int lq, int lg, St& S) {
    const float mx = vmax2(vmax3(s0[0], s0[1], s0[2]), vmax3(vmax3(s0[3], s1[0], s1[1]), s1[2], s1[3]));
    if (__any(mx > S.m + 8.0f)) {
        float mf = vmax2(mx, __shfl_xor(mx, 16)); mf = vmax2(mf, __shfl_xor(mf, 32));
        const float mn = vmax2(S.m, mf); const float alpha = __builtin_amdgcn_exp2f(S.m - mn); S.m = mn;
        S.lp *= alpha;
#pragma unroll
        for (int d = 0; d < 4; ++d) S.o[d] = S.o[d] * alpha;
    }
    const float mn = S.m;
    float p[8];
#pragma unroll
    for (int r = 0; r < 4; ++r) { p[r] = __builtin_amdgcn_exp2f(s0[r] - mn); p[4 + r] = __builtin_amdgcn_exp2f(s1[r] - mn); }
    S.lp += ((p[0] + p[1]) + (p[2] + p[3])) + ((p[4] + p[5]) + (p[6] + p[7]));
    u32x4 pw; pw.x = pg8::cvt_pk_bf16(p[0], p[1]); pw.y = pg8::cvt_pk_bf16(p[2], p[3]); pw.z = pg8::cvt_pk_bf16(p[4], p[5]); pw.w = pg8::cvt_pk_bf16(p[6], p[7]);
    const bf16x8 pf = __builtin_bit_cast(bf16x8, pw);
    const LAS unsigned char* tb = vl + KT_BYTES + (4 * lg + (lq >> 2)) * 32 + 8 * (lq & 3);
#pragma unroll
    for (int d = 0; d < 4; ++d) {
        const v4i16_t lo = vtr(tb + d * VPL), hi = vtr(tb + d * VPL + 512);
        const bf16x8 vf = (bf16x8){lo[0], lo[1], lo[2], lo[3], hi[0], hi[1], hi[2], hi[3]};
        S.o[d] = mfma16(vf, pf, S.o[d]);
    }
}
template <int NT>
__device__ __forceinline__ void multi_soft_pv(f32x4 (&s0)[NT], f32x4 (&s1)[NT], const LAS unsigned char* vl, int lq, int lg, St (&S)[NT], const int am = -1) {
    float mx[NT]; bool trig = false;
#pragma unroll
    for (int t = 0; t < NT; ++t) if (am & (1 << t)) { mx[t] = vmax2(vmax3(s0[t][0], s0[t][1], s0[t][2]), vmax3(vmax3(s0[t][3], s1[t][0], s1[t][1]), s1[t][2], s1[t][3])); trig = trig || (mx[t] > S[t].m + 8.0f); }
    if (__any(trig)) {
#pragma unroll
        for (int t = 0; t < NT; ++t) if (am & (1 << t)) {
            float mf = vmax2(mx[t], __shfl_xor(mx[t], 16)); mf = vmax2(mf, __shfl_xor(mf, 32));
            const float mn = vmax2(S[t].m, mf); const float alpha = __builtin_amdgcn_exp2f(S[t].m - mn); S[t].m = mn; S[t].lp *= alpha;
#pragma unroll
            for (int d = 0; d < 4; ++d) S[t].o[d] = S[t].o[d] * alpha;
        }
    }
    bf16x8 pf[NT];
#pragma unroll
    for (int t = 0; t < NT; ++t) if (am & (1 << t)) {
        const float mn = S[t].m; float p[8];
#pragma unroll
        for (int r = 0; r < 4; ++r) { p[r] = __builtin_amdgcn_exp2f(s0[t][r] - mn); p[4 + r] = __builtin_amdgcn_exp2f(s1[t][r] - mn); }
        S[t].lp += ((p[0] + p[1]) + (p[2] + p[3])) + ((p[4] + p[5]) + (p[6] + p[7]));
        u32x4 pw; pw.x = pg8::cvt_pk_bf16(p[0], p[1]); pw.y = pg8::cvt_pk_bf16(p[2], p[3]); pw.z = pg8::cvt_pk_bf16(p[4], p[5]); pw.w = pg8::cvt_pk_bf16(p[6], p[7]);
        pf[t] = __builtin_bit_cast(bf16x8, pw);
    }
    const LAS unsigned char* tb = vl + KT_BYTES + (4 * lg + (lq >> 2)) * 32 + 8 * (lq & 3);
#pragma unroll
    for (int d = 0; d < 4; ++d) {
        const v4i16_t lo = vtr(tb + d * VPL), hi = vtr(tb + d * VPL + 512);
        const bf16x8 vf = (bf16x8){lo[0], lo[1], lo[2], lo[3], hi[0], hi[1], hi[2], hi[3]};
#pragma unroll
        for (int t = 0; t < NT; ++t) if (am & (1 << t)) S[t].o[d] = mfma16(vf, pf[t], S[t].o[d]);
    }
}
__device__ __forceinline__ float lsum(float lp) { lp += __shfl_xor(lp, 16); lp += __shfl_xor(lp, 32); return lp; }

__device__ __forceinline__ void finish(const St& S, float l, bf16* yrow  , LAS float* ssq_slot, int lg) {
    const float inv = 1.0f / l; float ss = 0.f;
#pragma unroll
    for (int d = 0; d < 4; ++d) { const f32x4 v = S.o[d] * inv; ss += (v[0] * v[0] + v[1] * v[1]) + (v[2] * v[2] + v[3] * v[3]);
        u32x2 w; w.x = pg8::cvt_pk_bf16(v[0], v[1]); w.y = pg8::cvt_pk_bf16(v[2], v[3]); *(u32x2*)(yrow + 16 * d + 4 * lg) = w; }
    ss += __shfl_xor(ss, 16); ss += __shfl_xor(ss, 32);
    if (lg == 0) *ssq_slot = ss;
}

__device__ __forceinline__ void attn_unit(Frame& F, int b, int t0, int layer) {
    LAS unsigned char* lds = F.lds;
    int lane = F.lane, lq = lane & 15, lg = lane >> 4; const int wave = F.wave;
#define RELANE() do { asm volatile("" : "+v"(lane)); lq = lane & 15; lg = lane >> 4; } while (0)
    const bf16* QKV = (const bf16*)(F.ws + WS_BIG); const bf16* MKV = (const bf16*)(F.ws + WS_MEMKV4) + (size_t)layer * MROWS * 512; bf16* Y = (bf16*)(F.ws + WS_HB);
    LAS bf16* Os = (LAS bf16*)(lds + L_OS); LAS float* Ms = (LAS float*)(lds + L_MS); LAS float* Ls = (LAS float*)(lds + L_LS);
    LAS float* ssq = (LAS float*)(lds + L_SSQ); LAS float* rpb = (LAS float*)(lds + L_RPB);
    LAS unsigned char* vl = lds + L_KV + wave * KV_WAVE;
    const size_t rowb = (size_t)b * T;
    { const float* rp = INP(4) + (size_t)layer * 6 * 465; for (int i = F.tid; i < 6 * 480; i += 512) { const int hh = i / 480, rem = i - hh * 480, ro = rem >> 5, co = rem & 31; rpb[i] = co < 31 ? rp[hh * 465 + ro * 31 + co] * LOG2E : -INFINITY; } }
    __syncthreads();
    const int R0 = t0 >> 6;
#pragma nounroll
    for (int pass = 0; pass < 3; ++pass) {
        RELANE();
        const int h = 2 * pass + (wave >> 2), kq = wave & 3;
        const int qc = 16 * kq + lq, cs = (kq == 0) ? 0 : (kq == 1) ? 8 : (kq == 2) ? 24 : 32;
        int c0q = qc - 8; c0q = c0q < 0 ? 0 : (c0q > 48 ? 48 : c0q);
        unsigned bcol[8];
#pragma unroll
        for (int e = 0; e < 8; ++e) { const int c = cs + 16 * (e >> 2) + 4 * lg + (e & 3); const bool ok = (c >= c0q) && (c <= c0q + 15);
            bcol[e] = (unsigned)(uintptr_t)(rpb + h * 480) + 4u * (unsigned)(ok ? (c - qc + 15) : 31); }
        int r0v[4]; bf16x8 qf[4][2]; St S[4];
#pragma unroll
        for (int rr = 0; rr < 4; ++rr) { const int r = R0 + rr; int r0 = r - 4; r0 = r0 < 0 ? 0 : (r0 > 120 ? 120 : r0); r0v[rr] = r0;
            const size_t qrow = rowb + (size_t)r * 64 + qc;
            qf[rr][0] = *(const bf16x8*)(QKV + qrow * NQKV + OFF_QA + h * 64 + lg * 8); qf[rr][1] = *(const bf16x8*)(QKV + qrow * NQKV + OFF_QA + h * 64 + 32 + lg * 8);
            st_init(S[rr]); }
        const int krmin = r0v[0], nrows = r0v[3] + 8 - krmin;
        const bf16* kbase = QKV + (rowb + (size_t)krmin * 64 + cs + (lane >> 3)) * NQKV + OFF_KA + h * 64 + (lane & 7) * 8;
        const bf16* vbase = kbase + (OFF_VA - OFF_KA);
        const size_t v8 = (size_t)8 * NQKV;
        const size_t rstep = (size_t)64 * NQKV;
        auto na_row = [&](int kr) {
            const Kf kf = kf_read(vl, lq, lg);
            f32x4 s0[4], s1[4];
            int am = 0;
#pragma unroll
            for (int rr = 0; rr < 4; ++rr) am |= (kr >= r0v[rr] && kr < r0v[rr] + 8) ? (1 << rr) : 0;
            am = __builtin_amdgcn_readfirstlane(am);
#pragma unroll
            for (int rr = 0; rr < 4; ++rr) if (am & (1 << rr)) {
                const unsigned ro = (unsigned)(kr - (R0 + rr) + 7) * 128u;
                f32x4 a0, a1;
#pragma unroll
                for (int e = 0; e < 4; ++e) { a0[e] = *(const LAS float*)(uintptr_t)(bcol[e] + ro); a1[e] = *(const LAS float*)(uintptr_t)(bcol[4 + e] + ro); }
                qk(kf, qf[rr], s0[rr], s1[rr]);
                s0[rr] = s0[rr] + a0; s1[rr] = s1[rr] + a1;
            }
            multi_soft_pv<4>(s0, s1, vl, lq, lg, S, am);
            asm volatile("" ::: "memory");
        };
        Ld LA;
        ld_issue(LA, kbase, vbase, v8);
#pragma nounroll
        for (int j = 0; j < nrows; ++j) {
            stage_kv(LA, vl, lane);
            asm volatile("" ::: "memory");
            { const int jn = (j + 1 < nrows) ? j + 1 : nrows - 1; ld_issue(LA, kbase + (size_t)jn * rstep, vbase + (size_t)jn * rstep, v8); }
            na_row(krmin + j);
        }
#pragma unroll
        for (int rr = 0; rr < 4; ++rr) { const float l = lsum(S[rr].lp);
            finish(S[rr], l, Y + (rowb + (size_t)(R0 + rr) * 64 + qc) * D + h * 64, ssq + h * 256 + (rr * 64 + qc), lg); }
    }
#pragma nounroll
    for (int pass = 0; pass < 2; ++pass) {
        RELANE();
        const int h = 2 * pass + (wave >> 2), j0 = 4 * (wave & 3);
        bf16x8 qf[4][2]; St S[4];
#pragma unroll
        for (int t = 0; t < 4; ++t) { const size_t qrow = rowb + t0 + 16 * (j0 + t) + lq;
            qf[t][0] = *(const bf16x8*)(QKV + qrow * NQKV + OFF_QM + h * 64 + lg * 8); qf[t][1] = *(const bf16x8*)(QKV + qrow * NQKV + OFF_QM + h * 64 + 32 + lg * 8);
            st_init(S[t]); }
        const bf16* kbase = MKV + ((size_t)b * NMEM + (lane >> 3)) * 512 + h * 64 + (lane & 7) * 8;
        const bf16* vbase = kbase + 256;
        Ld LA;
        ld_issue(LA, kbase, vbase, (size_t)8 * 512);
#pragma nounroll
        for (int s = 0; s < 8; ++s) {
            stage_kv(LA, vl, lane);
            asm volatile("" ::: "memory");
            { const int sn = (s + 1 < 8) ? s + 1 : 7; ld_issue(LA, kbase + sn * 32 * 512, vbase + sn * 32 * 512, (size_t)8 * 512); }
            const Kf kf = kf_read(vl, lq, lg);
            f32x4 s0[4], s1[4];
#pragma unroll
            for (int t = 0; t < 4; ++t) qk(kf, qf[t], s0[t], s1[t]);
            multi_soft_pv<4>(s0, s1, vl, lq, lg, S);
            asm volatile("" ::: "memory");
        }
#pragma unroll
        for (int t = 0; t < 4; ++t) { const int idx = 16 * (j0 + t) + lq; const float l = lsum(S[t].lp);
            finish(S[t], l, Y + (rowb + t0 + idx) * D + 768 + h * 64, ssq + (12 + h) * 256 + idx, lg); }
    }
    __syncthreads();
    for (int h = 0; h < 6; ++h) {
#pragma nounroll
        for (int br = 0; br < 2; ++br) {
            RELANE();
            const int sh = 2 * br, dl = 1 << sh, seg = T >> sh;
            const int res = br ? (wave >> 1) : 0, m0 = br ? ((t0 >> 2) + 32 * (wave & 1)) : (t0 + 32 * wave);
            bf16x8 qf[2][2]; St S[2]; int idxv[2];
#pragma unroll
            for (int t = 0; t < 2; ++t) { const size_t qrow = rowb + (size_t)(m0 + 16 * t + lq) * dl + res;
                qf[t][0] = *(const bf16x8*)(QKV + qrow * NQKV + OFF_QB + h * 64 + lg * 8); qf[t][1] = *(const bf16x8*)(QKV + qrow * NQKV + OFF_QB + h * 64 + 32 + lg * 8);
                st_init(S[t]); idxv[t] = br ? (128 * (wave & 1) + 64 * t + 4 * lq + res) : (32 * wave + 16 * t + lq); }
            const bool edge = (m0 - 64 < 0) || (m0 + 95 >= seg);
            auto dload = [&](Ld& L, int s) {
                const int kb = m0 - 64 + 32 * s;
                int kv = kb + (lane >> 3);
                const bf16* kcol = QKV + (rowb + res) * NQKV + OFF_KB + h * 64 + (lane & 7) * 8; const bf16* vcol = kcol + (OFF_VB - OFF_KB);
                const size_t rs = (size_t)dl * NQKV;
                if (edge) {
                    int v0 = kv, v1 = kv + 8, v2 = kv + 16, v3 = kv + 24;
                    v0 = v0 < 0 ? 0 : (v0 >= seg ? seg - 1 : v0); v1 = v1 < 0 ? 0 : (v1 >= seg ? seg - 1 : v1); v2 = v2 < 0 ? 0 : (v2 >= seg ? seg - 1 : v2); v3 = v3 < 0 ? 0 : (v3 >= seg ? seg - 1 : v3);
                    ld_issue8(L, kcol + (size_t)v0 * rs, kcol + (size_t)v1 * rs, kcol + (size_t)v2 * rs, kcol + (size_t)v3 * rs, vcol + (size_t)v0 * rs, vcol + (size_t)v1 * rs, vcol + (size_t)v2 * rs, vcol + (size_t)v3 * rs);
                } else ld_issue(L, kcol + (size_t)kv * rs, vcol + (size_t)kv * rs, 8 * rs); };
            auto dstep = [&](int s) {
                const Kf kf = kf_read(vl, lq, lg);
                const int kb = m0 - 64 + 32 * s;
                f32x4 s0[2], s1[2];
#pragma unroll
                for (int t = 0; t < 2; ++t) {
                    qk(kf, qf[t], s0[t], s1[t]);
                    if (edge || s == 0 || s == 4) {
                        const int qm = m0 + 16 * t + lq;
#pragma unroll
                        for (int e = 0; e < 8; ++e) { const int km = kb + 16 * (e >> 2) + 4 * lg + (e & 3); const int dd = km - qm;
                            const bool ok = (km >= 0) && (km < seg) && (dd >= -64) && (dd <= 64); if (!ok) { if (e < 4) s0[t][e] = -INFINITY; else s1[t][e - 4] = -INFINITY; } }
                    }
                }
                multi_soft_pv<2>(s0, s1, vl, lq, lg, S);
                asm volatile("" ::: "memory");
            };
            { Ld LA;
              dload(LA, 0);
#pragma nounroll
              for (int s = 0; s < 5; ++s) {
                  stage_kv(LA, vl, lane);
                  asm volatile("" ::: "memory");
                  dload(LA, s + 1 < 5 ? s + 1 : 4);
                  dstep(s);
              } }
#pragma unroll
            for (int t = 0; t < 2; ++t) {
                const int idx = idxv[t]; float l = lsum(S[t].lp);
                LAS u32x2* osr = (LAS u32x2*)(Os + idx * 64 + 4 * lg);
                if (br > 0) {
                    const float m1 = Ms[idx], l1 = Ls[idx]; const float mn = vmax2(S[t].m, m1);
                    const float a1 = __builtin_amdgcn_exp2f(m1 - mn), a2 = __builtin_amdgcn_exp2f(S[t].m - mn);
#pragma unroll
                    for (int d = 0; d < 4; ++d) { const u32x2 w = osr[4 * d]; const f32x4 o1 = (f32x4){bf_lo(w.x), bf_hi(w.x), bf_lo(w.y), bf_hi(w.y)}; S[t].o[d] = o1 * a1 + S[t].o[d] * a2; }
                    l = l1 * a1 + l * a2; S[t].m = mn;
                }
#pragma unroll
                for (int d = 0; d < 4; ++d) { u32x2 w; w.x = pg8::cvt_pk_bf16(S[t].o[d][0], S[t].o[d][1]); w.y = pg8::cvt_pk_bf16(S[t].o[d][2], S[t].o[d][3]); osr[4 * d] = w; }
                if (lg == 0) { Ms[idx] = S[t].m; Ls[idx] = l; }
            }
            __syncthreads();
        }
        {
            constexpr int dl = 16, seg = T >> 4;
#pragma nounroll
            for (int tix = wave; tix < 16; tix += 8) {
                RELANE();
                const int res = tix, m0 = t0 >> 4, idx = 16 * lq + res;
                const size_t qrow = rowb + (size_t)(m0 + lq) * dl + res;
                bf16x8 qf[2];
                qf[0] = *(const bf16x8*)(QKV + qrow * NQKV + OFF_QB + h * 64 + lg * 8); qf[1] = *(const bf16x8*)(QKV + qrow * NQKV + OFF_QB + h * 64 + 32 + lg * 8);
                St S; st_init(S);
                const int qm = m0 + lq;
                const bool edge = (m0 - 64 < 0) || (m0 + 95 >= seg);
                auto dload = [&](Ld& L, int s) {
                    const int kb = m0 - 64 + 32 * s;
                    int kv = kb + (lane >> 3);
                    const bf16* kcol = QKV + (rowb + res) * NQKV + OFF_KB + h * 64 + (lane & 7) * 8; const bf16* vcol = kcol + (OFF_VB - OFF_KB);
                    const size_t rs = (size_t)dl * NQKV;
                    if (edge) {
                        int v0 = kv, v1 = kv + 8, v2 = kv + 16, v3 = kv + 24;
                        v0 = v0 < 0 ? 0 : (v0 >= seg ? seg - 1 : v0); v1 = v1 < 0 ? 0 : (v1 >= seg ? seg - 1 : v1); v2 = v2 < 0 ? 0 : (v2 >= seg ? seg - 1 : v2); v3 = v3 < 0 ? 0 : (v3 >= seg ? seg - 1 : v3);
                        ld_issue8(L, kcol + (size_t)v0 * rs, kcol + (size_t)v1 * rs, kcol + (size_t)v2 * rs, kcol + (size_t)v3 * rs, vcol + (size_t)v0 * rs, vcol + (size_t)v1 * rs, vcol + (size_t)v2 * rs, vcol + (size_t)v3 * rs);
                    } else ld_issue(L, kcol + (size_t)kv * rs, vcol + (size_t)kv * rs, 8 * rs); };
                auto dstep = [&](int s) {
                    const Kf kf = kf_read(vl, lq, lg);
                    const int kb = m0 - 64 + 32 * s;
                    f32x4 s0, s1; qk(kf, qf, s0, s1);
                    if (edge || s == 0 || s == 4) {
#pragma unroll
                        for (int e = 0; e < 8; ++e) { const int km = kb + 16 * (e >> 2) + 4 * lg + (e & 3); const int dd = km - qm;
                            const bool ok = (km >= 0) && (km < seg) && (dd >= -64) && (dd <= 64); if (!ok) { if (e < 4) s0[e] = -INFINITY; else s1[e - 4] = -INFINITY; } }
                    }
                    soft_pv(s0, s1, vl, lq, lg, S);
                    asm volatile("" ::: "memory");
                };
                { Ld LA;
                  dload(LA, 0);
#pragma nounroll
                  for (int s = 0; s < 5; ++s) {
                      stage_kv(LA, vl, lane);
                      asm volatile("" ::: "memory");
                      dload(LA, s + 1 < 5 ? s + 1 : 4);
                      dstep(s);
                  } }
                float l = lsum(S.lp);
                LAS u32x2* osr = (LAS u32x2*)(Os + idx * 64 + 4 * lg);
                { const float m1 = Ms[idx], l1 = Ls[idx]; const float mn = vmax2(S.m, m1);
                  const float a1 = __builtin_amdgcn_exp2f(m1 - mn), a2 = __builtin_amdgcn_exp2f(S.m - mn);
#pragma unroll
                  for (int d = 0; d < 4; ++d) { const u32x2 w = osr[4 * d]; const f32x4 o1 = (f32x4){bf_lo(w.x), bf_hi(w.x), bf_lo(w.y), bf_hi(w.y)}; S.o[d] = o1 * a1 + S.o[d] * a2; }
                  l = l1 * a1 + l * a2; S.m = mn; }
                finish(S, l, Y + qrow * D + 384 + h * 64, ssq + (6 + h) * 256 + idx, lg);
            }
            __syncthreads();
        }
    }
    VM_WAIT(); __syncthreads();
    RELANE();
    {
        const float* gm = INP(7) + (size_t)layer * D;
        const int c0 = 8 * lane, c1 = 512 + 8 * lane;
        const int g0 = c0 < 384 ? 0 : 1, g1 = c1 < 768 ? 1 : 2;
        f32x4 ga[2], gb[2];
        ga[0] = *(const f32x4*)(gm + c0); ga[1] = *(const f32x4*)(gm + c0 + 4); gb[0] = *(const f32x4*)(gm + c1); gb[1] = *(const f32x4*)(gm + c1 + 4);
#pragma nounroll
        for (int i0 = 0; i0 < 32; i0 += 4) {
            u32x4 w0[4], w1[4]; float s0v[4], s1v[4];
#pragma unroll
            for (int q = 0; q < 4; ++q) { const bf16* yr = Y + (rowb + t0 + wave * 32 + i0 + q) * D; w0[q] = *(const u32x4*)(yr + c0); w1[q] = *(const u32x4*)(yr + c1); }
#pragma unroll
            for (int q = 0; q < 4; ++q) {
                const int idx = wave * 32 + i0 + q;
                float sa = 0.f, sb = 0.f, sm = 0.f;
#pragma unroll
                for (int hh = 0; hh < 6; ++hh) { sa += ssq[hh * 256 + idx]; sb += ssq[(6 + hh) * 256 + idx]; }
#pragma unroll
                for (int hh = 0; hh < 4; ++hh) sm += ssq[(12 + hh) * 256 + idx];
                const float ra = 1.0f / sqrtf(sa * (1.0f / 384.f) + RMS_EPS), rb = 1.0f / sqrtf(sb * (1.0f / 384.f) + RMS_EPS), rm = 1.0f / sqrtf(sm * (1.0f / 256.f) + RMS_EPS);
                s0v[q] = g0 == 0 ? ra : rb; s1v[q] = g1 == 1 ? rb : rm;
            }
#pragma unroll
            for (int q = 0; q < 4; ++q) {
                bf16* yr = Y + (rowb + t0 + wave * 32 + i0 + q) * D; const float s0 = s0v[q], s1 = s1v[q]; const u32x4 a = w0[q], bb = w1[q];
                u32x4 o0, o1;
                o0.x = pk2(bf_lo(a.x) * s0 * ga[0][0], bf_hi(a.x) * s0 * ga[0][1]); o0.y = pk2(bf_lo(a.y) * s0 * ga[0][2], bf_hi(a.y) * s0 * ga[0][3]);
                o0.z = pk2(bf_lo(a.z) * s0 * ga[1][0], bf_hi(a.z) * s0 * ga[1][1]); o0.w = pk2(bf_lo(a.w) * s0 * ga[1][2], bf_hi(a.w) * s0 * ga[1][3]);
                o1.x = pk2(bf_lo(bb.x) * s1 * gb[0][0], bf_hi(bb.x) * s1 * gb[0][1]); o1.y = pk2(bf_lo(bb.y) * s1 * gb[0][2], bf_hi(bb.y) * s1 * gb[0][3]);
                o1.z = pk2(bf_lo(bb.z) * s1 * gb[1][0], bf_hi(bb.z) * s1 * gb[1][1]); o1.w = pk2(bf_lo(bb.w) * s1 * gb[1][2], bf_hi(bb.w) * s1 * gb[1][3]);
                *(u32x4*)(yr + c0) = o0; *(u32x4*)(yr + c1) = o1;
            }
        }
    }
    __syncthreads();
}
}

#ifdef NO_G1
#define GEMM_SITE1(x)
#else
#define GEMM_SITE1(x) x
#endif
#ifdef NO_G2
#define GEMM_SITE2(x)
#else
#define GEMM_SITE2(x) x
#endif
#ifdef NO_G3
#define GEMM_SITE3(x)
#else
#define GEMM_SITE3(x) x
#endif
#ifdef NO_G4
#define GEMM_SITE4(x)
#else
#define GEMM_SITE4(x) x
#endif
#ifdef NO_G5
#define GEMM_SITE5(x)
#else
#define GEMM_SITE5(x) x
#endif
#ifdef NO_G6
#define GEMM_SITE6(x)
#else
#define GEMM_SITE6(x) x
#endif
#ifdef NO_G7
#define GEMM_SITE7(x)
#else
#define GEMM_SITE7(x) x
#endif
struct Args { const float* in[18]; float* out; unsigned char* ws; int ph_lo, ph_hi, use_bar, pad; };
constexpr int PH_PER_LAYER = 16, SEQ_FINAL = 1 + DEPTH * PH_PER_LAYER, SEQ_END = SEQ_FINAL + 1;

__global__ void __launch_bounds__(NWAVES * 64, 2) fwd_kernel(Args args) {
    extern __shared__ __attribute__((aligned(16))) unsigned char lds_raw[];
    Frame F;
    F.lds = (LAS unsigned char*)lds_raw; F.misc = F.lds + MISC_OFF;
    F.tid = threadIdx.x; F.lane = F.tid & 63; F.wave = __builtin_amdgcn_readfirstlane(F.tid >> 6);
    F.G = gridDim.x; F.bx = blockIdx.x; F.ws = args.ws; F.out = args.out;
    if (F.tid == 0) {
#pragma unroll
        for (int i = 0; i < 18; ++i) ((LAS unsigned long long*)(F.misc + MISC_PTAB))[i] = (unsigned long long)args.in[i];
        ((LAS unsigned long long*)(F.misc + MISC_PTAB))[18] = (unsigned long long)args.ws; ((LAS unsigned long long*)(F.misc + MISC_PTAB))[19] = (unsigned long long)args.out;
    }
    gu32* ctl = (gu32*)(F.ws + WS_CTL);
    if (F.tid < 4) ((LAS unsigned*)(F.misc + MISC_BARW))[F.tid] = 0u;
    __syncthreads();
    XcdBarrier bar; bar.bar = (unsigned*)(ctl + CW_BAR); bar.x = 0; bar.st = nullptr;
    if (args.use_bar) { bar = xcd_barrier_post((unsigned*)(ctl + CW_BAR), (volatile LAS unsigned*)(F.misc + MISC_BARW)); if (F.tid == 0) ((volatile LAS unsigned*)(F.misc + MISC_BARW))[2] = bar.x; __syncthreads(); }
    const int lo = args.ph_lo, hi = args.ph_hi;
#define IN(k) (lo <= (k) && (k) < hi)
#define LAUNDER() do { unsigned lb_ = (unsigned)(uintptr_t)(LAS unsigned char*)lds_raw; asm volatile("" : "+v"(lb_)); lb_ = (unsigned)__builtin_amdgcn_readfirstlane((int)lb_); F.lds = (LAS unsigned char*)(uintptr_t)lb_; F.misc = F.lds + MISC_OFF; \
    F.ws = (unsigned char*)inp_ptr(F.misc, 18); F.out = (float*)inp_ptr(F.misc, 19); asm volatile("" : "+v"(F.tid), "+v"(F.lane)); F.wave = __builtin_amdgcn_readfirstlane(F.tid >> 6); \
    { int bx_ = F.bx, g_ = F.G; asm volatile("" : "+v"(bx_), "+v"(g_)); F.bx = __builtin_amdgcn_readfirstlane(bx_); F.G = __builtin_amdgcn_readfirstlane(g_); } } while (0)
#define SEAM(k) do { if (args.use_bar && (k) + 1 < hi) { XcdBarrier b_; b_.bar = (unsigned*)((unsigned char*)inp_ptr(F.misc, 18) + WS_CTL) + CW_BAR; b_.st = (volatile LAS unsigned*)(F.misc + MISC_BARW); \
        b_.x = (unsigned)__builtin_amdgcn_readfirstlane((int)((volatile LAS unsigned*)(F.misc + MISC_BARW))[2]); xcd_barrier(b_); if (PROBE_BAR2) xcd_barrier(b_); } else { VM_WAIT(); __syncthreads(); } } while (0)

#define HB ((bf16*)(F.ws + WS_HB))
#define QKV ((bf16*)(F.ws + WS_BIG))
    LAS int* texp_l = (LAS int*)(F.misc + MISC_TEXP);

    if (IN(0)) { LAUNDER(); for (int rep = 0; rep < PROBE_CONV_REPS; ++rep) phase_convert(F);
        if (!(args.use_bar && hi > 2)) SEAM(0); }


    for (int L = 0; L < DEPTH; ++L) {
        const int base = 1 + L * PH_PER_LAYER;
        if (hi <= base || lo >= base + PH_PER_LAYER) continue;
        const bool moe = (L & 1) != 0; const int fi = L >> 1;
        const bool f8 = moe || DENSE_UP8(L), f8d = moe || DENSE_DN8(L);
#define wc (F.ws + WS_WC + (size_t)L * WC_STRIDE)
        const int comb = (L > 0 && ((L - 1) & 1)) ? 1 : 0;
        if (IN(base + 0) && (L == 0 || comb)) {
            LAUNDER();
            RowPass P{}; P.xsrc = (L == 0) ? INP(0) : (const float*)nullptr; P.xbf = (const bf16*)F.out; P.combine = comb; P.xdst = (bf16*)F.out; P.gain = INP(2) + (size_t)L * D;
            P.ob = nullptr; P.obp = XP; P.ssq = (float*)(F.ws + WS_SSQ); P.ob8 = nullptr; P.of = nullptr; P.router = 0; P.wr = nullptr;
            phase_rows(F, P);
            if (L == 0) phase_memnorm(F);
            SEAM(base + 0);
        }
        if (IN(base + 1)) {
            LAUNDER();
#if QKV_FP8
            { pg8::Gemm g{HB, (const bf16*)(wc + WC_IN), M, NQKV, D / 2, 0}; pg8::TileOrder S; S.init(M, NQKV, F.G, F.bx, nullptr);
              pg8::EpiQKVT<true> E{QKV, (const float*)(F.ws + WS_COS), (const float*)(F.ws + WS_SIN), ACC8_SCALE};
              GEMM_SITE1(pg8::gemm_phase(F.lds, g, S, E, F.tid)); }
#else
            { pg8::Gemm g{(const bf16*)F.out, (const bf16*)(wc + WC_IN), M, NQKV, D, 0}; pg8::TileOrder S; S.init(M, NQKV, F.G, F.bx, nullptr);
              pg8::EpiQKVT<false> E{QKV, (const float*)(F.ws + WS_COS), (const float*)(F.ws + WS_SIN), 1.0f, (const float*)(F.ws + WS_SSQ), 1};
              GEMM_SITE1(pg8::gemm_phase(F.lds, g, S, E, F.tid)); }
#endif
            if (L == 0) {
                LAUNDER();
                __syncthreads();
                for (int i = F.tid; i < MAXTILES + 8; i += 512) texp_l[i] = i >> 3;
                __syncthreads();
                pg8::Gemm g{(const bf16*)(F.ws + WS_MEMN4), (const bf16*)(F.ws + WS_WC + WC_MKV), DEPTH * MROWS, 512, D, WC_STRIDE}; pg8::TileOrder S; S.init(DEPTH * MROWS, 512, F.G, F.bx, texp_l);
                pg8::EpiPlain E{(bf16*)(F.ws + WS_MEMKV4), 512};
                GEMM_SITE2(pg8::gemm_phase(F.lds, g, S, E, F.tid));
            }
            SEAM(base + 1);
        }
        if (IN(base + 2)) {
            LAUNDER();
#ifndef NO_ATT
            for (int rep = 0; rep < PROBE_ATT_REPS; ++rep)
            for (int v = F.bx; v < M / 256; v += F.G) { const int u = (F.G == 256) ? ((v & 7) * 32 + (v >> 3)) : v;
                att::attn_unit(F, u >> 5, (u & 31) * 256, L); }
#endif
            SEAM(base + 2);
        }
        if (IN(base + 3)) {
            LAUNDER();
            pg8::Gemm g{HB, (const bf16*)(wc + WC_OUT), M, D, D, 0}; pg8::TileOrder S; S.init(M, D, F.G, F.bx, nullptr);
            pg8::EpiResT<false> E{(const float*)nullptr, (bf16*)F.out, nullptr, D, 0, 1.0f};
            GEMM_SITE3(pg8::gemm_phase(F.lds, g, S, E, F.tid));
            SEAM(base + 3);
        }
        if (IN(base + 4)) {
            LAUNDER();
            RowPass P{}; P.xsrc = nullptr; P.xbf = (const bf16*)F.out; P.xdst = nullptr; P.combine = 0; P.gain = INP(9) + (size_t)L * D; P.ob = f8 ? nullptr : HB; P.obp = D; P.ssq = nullptr; P.ob8 = f8 ? (unsigned char*)(F.ws + WS_HB) : nullptr; P.of = nullptr; P.router = moe ? 1 : 0; P.wr = INP(13) + (size_t)fi * D * NE;
            phase_rows(F, P);
            if (PROBE_PE2) { __syncthreads(); phase_rows(F, P); }
            SEAM(base + 4);
        }
        if (moe && IN(base + 5)) { LAUNDER(); phase_moe_assign(F); SEAM(base + 5); }
        int nT = M / 256;
        if (moe && hi > base + 6 && lo < base + 16) nT = __builtin_amdgcn_readfirstlane(((const int*)(F.ws + WS_TEXP))[MAXTILES]);
        nT = nT < 0 ? 0 : (nT > MAXTILES ? MAXTILES : nT);
        const int ntail = (moe && nT > 2 * CHUNK_TILES) ? nT - 2 * CHUNK_TILES : 0;
        const int nsteps = !moe ? 2 : 4;
        for (int k = 0; k < nsteps; ++k) {
            const int pk = base + 6 + k;
            if (!IN(pk)) continue;
            LAUNDER();
            int dc = -1, uc = -1;
            if (!moe) { if (k == 0) uc = 0; else dc = 0; }
            else {
                if (k == 0) uc = 0; else if (k == 1) { dc = 0; uc = ntail ? 2 : -1; } else if (k == 2) { dc = ntail ? 2 : -1; uc = 1; } else dc = 1; }
            {
                __syncthreads();
                const int* tg = (const int*)(F.ws + WS_TEXP);
                for (int i = F.tid; i < MAXTILES + 8; i += 512) texp_l[i] = (moe && i < nT) ? tg[i] : 0;
                __syncthreads();
            }
#define CH_TILE0(ch) (moe ? (ch) * CHUNK_TILES : 0)
#define CH_NTILE(ch) (moe ? ((nT - CH_TILE0(ch)) < CHUNK_TILES ? (nT - CH_TILE0(ch)) : CHUNK_TILES) : M / 256)
#define CH_HID(ch) (moe ? ((ch) == 2 ? (bf16*)(F.ws + WS_MEMN4) : (bf16*)(F.ws + WS_HIDC)) : (bf16*)(F.ws + WS_BIG))
            if (dc >= 0) {
                const int tile0 = CH_TILE0(dc), ntile = CH_NTILE(dc); bf16* hid = CH_HID(dc);
                if (f8d) {
                    pg8::Gemm g{hid, moe ? (const bf16*)(F.ws + WS_WM + (size_t)fi * WM_STRIDE + WM_DOWN) : (const bf16*)(F.ws + WS_WD + (size_t)fi * WD_STRIDE + 14 * MiB), ntile * 256, D, FF / 2, WD8_ESTRIDE};
                    pg8::TileOrder S; S.init(ntile * 256, D, F.G, F.bx, texp_l + tile0);
                    pg8::EpiResT<true> E{nullptr, (bf16*)F.out, (bf16*)(F.ws + WS_GA) + (size_t)tile0 * 256 * D, D, moe ? 1 : 2, ACCD8_SCALE};
                    GEMM_SITE5(pg8::gemm_phase(F.lds, g, S, E, F.tid));
                } else {
                    pg8::Gemm g{hid, (const bf16*)(F.ws + WS_WD + (size_t)fi * WD_STRIDE + 14 * MiB), ntile * 256, D, FF, 0}; pg8::TileOrder S; S.init(ntile * 256, D, F.G, F.bx, texp_l + tile0);
                    pg8::EpiResT<false> E{nullptr, (bf16*)F.out, nullptr, D, 2, 1.0f};
                    GEMM_SITE7(pg8::gemm_phase(F.lds, g, S, E, F.tid));
                }
            }
            if (dc >= 0 && uc >= 0) { LAUNDER(); __syncthreads(); }
            if (uc >= 0) {
                const int tile0 = CH_TILE0(uc), ntile = CH_NTILE(uc); bf16* hid = CH_HID(uc);
                if (f8) {
                    pg8::Gemm g{moe ? (const bf16*)(F.ws + WS_GA8 + (size_t)tile0 * 256 * D) : (const bf16*)(F.ws + WS_HB),
                                moe ? (const bf16*)(F.ws + WS_WM + (size_t)fi * WM_STRIDE) : (const bf16*)(F.ws + WS_WD + (size_t)fi * WD_STRIDE), ntile * 256, 2 * FF, D / 2, (size_t)7 * MiB};
                    pg8::TileOrderSkew S; S.init(ntile * 256, 2 * FF, F.G, F.bx, texp_l + tile0);
                    const bool sk = moe && (dc == 2) && (ntile == F.G);
                    S.nsk = sk ? 4 * CH_NTILE(dc) : 0; S.kd = 3; S.per = 28;
                    pg8::EpiSwigluT<true> E{hid, ACC8_SCALE, f8d ? 0 : 1};
                    GEMM_SITE4(pg8::gemm_phase(F.lds, g, S, E, F.tid));
                } else {
                    pg8::Gemm g{HB, (const bf16*)(F.ws + WS_WD + (size_t)fi * WD_STRIDE), ntile * 256, 2 * FF, D, 0}; pg8::TileOrder S; S.init(ntile * 256, 2 * FF, F.G, F.bx, texp_l + tile0);
                    pg8::EpiSwigluT<false> E{hid, 1.0f, 1};
                    GEMM_SITE6(pg8::gemm_phase(F.lds, g, S, E, F.tid));
                }
            }
            SEAM(pk);
        }
    }
    if (IN(SEQ_FINAL)) {
        LAUNDER();
        RowPass P{}; P.xsrc = nullptr; P.xbf = (const bf16*)F.out; P.xdst = nullptr; P.combine = 1; P.gain = INP(17); P.ob = nullptr; P.obp = D; P.ssq = nullptr; P.of = F.out; P.router = 0; P.wr = nullptr;
        phase_rows(F, P);
    }
#undef IN
#undef SEAM
}

extern "C" void kernel_launch(void* const* d_in, const int* in_sizes, int n_in, void* d_out, int out_size, void* d_ws, size_t ws_size, hipStream_t stream) {
    static int grid = 0;
    if (grid == 0) {
        if (n_in != 18 || out_size != M * D || ws_size < WS_END) { fprintf(stderr, "kernel_launch: unexpected problem (n_in %d out %d ws %zu)\n", n_in, out_size, ws_size); grid = -1; return; }
        int dev = 0, cus = 0, per_cu = 0;
        if (hipGetDevice(&dev) != hipSuccess || hipDeviceGetAttribute(&cus, hipDeviceAttributeMultiprocessorCount, dev) != hipSuccess) { grid = -1; return; }
        if (hipFuncSetAttribute((const void*)fwd_kernel, hipFuncAttributeMaxDynamicSharedMemorySize, LDS_BYTES) != hipSuccess) { fprintf(stderr, "kernel_launch: hipFuncSetAttribute failed\n"); grid = -1; return; }
        if (hipOccupancyMaxActiveBlocksPerMultiprocessor(&per_cu, (const void*)fwd_kernel, NWAVES * 64, LDS_BYTES) != hipSuccess || per_cu < 1) fprintf(stderr, "kernel_launch: occupancy query says %d\n", per_cu);
        (void)hipGetLastError();
        grid = cus;
    }
    if (grid < 0) return;
    (void)hipMemsetAsync((char*)d_ws + WS_CTL, 0, CTL_ZERO_BYTES, stream);
    Args a{};
    for (int i = 0; i < 18; ++i) a.in[i] = (const float*)d_in[i];
    a.out = (float*)d_out; a.ws = (unsigned char*)d_ws; a.pad = 0;
#if MK_ONE_LAUNCH
    a.ph_lo = 0; a.ph_hi = SEQ_END; a.use_bar = 1;
    hipLaunchKernelGGL(fwd_kernel, dim3(grid), dim3(NWAVES * 64), LDS_BYTES, stream, a);
#else
    a.use_bar = 0;
#ifndef MAXSEQ
#define MAXSEQ 1000
#ifndef PROBE_ATT_REPS
#define PROBE_ATT_REPS 1
#endif
#ifndef PROBE_QKV_REPS
#define PROBE_QKV_REPS 1
#endif
#ifndef PROBE_CONV_REPS
#define PROBE_CONV_REPS 1
#endif
#endif
    auto run = [&](int k) { if (k >= MAXSEQ) return; a.ph_lo = k; a.ph_hi = k + 1; hipLaunchKernelGGL(fwd_kernel, dim3(grid), dim3(NWAVES * 64), LDS_BYTES, stream, a); };
    run(0);
    for (int L = 0; L < DEPTH; ++L) {
        const int base = 1 + L * PH_PER_LAYER; const bool moe = (L & 1) != 0;
        for (int k = 0; k < 5; ++k) run(base + k);
        if (moe) { run(base + 5); for (int c = 0; c < NCHUNK; ++c) { run(base + 6 + 2 * c); run(base + 7 + 2 * c); } }
        else { run(base + 6); run(base + 7); }
    }
    run(SEQ_FINAL);
#endif
}
```

```cpp
#include <hip/hip_runtime.h>
#include <cstdio>
#include <cstdint>

#ifndef MK_ONE_LAUNCH
#define MK_ONE_LAUNCH 1
#endif
#define MAXSEQ 1000
#ifndef PROBE_ATT_REPS
#define PROBE_ATT_REPS 1
#endif
#ifndef PROBE_QKV_REPS
#define PROBE_QKV_REPS 1
#endif
#ifndef DENSE_UP8_MASK
#define DENSE_UP8_MASK 5
#endif
#ifndef DENSE_DN8_MASK
#define DENSE_DN8_MASK 5
#endif
#define DENSE_UP8(L) (((DENSE_UP8_MASK) >> (L)) & 1)
#define DENSE_DN8(L) (((DENSE_DN8_MASK) >> (L)) & 1)
#ifndef QKV_FP8
#define QKV_FP8 0
#endif
#ifndef PROBE_BAR2
#define PROBE_BAR2 0
#endif
#ifndef PROBE_PE2
#define PROBE_PE2 0
#endif
#ifndef PROBE_SAMPLE
#define PROBE_SAMPLE 0
#endif
#ifndef PROBE_CONV_REPS
#define PROBE_CONV_REPS 1
#endif

#define GAS __attribute__((address_space(1)))
#define LAS __attribute__((address_space(3)))
typedef unsigned short bf16;
typedef short bf16x8 __attribute__((ext_vector_type(8)));
typedef float f32x4 __attribute__((ext_vector_type(4)));
typedef float f32x2 __attribute__((ext_vector_type(2)));
typedef unsigned u32x4 __attribute__((ext_vector_type(4)));
typedef unsigned u32x2 __attribute__((ext_vector_type(2)));
typedef short v4i16_t __attribute__((ext_vector_type(4)));

constexpr int BATCH = 8, T = 8192, D = 1024, M = BATCH * T, DEPTH = 4;
constexpr int NQKV = 2560, FF = 3584, NE = 8, NMEM = 256, MROWS = BATCH * NMEM;
constexpr int OFF_QA = 0, OFF_KA = 384, OFF_VA = 768, OFF_QB = 1152, OFF_KB = 1536, OFF_VB = 1920, OFF_QM = 2304;
constexpr float RMS_EPS = 1e-6f;
constexpr float LOG2E = 1.4426950408889634f;
constexpr float QSCALE = 0.125f * LOG2E;
constexpr int XP = 2 * D;
constexpr int NWAVES = 8;
constexpr int MAXTILES = 520;
constexpr int CHUNK_TILES = 256;
constexpr int NCHUNK = 5;

constexpr size_t MiB = 1u << 20;
constexpr size_t WS_CTL = 0, CTL_ZERO_BYTES = 1 * MiB;
constexpr size_t WS_COS = 2 * MiB, WS_SIN = 2 * MiB + 256 * 1024;
constexpr size_t WS_E01 = 4 * MiB;
constexpr size_t WS_GATE = 4 * MiB + 256 * 1024;
constexpr size_t WS_POS = 5 * MiB;
constexpr size_t WS_TCNT = 6 * MiB;
constexpr size_t WS_TEXP = 6 * MiB + 64 * 1024;
constexpr size_t WS_SSQ = 8 * MiB;
constexpr size_t WS_WC = 16 * MiB, WC_STRIDE = 8 * MiB;
constexpr size_t WC_IN = 0, WC_MKV = 5 * MiB, WC_OUT = 6 * MiB;
constexpr size_t WS_WD = 48 * MiB, WD_STRIDE = 21 * MiB;
constexpr size_t WS_WM = 90 * MiB, WM_STRIDE = 112 * MiB;
constexpr size_t WM_DOWN = 56 * MiB;
constexpr size_t WS_HB = 314 * MiB;
constexpr size_t WS_BIG = 442 * MiB;
constexpr size_t WS_GA = WS_BIG, WS_HIDC = WS_BIG + 260 * MiB;
constexpr size_t WS_GA8 = 926 * MiB;
constexpr size_t WS_MEMN4 = 1056 * MiB;
constexpr size_t WS_MEMKV4 = 1072 * MiB;
constexpr size_t WS_END = 1080 * MiB;
static_assert(WS_HIDC + (size_t)CHUNK_TILES * 256 * FF <= WS_GA8 && WS_BIG + (size_t)M * FF * 2 <= WS_GA8 && WS_GA8 + (size_t)MAXTILES * 256 * D <= WS_END, "ws map");
constexpr float A8_SCALE = 32.0f, W8_SCALE = 1024.0f, ACC8_SCALE = 1.0f / 32768.0f;
constexpr float H8_SCALE = 16.0f, WD8_SCALE = 4096.0f, ACCD8_SCALE = 1.0f / 65536.0f;
constexpr size_t WD8_ESTRIDE = (size_t)D * FF;

constexpr int CW_TMO = 0, CW_CODE = 1, CW_BAR = 4096;

constexpr int RING_BYTES = 131072;
constexpr int MISC_OFF = 139264;
constexpr int LDS_BYTES = 155648;
constexpr int MISC_BARW = 0;
constexpr int MISC_TEXP = 64;
constexpr int MISC_PTAB = 2560;
constexpr int MISC_SCR = 4096;

__device__ __forceinline__ float vmax2(float a, float b) { return __builtin_amdgcn_fmed3f(a, b, INFINITY); }
__device__ __forceinline__ float vmax3(float a, float b, float c) { return vmax2(vmax2(a, b), c); }
__device__ __forceinline__ float clamp8(float x) { return __builtin_amdgcn_fmed3f(x, -448.0f, 448.0f); }
__device__ __forceinline__ unsigned cvt4_fp8(float a, float b, float c, float d) {
    unsigned w = 0; w = __builtin_amdgcn_cvt_pk_fp8_f32(clamp8(a), clamp8(b), w, false); w = __builtin_amdgcn_cvt_pk_fp8_f32(clamp8(c), clamp8(d), w, true); return w; }
namespace pg8 {
#define PG8_LAS __attribute__((address_space(3)))
typedef unsigned short bf16_t;
constexpr int BM = 256, BK = 64, HALF = 128, HTB = HALF * BK * 2, STAGE_BYTES = 8 * HTB, NXCD = 8, WGM = 8;

__host__ __device__ __forceinline__ int lds_byte(int r, int c) { const int st = (r >> 4) * 2 + (c >> 5), rr = r & 15, cc = c & 31, ob = rr * 64 + cc * 2; return st * 1024 + (ob ^ (((ob >> 9) & 1) << 5)); }
__host__ __device__ __forceinline__ void stage_rc(int b, int& R, int& C) { const int st = b / 1024, sb = b % 1024, swz = sb ^ (((sb >> 9) & 1) << 5); R = (st >> 1) * 16 + swz / 64; C = (st & 1) * 32 + (swz % 64) / 2; }
__host__ __device__ __forceinline__ int perm32(int rho) { const int n = rho >> 4, i = rho & 15; return 8 * (i >> 2) + 4 * n + (i & 3); }

struct Unit { int pm, pn, e; };
struct Gemm { const bf16_t* A; const bf16_t* Bt; int M, N, K; size_t estride; };

struct TileOrder {
    int nM, nN, nwg, G, c; const PG8_LAS int* texp;
    __device__ void init(int Mr, int N, int G_, int c_, const PG8_LAS int* texp_) { nM = Mr / BM; nN = N / BM; nwg = nM * nN; G = G_; c = c_; texp = texp_; }
    __device__ bool next(int i, Unit& u) const {
        const long L = (long)i * G + c; if (L >= nwg) return false;
        int wgid = (int)L; { const int q = nwg / NXCD, r = nwg % NXCD, xcd = wgid % NXCD, off = wgid / NXCD; wgid = (xcd < r ? xcd * (q + 1) : r * (q + 1) + (xcd - r) * q) + off; }
        const int nig = WGM * nN, gid = wgid / nig, fm = gid * WGM, gsz = (nM - fm) < WGM ? (nM - fm) : WGM;
        u.pm = fm + ((wgid % nig) % gsz); u.pn = (wgid % nig) / gsz; u.e = texp ? __builtin_amdgcn_readfirstlane(texp[u.pm]) : 0; return true;
    }
};

struct TileOrderSkew : TileOrder {
    int nsk, kd, per;
    __device__ bool next(int i, Unit& u) const {
        int cc = c, ii = i;
        if (nsk > 0) {
            if (c < nsk) { if (i >= per - kd) return false; }
            else if (i == per) { const int S = (nsk + 7) & ~7, j = c / S - 1, c2 = c % S; if (c < S || j >= kd || c2 >= nsk) return false; cc = c2; ii = per - kd + j; }
            else if (i > per) return false;
        }
        const long L = (long)ii * G + cc; if (L >= nwg) return false;
        int wgid = (int)L; { const int q = nwg / NXCD, r = nwg % NXCD, xcd = wgid % NXCD, off = wgid / NXCD; wgid = (xcd < r ? xcd * (q + 1) : r * (q + 1) + (xcd - r) * q) + off; }
        const int nig = WGM * nN, gid = wgid / nig, fm = gid * WGM, gsz = (nM - fm) < WGM ? (nM - fm) : WGM;
        u.pm = fm + ((wgid % nig) % gsz); u.pn = (wgid % nig) / gsz; u.e = texp ? __builtin_amdgcn_readfirstlane(texp[u.pm]) : 0; return true;
    }
};

typedef int i32x8 __attribute__((ext_vector_type(8)));
typedef int i32x4 __attribute__((ext_vector_type(4)));
__device__ __forceinline__ i32x8 cat8(bf16x8 a, bf16x8 b) { const i32x4 x = __builtin_bit_cast(i32x4, a), y = __builtin_bit_cast(i32x4, b); return __builtin_shufflevector(x, y, 0, 1, 2, 3, 4, 5, 6, 7); }
__device__ __forceinline__ void mfma8(f32x4& acc, const i32x8 a, const i32x8 b) { int sc = 0x7f7f7f7f;
    asm volatile("v_mfma_scale_f32_16x16x128_f8f6f4 %0, %1, %2, %0, %3, %3 op_sel_hi:[0,0,0]" : "+v"(acc) : "v"(a), "v"(b), "v"(sc)); }
__device__ __forceinline__ unsigned cvt_pk_bf16(float lo, float hi) { unsigned r; asm volatile("v_cvt_pk_bf16_f32 %0, %1, %2" : "=v"(r) : "v"(lo), "v"(hi)); return r; }


struct EpiPlain {
    static constexpr bool PERM = true, FP8 = false; static constexpr int LDA = 0;
    bf16_t* O; int ldc;
    __device__ __forceinline__ void operator()(const f32x4 (&acc)[2][2][4][2], const Unit& u, int wr, int wc, int fr, int fq) const {
        const int row0 = u.pm * BM + wr * 64 + fr, col0 = u.pn * BM + wc * 32 + 8 * fq;
#pragma unroll
        for (int ai = 0; ai < 2; ++ai)
#pragma unroll
            for (int m = 0; m < 4; ++m) { bf16_t* rowp = O + (size_t)(row0 + ai * HALF + m * 16) * ldc + col0;
#pragma unroll
                for (int bj = 0; bj < 2; ++bj) { const f32x4 v0 = acc[ai][bj][m][0], v1 = acc[ai][bj][m][1];
                    u32x4 w; w.x = cvt_pk_bf16(v0[0], v0[1]); w.y = cvt_pk_bf16(v0[2], v0[3]); w.z = cvt_pk_bf16(v1[0], v1[1]); w.w = cvt_pk_bf16(v1[2], v1[3]);
                    *(u32x4*)(rowp + bj * HALF) = w; } }
    }
};
template <bool F8> struct EpiQKVT {
    static constexpr bool PERM = true, FP8 = F8; static constexpr int LDA = F8 ? 0 : XP;
    bf16_t* O; const float* cosT; const float* sinT; float insc;
    const float* ssq; int npart;
    __device__ __forceinline__ void operator()(const f32x4 (&acc)[2][2][4][2], const Unit& u, int wr, int wc, int fr, int fq) const {
        const int row0 = u.pm * BM + wr * 64 + fr, col0 = u.pn * BM + wc * 32 + 8 * fq;
        const bool lane_rot = ((wc & 1) == 0) && (fq < 2);
        float rsv[2][4];
        if (npart) {
            f32x4 pp[2][4];
#pragma unroll
            for (int ai = 0; ai < 2; ++ai)
#pragma unroll
                for (int m = 0; m < 4; ++m) pp[ai][m] = *(const f32x4*)(ssq + (size_t)(row0 + ai * HALF + m * 16) * 16 + 4 * fq);
#pragma unroll
            for (int ai = 0; ai < 2; ++ai)
#pragma unroll
                for (int m = 0; m < 4; ++m) { float sq = (pp[ai][m][0] + pp[ai][m][1]) + (pp[ai][m][2] + pp[ai][m][3]); sq += __shfl_xor(sq, 16); sq += __shfl_xor(sq, 32);
                    rsv[ai][m] = insc * __builtin_amdgcn_rsqf(sq * (1.0f / D) + RMS_EPS); }
        } else {
#pragma unroll
            for (int ai = 0; ai < 2; ++ai)
#pragma unroll
                for (int m = 0; m < 4; ++m) rsv[ai][m] = insc;
        }
        const bool anyrot = (u.pn >= 4) && (u.pn <= 7);
#pragma unroll
        for (int ai = 0; ai < 2; ++ai) {
            f32x4 rc[4], rn[4];
#pragma unroll
            for (int m = 0; m < 4; ++m) { rc[m] = (f32x4){0.f, 0.f, 0.f, 0.f}; rn[m] = rc[m]; }
            if (anyrot) {
#pragma unroll
                for (int m = 0; m < 4; ++m) { const int t = (row0 + ai * HALF + m * 16) & (T - 1); rc[m] = *(const f32x4*)(cosT + t * 8 + 4 * (fq & 1)); rn[m] = *(const f32x4*)(sinT + t * 8 + 4 * (fq & 1)); }
            }
#pragma unroll
            for (int m = 0; m < 4; ++m) {
                const int row = row0 + ai * HALF + m * 16;
                const float rs = rsv[ai][m];
#pragma unroll
                for (int bj = 0; bj < 2; ++bj) {
                    const int idx = 2 * u.pn + bj;
                    const float sc = ((idx < 3 || (idx >= 9 && idx < 12) || idx >= 18) ? QSCALE : 1.0f) * rs;
                    const bool rot = (idx >= 9 && idx < 15) && lane_rot;
                    f32x4 v0 = acc[ai][bj][m][0] * sc, v1 = acc[ai][bj][m][1] * sc;
                    if (rot) {
                        const f32x4 c = rc[m], s = rn[m];
                        f32x4 a, b;
                        a[0] = v0[0] * c[0] - v0[1] * s[0]; a[1] = v0[1] * c[0] + v0[0] * s[0];
                        a[2] = v0[2] * c[1] - v0[3] * s[1]; a[3] = v0[3] * c[1] + v0[2] * s[1];
                        b[0] = v1[0] * c[2] - v1[1] * s[2]; b[1] = v1[1] * c[2] + v1[0] * s[2];
                        b[2] = v1[2] * c[3] - v1[3] * s[3]; b[3] = v1[3] * c[3] + v1[2] * s[3];
                        v0 = a; v1 = b;
                    }
                    u32x4 w; w.x = cvt_pk_bf16(v0[0], v0[1]); w.y = cvt_pk_bf16(v0[2], v0[3]); w.z = cvt_pk_bf16(v1[0], v1[1]); w.w = cvt_pk_bf16(v1[2], v1[3]);
                    *(u32x4*)(O + (size_t)row * NQKV + col0 + bj * HALF) = w;
                }
            }
        }
    }
};
template <bool F8> struct EpiSwigluT {
    static constexpr bool PERM = true, FP8 = F8; static constexpr int LDA = 0;
    bf16_t* O; float insc; int out_bf16;
    __device__ __forceinline__ void operator()(const f32x4 (&acc)[2][2][4][2], const Unit& u, int wr, int wc, int fr, int fq) const {
        const int row0 = u.pm * BM + wr * 64 + fr, col0 = u.pn * HALF + wc * 32 + 8 * fq;
#pragma unroll
        for (int ai = 0; ai < 2; ++ai)
#pragma unroll
            for (int m = 0; m < 4; ++m) {
                float h[8];
#pragma unroll
                for (int n = 0; n < 2; ++n)
#pragma unroll
                    for (int j = 0; j < 4; ++j) { const float g = acc[ai][0][m][n][j] * insc, up = acc[ai][1][m][n][j] * insc;
                        const float sg = g * __builtin_amdgcn_rcpf(1.0f + __builtin_amdgcn_exp2f(-g * LOG2E)); h[4 * n + j] = sg * up; }
                if (F8 && !out_bf16) {
                    u32x2 w; w.x = cvt4_fp8(h[0] * H8_SCALE, h[1] * H8_SCALE, h[2] * H8_SCALE, h[3] * H8_SCALE); w.y = cvt4_fp8(h[4] * H8_SCALE, h[5] * H8_SCALE, h[6] * H8_SCALE, h[7] * H8_SCALE);
                    *(u32x2*)((unsigned char*)O + (size_t)(row0 + ai * HALF + m * 16) * FF + col0) = w;
                } else {
                    u32x4 w; w.x = cvt_pk_bf16(h[0], h[1]); w.y = cvt_pk_bf16(h[2], h[3]); w.z = cvt_pk_bf16(h[4], h[5]); w.w = cvt_pk_bf16(h[6], h[7]);
                    *(u32x4*)(O + (size_t)(row0 + ai * HALF + m * 16) * FF + col0) = w;
                }
            }
    }
};
template <bool F8> struct EpiResT {
    static constexpr bool PERM = true, FP8 = F8; static constexpr int LDA = 0;
    const float* src; bf16_t* xbf; bf16_t* ob; int ldc; int as_bf16; float insc;
    __device__ __forceinline__ void operator()(const f32x4 (&acc)[2][2][4][2], const Unit& u, int wr, int wc, int fr, int fq) const {
        const int row0 = u.pm * BM + wr * 64 + fr, col0 = u.pn * BM + wc * 32 + 8 * fq;
        float* ssqp = nullptr;
        if (as_bf16 == 2) {
            extern __shared__ __attribute__((aligned(16))) unsigned char lds_epi[];
            const unsigned long long v = ((const PG8_LAS unsigned long long*)((PG8_LAS unsigned char*)lds_epi + MISC_OFF + MISC_PTAB))[18];
            const unsigned lo = __builtin_amdgcn_readfirstlane((unsigned)v), hi = __builtin_amdgcn_readfirstlane((unsigned)(v >> 32));
            ssqp = (float*)((unsigned char*)(((unsigned long long)hi << 32) | lo) + WS_SSQ); }
        if (as_bf16 == 1) {
#pragma unroll
            for (int ai = 0; ai < 2; ++ai)
#pragma unroll
                for (int m = 0; m < 4; ++m) { bf16_t* rowp = ob + (size_t)(row0 + ai * HALF + m * 16) * ldc + col0;
#pragma unroll
                    for (int bj = 0; bj < 2; ++bj) { const f32x4 v0 = acc[ai][bj][m][0] * insc, v1 = acc[ai][bj][m][1] * insc;
                        u32x4 w; w.x = cvt_pk_bf16(v0[0], v0[1]); w.y = cvt_pk_bf16(v0[2], v0[3]); w.z = cvt_pk_bf16(v1[0], v1[1]); w.w = cvt_pk_bf16(v1[2], v1[3]); *(u32x4*)(rowp + bj * HALF) = w; } }
        } else {
#pragma unroll
            for (int ai = 0; ai < 2; ++ai) {
                u32x4 rw[4][2];
#pragma unroll
                for (int m = 0; m < 4; ++m)
#pragma unroll
                    for (int bj = 0; bj < 2; ++bj) rw[m][bj] = *(const u32x4*)(xbf + (size_t)(row0 + ai * HALF + m * 16) * XP + col0 + bj * HALF);
#pragma unroll
                for (int m = 0; m < 4; ++m) { const size_t xoff = (size_t)(row0 + ai * HALF + m * 16) * XP + col0; float ss = 0.f;
#pragma unroll
                    for (int bj = 0; bj < 2; ++bj) { const u32x4 r = rw[m][bj];
                        const f32x4 b0 = (f32x4){__builtin_bit_cast(float, r.x << 16), __builtin_bit_cast(float, r.x & 0xffff0000u), __builtin_bit_cast(float, r.y << 16), __builtin_bit_cast(float, r.y & 0xffff0000u)};
                        const f32x4 b1 = (f32x4){__builtin_bit_cast(float, r.z << 16), __builtin_bit_cast(float, r.z & 0xffff0000u), __builtin_bit_cast(float, r.w << 16), __builtin_bit_cast(float, r.w & 0xffff0000u)};
                        const f32x4 x0 = b0 + acc[ai][bj][m][0] * insc, x1 = b1 + acc[ai][bj][m][1] * insc;
                        ss += ((x0[0] * x0[0] + x0[1] * x0[1]) + (x0[2] * x0[2] + x0[3] * x0[3])) + ((x1[0] * x1[0] + x1[1] * x1[1]) + (x1[2] * x1[2] + x1[3] * x1[3]));
                        u32x4 w; w.x = cvt_pk_bf16(x0[0], x0[1]); w.y = cvt_pk_bf16(x0[2], x0[3]); w.z = cvt_pk_bf16(x1[0], x1[1]); w.w = cvt_pk_bf16(x1[2], x1[3]);
                        *(u32x4*)(xbf + xoff + bj * HALF) = w; }
                    if (ssqp) { ss += __shfl_xor(ss, 16); ss += __shfl_xor(ss, 32); if (fq == 0) ssqp[(size_t)(row0 + ai * HALF + m * 16) * 16 + 4 * u.pn + wc] = ss; } }
                asm volatile("" ::: "memory");
            }
        }
    }
};

template <class Epi, class Sched>
__device__ __forceinline__ void gemm_phase(PG8_LAS unsigned char* lds, const Gemm g, const Sched& S, const Epi& E, const int tid) {
    const int wid = __builtin_amdgcn_readfirstlane(tid >> 6), lane = tid & 63, wr = wid >> 2, wc = wid & 3, fr = lane & 15, fq = lane >> 4;
    const int K = g.K, nt = K / BK;
    const int LDA_ = Epi::LDA ? Epi::LDA : K;
    unsigned voffA[2], voffB[2];
#pragma unroll
    for (int i = 0; i < 2; ++i) { int R, C; stage_rc(tid * 16 + i * 8192, R, C); const int Rb = Epi::PERM ? ((R & ~31) + perm32(R & 31)) : R;
        voffA[i] = (unsigned)(R * LDA_ + C) * 2u; voffB[i] = (unsigned)(Rb * K + C) * 2u; }
    const size_t kstep = (size_t)(BK * 2);
    const size_t hstep = (size_t)HALF * K * 2;
    const size_t tstep = 2 * hstep;
    const size_t hstepA = (size_t)HALF * LDA_ * 2, tstepA = 2 * hstepA;
    const unsigned ldsw = (unsigned)wid * 1024u;
    const int aoff = lds_byte(wr * 64 + fr, fq * 8), boff = lds_byte(wc * 32 + fr, fq * 8);
#define PG8_SA(b, h) (((b) * 2 + (h)) * HTB)
#define PG8_SB(b, h) ((4 + (b) * 2 + (h)) * HTB)
#define PG8_STAGE(bufoff, gbase, voff) do { _Pragma("unroll") for (int _i = 0; _i < 2; ++_i) \
        __builtin_amdgcn_global_load_lds((const unsigned*)((const char*)(gbase) + (voff)[_i]), (PG8_LAS unsigned*)(lds + (bufoff) + ldsw + _i * 8192), 16, 0, 0); } while (0)
#define PG8_LDA(dst, b, h) do { _Pragma("unroll") for (int m = 0; m < 4; ++m) _Pragma("unroll") for (int k = 0; k < 2; ++k) dst[m][k] = *(const PG8_LAS bf16x8*)(lds + PG8_SA(b, h) + aoff + m * 2048 + k * 1024); } while (0)
#define PG8_LDB(dst, b, h) do { _Pragma("unroll") for (int n = 0; n < 2; ++n) _Pragma("unroll") for (int k = 0; k < 2; ++k) dst[n][k] = *(const PG8_LAS bf16x8*)(lds + PG8_SB(b, h) + boff + n * 2048 + k * 1024); } while (0)
#define PG8_MMA(ai, bj, At, Bt) do { __builtin_amdgcn_s_setprio(1); \
        if constexpr (Epi::FP8) { _Pragma("unroll") for (int m = 0; m < 4; ++m) _Pragma("unroll") for (int n = 0; n < 2; ++n) \
            mfma8(acc[ai][bj][m][n], cat8(Bt[n][0], Bt[n][1]), cat8(At[m][0], At[m][1])); } \
        else { _Pragma("unroll") for (int m = 0; m < 4; ++m) _Pragma("unroll") for (int n = 0; n < 2; ++n) _Pragma("unroll") for (int k = 0; k < 2; ++k) \
            acc[ai][bj][m][n] = __builtin_amdgcn_mfma_f32_16x16x32_bf16(Bt[n][k], At[m][k], acc[ai][bj][m][n], 0, 0, 0); } \
        __builtin_amdgcn_s_setprio(0); } while (0)
#define PG8_WAIT_V(n) asm volatile("s_waitcnt vmcnt(" #n ")" ::: "memory")
#define PG8_WAIT_L(n) asm volatile("s_waitcnt lgkmcnt(" #n ")" ::: "memory")
#define PG8_BAR __builtin_amdgcn_s_barrier()
#define PG8_SCHED __builtin_amdgcn_sched_barrier(0)
    Unit cur, nxt; int ui = 0;
    if (!S.next(0, cur)) return;
    f32x4 acc[2][2][4][2];
#pragma unroll
    for (int a = 0; a < 2; ++a)
#pragma unroll
        for (int b = 0; b < 2; ++b)
#pragma unroll
            for (int m = 0; m < 4; ++m)
#pragma unroll
                for (int n = 0; n < 2; ++n) acc[a][b][m][n] = (f32x4){0.f, 0.f, 0.f, 0.f};
    bf16x8 At[4][2], B0[2][2], B1[2][2];
    const char* cA = (const char*)g.A + (size_t)cur.pm * tstepA; const char* cB = (const char*)g.Bt + (size_t)cur.e * g.estride + (size_t)cur.pn * tstep;
    PG8_STAGE(PG8_SB(0, 0), cB, voffB); PG8_STAGE(PG8_SB(0, 1), cB + hstep, voffB); PG8_STAGE(PG8_SA(0, 0), cA, voffA); PG8_STAGE(PG8_SA(0, 1), cA + hstepA, voffA);
    if (wr == 1) PG8_BAR;
    PG8_WAIT_V(2); PG8_BAR;
    PG8_STAGE(PG8_SB(1, 0), cB + kstep, voffB); PG8_STAGE(PG8_SA(1, 0), cA + kstep, voffA); PG8_STAGE(PG8_SB(1, 1), cB + hstep + kstep, voffB);
    PG8_WAIT_V(6); PG8_BAR;
    for (;;) {
        const bool has_next = S.next(ui + 1, nxt);
        const char* nA = has_next ? (const char*)g.A + (size_t)nxt.pm * tstepA : cA; const char* nB = has_next ? (const char*)g.Bt + (size_t)nxt.e * g.estride + (size_t)nxt.pn * tstep : cB;
        for (int t = 0; t < nt; t += 2) {
            const bool last = (t == nt - 2);
            const char* a1 = cA + (size_t)(t + 1) * kstep;
            const char* a2 = last ? nA : cA + (size_t)(t + 2) * kstep; const char* b2 = last ? nB : cB + (size_t)(t + 2) * kstep;
            const char* a3 = a2 + kstep; const char* b3 = b2 + kstep;
            PG8_LDB(B0, 0, 0); PG8_LDB(B1, 0, 1); PG8_SCHED; PG8_LDA(At, 0, 0); PG8_STAGE(PG8_SA(1, 1), a1 + hstepA, voffA);
            PG8_WAIT_V(8); PG8_WAIT_L(0); PG8_BAR; PG8_MMA(0, 0, At, B0); PG8_MMA(0, 1, At, B1); PG8_BAR; PG8_SCHED;
            PG8_LDA(At, 0, 1); PG8_STAGE(PG8_SB(0, 0), b2, voffB); PG8_STAGE(PG8_SB(0, 1), b2 + hstep, voffB); PG8_STAGE(PG8_SA(0, 0), a2, voffA);
            PG8_WAIT_V(8); PG8_WAIT_L(0); PG8_BAR; PG8_MMA(1, 0, At, B0); PG8_MMA(1, 1, At, B1); PG8_BAR; PG8_SCHED;
            PG8_LDB(B0, 1, 0); PG8_LDB(B1, 1, 1); PG8_SCHED; PG8_LDA(At, 1, 0); PG8_STAGE(PG8_SA(0, 1), a2 + hstepA, voffA);
            PG8_WAIT_V(8); PG8_WAIT_L(0); PG8_BAR; PG8_MMA(0, 0, At, B0); PG8_MMA(0, 1, At, B1); PG8_BAR; PG8_SCHED;
            PG8_LDA(At, 1, 1); PG8_STAGE(PG8_SB(1, 0), b3, voffB); PG8_STAGE(PG8_SB(1, 1), b3 + hstep, voffB); PG8_STAGE(PG8_SA(1, 0), a3, voffA);
            PG8_WAIT_V(8); PG8_WAIT_L(0); PG8_BAR; PG8_MMA(1, 0, At, B0); PG8_MMA(1, 1, At, B1); PG8_BAR; PG8_SCHED;
        }
        if (wr == 0) PG8_BAR;
        if constexpr (Epi::FP8) {
#pragma unroll
            for (int a = 0; a < 2; ++a)
#pragma unroll
                for (int b = 0; b < 2; ++b)
                    asm volatile("s_nop 15\n\ts_nop 15" : "+v"(acc[a][b][0][0]), "+v"(acc[a][b][0][1]), "+v"(acc[a][b][1][0]), "+v"(acc[a][b][1][1]), "+v"(acc[a][b][2][0]), "+v"(acc[a][b][2][1]), "+v"(acc[a][b][3][0]), "+v"(acc[a][b][3][1]));
        }
        E(acc, cur, wr, wc, fr, fq);
        if (!has_next) break;
#pragma unroll
        for (int a = 0; a < 2; ++a)
#pragma unroll
            for (int b = 0; b < 2; ++b)
#pragma unroll
                for (int m = 0; m < 4; ++m)
#pragma unroll
                    for (int n = 0; n < 2; ++n) acc[a][b][m][n] = (f32x4){0.f, 0.f, 0.f, 0.f};
        cur = nxt; cA = nA; cB = nB; ++ui;
        if (wr == 1) PG8_BAR;
    }
    PG8_WAIT_V(0);
    PG8_BAR;
#undef PG8_SA
#undef PG8_SB
#undef PG8_STAGE
#undef PG8_LDA
#undef PG8_LDB
#undef PG8_MMA
#undef PG8_WAIT_V
#undef PG8_WAIT_L
#undef PG8_BAR
#undef PG8_SCHED
}
}

typedef GAS unsigned gu32;
#define RLX_AGENT __ATOMIC_RELAXED, __HIP_MEMORY_SCOPE_AGENT
#define LDS_WAIT() asm volatile("s_waitcnt lgkmcnt(0)" ::: "memory")
#define VM_WAIT() asm volatile("s_waitcnt vmcnt(0)" ::: "memory")
__device__ __forceinline__ unsigned f2bf(float f) { unsigned u = __builtin_bit_cast(unsigned, f); return (u + 0x7fffu + ((u >> 16) & 1u)) >> 16; }
__device__ __forceinline__ unsigned pk2(float lo, float hi) { return f2bf(lo) | (f2bf(hi) << 16); }
__device__ __forceinline__ float bf_lo(unsigned w) { return __builtin_bit_cast(float, w << 16); }
__device__ __forceinline__ float bf_hi(unsigned w) { return __builtin_bit_cast(float, w & 0xffff0000u); }

#define XB_TMO      128
#define XB_XCNT(j)  (256  + 64 * (j))
#define XB_XSUB(j)  (1280 + 64 * (j))
#define XB_XGEN(j)  (2304 + 64 * (j))
#define XB_TOP      3328
#define XB_TOPGEN   3392
#define XCD_BAR_WORDS 3456
#define XB_SPIN_CAP (1u << 18)

__device__ __forceinline__ unsigned xb_ld(unsigned* p)              { return __hip_atomic_load(p, __ATOMIC_RELAXED, __HIP_MEMORY_SCOPE_AGENT); }
__device__ __forceinline__ unsigned xb_add(unsigned* p, unsigned v) { return __hip_atomic_fetch_add(p, v, __ATOMIC_RELAXED, __HIP_MEMORY_SCOPE_AGENT); }
__device__ __forceinline__ unsigned xb_xcc_id() { return (unsigned)__builtin_amdgcn_s_getreg((3 << 11) | 20) & 0xFu; }
#define XB_SPIN(cond, bar) do { unsigned _sp = 0; while (cond) { __builtin_amdgcn_s_sleep(1); \
    if ((++_sp & 255u) == 0u) { if (xb_ld(&(bar)[XB_TMO])) break; if (_sp > XB_SPIN_CAP) { atomicAdd(&(bar)[XB_TMO], 1u); break; } } } } while (0)

struct XcdBarrier { unsigned* bar; unsigned x; volatile LAS unsigned* st; };

__device__ __forceinline__ XcdBarrier xcd_barrier_post(unsigned* bar, volatile LAS unsigned* st) {
    XcdBarrier b; b.bar = bar; b.x = xb_xcc_id(); b.st = st;
    if (threadIdx.x == 0) (void)xb_add(&bar[XB_XCNT(b.x)], 1u);
    return b;
}
__device__ __forceinline__ void xcd_barrier_complete(unsigned* bar, unsigned x, unsigned& nloc, unsigned& nx) {
    const unsigned G = gridDim.x * gridDim.y * gridDim.z;
    unsigned sum, cnt, mine, sp = 0u;
    for (;;) {
        sum = 0u; cnt = 0u; mine = 0u;
#pragma unroll
        for (unsigned j = 0; j < 16; ++j) { const unsigned c = xb_ld(&bar[XB_XCNT(j)]); sum += c; cnt += (c > 0u) ? 1u : 0u; mine = (j == x) ? c : mine; }
        if (sum == G) break;
        __builtin_amdgcn_s_sleep(1);
        if ((++sp & 255u) == 0u) { if (xb_ld(&bar[XB_TMO])) break; if (sp > XB_SPIN_CAP) { atomicAdd(&bar[XB_TMO], 1u); break; } }
    }
    nloc = mine > 0u ? mine : 1u; nx = cnt > 0u ? cnt : 1u;
}
__device__ __forceinline__ void xcd_barrier(const XcdBarrier& b) {
    asm volatile("s_waitcnt vmcnt(0)" ::: "memory");
    __syncthreads();
    if (threadIdx.x == 0) {
        unsigned* bar = b.bar;
        __builtin_amdgcn_s_waitcnt(0);
        unsigned nloc = b.st[0], nx = b.st[1];
        if (nloc == 0u) { xcd_barrier_complete(bar, b.x, nloc, nx); b.st[0] = nloc; b.st[1] = nx; }
        const unsigned old = xb_add(&bar[XB_XSUB(b.x)], 1u);
        const unsigned gen = old / nloc;
        if (old + 1u == (gen + 1u) * nloc) {
            __builtin_amdgcn_fence(__ATOMIC_RELEASE, "agent");
            asm volatile("s_waitcnt vmcnt(0)" ::: "memory");
            const unsigned og = xb_add(&bar[XB_TOP], 1u);
            const unsigned tg = og / nx;
            if (og + 1u == (tg + 1u) * nx) xb_add(&bar[XB_TOPGEN], 1u);
            else XB_SPIN(xb_ld(&bar[XB_TOPGEN]) == tg, bar);
            __builtin_amdgcn_fence(__ATOMIC_ACQUIRE, "agent");
            xb_add(&bar[XB_XGEN(b.x)], 1u);
            asm volatile("s_waitcnt vmcnt(0)" ::: "memory");
        } else {
            XB_SPIN(xb_ld(&bar[XB_XGEN(b.x)]) == gen, bar);
            __builtin_amdgcn_fence(__ATOMIC_ACQUIRE, "agent");
            asm volatile("s_waitcnt vmcnt(0)" ::: "memory");
        }
    }
    __syncthreads();
}

struct Frame {
    LAS unsigned char* lds;
    LAS unsigned char* misc;
    unsigned char* ws;
    int tid, lane, wave, G, bx;
    float* out;
};
__device__ __forceinline__ const float* inp_ptr(LAS unsigned char* misc, int i) {
    const unsigned long long v = ((const LAS unsigned long long*)(misc + MISC_PTAB))[i];
    const unsigned lo = __builtin_amdgcn_readfirstlane((unsigned)v), hi = __builtin_amdgcn_readfirstlane((unsigned)(v >> 32));
    return (const float*)(GAS const float*)(((unsigned long long)hi << 32) | lo);
}
#define INP(i) inp_ptr(F.misc, (i))

__device__ __forceinline__ void lds_add(LAS int* p, int v) { (void)__hip_atomic_fetch_add(p, v, __ATOMIC_RELAXED, __HIP_MEMORY_SCOPE_WORKGROUP); }
__device__ __forceinline__ float wave_sum(float v) {
#pragma unroll
    for (int o = 1; o < 64; o <<= 1) v += __shfl_xor(v, o);
    return v;
}

__device__ __forceinline__ int map_row(int n, int mode) {
    if (mode == 1) { if (n >= OFF_QB && n < OFF_VB) { const int d = (n - OFF_QB) & 63; if (d < 16) { const int dn = d < 8 ? 2 * d : 2 * (d - 8) + 1; return n - d + dn; } } return n; }
    if (mode == 2) return ((n >> 7) << 8) + (n & 127);
    if (mode == 3) return ((n >> 7) << 8) + 128 + (n & 127);
    return n;
}
template <bool F8>
__device__ __forceinline__ void convert_mat(const float* W, int K, int N, unsigned char* WT, int mode, float wscale, int& base, int gw, int NGW, int lane, const float* kgain = nullptr) {
    constexpr int KI = F8 ? 128 : 64;
    const int nblk = N >> 6, nitems = (K / KI) * nblk;
    int r = gw - (base % NGW); if (r < 0) r += NGW;
    base += nitems;
    const int q = lane >> 4, c4 = lane & 15;
#pragma nounroll
    for (; r < nitems; r += NGW) {
        const int kb = r / nblk, nb = r - kb * nblk, k0 = kb * KI, n = nb * 64 + 4 * c4;
        const GAS float* src = (const GAS float*)W + (size_t)k0 * N + n;
        size_t drow[4];
#pragma unroll
        for (int c = 0; c < 4; ++c) drow[c] = (size_t)map_row(n + c, mode) * K + k0;
#pragma nounroll
        for (int sgm = 0; sgm < 2; ++sgm) {
            f32x4 v[16];
            if (F8) {
                const int kq = 64 * sgm + 16 * q;
#pragma unroll
                for (int j = 0; j < 16; ++j) v[j] = *(const GAS f32x4*)(src + (size_t)(kq + j) * N) * wscale;
#pragma unroll
                for (int c = 0; c < 4; ++c) { u32x4 o; o.x = cvt4_fp8(v[0][c], v[1][c], v[2][c], v[3][c]); o.y = cvt4_fp8(v[4][c], v[5][c], v[6][c], v[7][c]);
                    o.z = cvt4_fp8(v[8][c], v[9][c], v[10][c], v[11][c]); o.w = cvt4_fp8(v[12][c], v[13][c], v[14][c], v[15][c]);
                    *(GAS u32x4*)(WT + drow[c] + kq) = o; }
            } else {
                const int kq = 32 * sgm + 8 * q;
#pragma unroll
                for (int j = 0; j < 8; ++j) v[j] = *(const GAS f32x4*)(src + (size_t)(kq + j) * N);
                if (kgain) {
#pragma unroll
                    for (int j = 0; j < 8; ++j) v[j] = v[j] * kgain[k0 + kq + j]; }
#pragma unroll
                for (int c = 0; c < 4; ++c) { u32x4 o; o.x = pk2(v[0][c], v[1][c]); o.y = pk2(v[2][c], v[3][c]); o.z = pk2(v[4][c], v[5][c]); o.w = pk2(v[6][c], v[7][c]);
                    *(GAS u32x4*)((bf16*)WT + drow[c] + kq) = o; }
            }
        }
    }
}
__device__ __forceinline__ void phase_convert(Frame& F) {
    const int gw = F.bx * NWAVES + F.wave, NGW = F.G * NWAVES;
    int base = 0;
#pragma nounroll
    for (int L = 0; L < DEPTH; ++L) { unsigned char* wc = F.ws + WS_WC + (size_t)L * WC_STRIDE;
#if QKV_FP8
        convert_mat<true>(INP(3) + (size_t)L * D * NQKV, D, NQKV, wc + WC_IN, 1, W8_SCALE, base, gw, NGW, F.lane);
#else
        convert_mat<false>(INP(3) + (size_t)L * D * NQKV, D, NQKV, wc + WC_IN, 1, 1.0f, base, gw, NGW, F.lane, INP(2) + (size_t)L * D);
#endif
        convert_mat<false>(INP(6) + (size_t)L * D * 512, D, 512, wc + WC_MKV, 0, 1.0f, base, gw, NGW, F.lane);
        convert_mat<false>(INP(8) + (size_t)L * D * D, D, D, wc + WC_OUT, 0, 1.0f, base, gw, NGW, F.lane); }
#pragma nounroll
    for (int i = 0; i < 2; ++i) { unsigned char* wd = F.ws + WS_WD + (size_t)i * WD_STRIDE;
        if (DENSE_UP8(2 * i)) { convert_mat<true>(INP(10) + (size_t)i * D * FF, D, FF, wd, 2, W8_SCALE, base, gw, NGW, F.lane); convert_mat<true>(INP(11) + (size_t)i * D * FF, D, FF, wd, 3, W8_SCALE, base, gw, NGW, F.lane); }
        else { convert_mat<false>(INP(10) + (size_t)i * D * FF, D, FF, wd, 2, 1.0f, base, gw, NGW, F.lane); convert_mat<false>(INP(11) + (size_t)i * D * FF, D, FF, wd, 3, 1.0f, base, gw, NGW, F.lane); }
        if (DENSE_DN8(2 * i)) convert_mat<true>(INP(12) + (size_t)i * FF * D, FF, D, wd + 14 * MiB, 0, WD8_SCALE, base, gw, NGW, F.lane);
        else convert_mat<false>(INP(12) + (size_t)i * FF * D, FF, D, wd + 14 * MiB, 0, 1.0f, base, gw, NGW, F.lane); }
#pragma nounroll
    for (int ie = 0; ie < 2 * NE; ++ie) { const int i = ie >> 3, e = ie & 7; unsigned char* wm = F.ws + WS_WM + (size_t)i * WM_STRIDE; const size_t eo = (size_t)ie * D * FF;
        convert_mat<true>(INP(14) + eo, D, FF, wm + (size_t)e * 7 * MiB, 2, W8_SCALE, base, gw, NGW, F.lane);
        convert_mat<true>(INP(15) + eo, D, FF, wm + (size_t)e * 7 * MiB, 3, W8_SCALE, base, gw, NGW, F.lane);
        convert_mat<true>(INP(16) + eo, FF, D, wm + WM_DOWN + (size_t)e * WD8_ESTRIDE, 0, WD8_SCALE, base, gw, NGW, F.lane); }
    float* cosT = (float*)(F.ws + WS_COS); float* sinT = (float*)(F.ws + WS_SIN);
    for (int idx = F.bx * 512 + F.tid; idx < T * 8; idx += F.G * 512) {
        const int t = idx >> 3, i = idx & 7;
        const double f = (i == 0) ? 0.15915494309189535 : (i == 1) ? 0.03086376340470123 : (i == 2) ? 0.005985185712713705 : (i == 3) ? 0.001160663641240061
                       : (i == 4) ? 0.00022507907903927653 : (i == 5) ? 4.364795279280289e-05 : (i == 6) ? 8.464330808241401e-06 : 1.6414262627950345e-06;
        double rev = (double)t * f; rev -= (double)(long long)rev;
        const float rf = (float)rev;
        cosT[idx] = __builtin_amdgcn_cosf(rf); sinT[idx] = __builtin_amdgcn_sinf(rf);
    }
}

struct RowPass {
    const float* xsrc; const bf16* xbf; bf16* xdst;
    const float* gain;
    bf16* ob; float* of;
    int obp; float* ssq;
    unsigned char* ob8;
    int combine;
    int router; const float* wr;
};
constexpr int RG = 2;
__device__ __forceinline__ void phase_rows(Frame& F, const RowPass P) {
    LAS float* wrl = (LAS float*)F.lds;
    LAS int* hist = (LAS int*)(F.misc + MISC_SCR);
    const bf16* YS = (const bf16*)(F.ws + WS_GA);
    const int* posg = (const int*)(F.ws + WS_POS); const float* gateg = (const float*)(F.ws + WS_GATE);
    int* e01g = (int*)(F.ws + WS_E01); float* gatew = (float*)(F.ws + WS_GATE); int* tcnt = (int*)(F.ws + WS_TCNT);
    if (P.router) { for (int i = F.tid; i < D * 8; i += 512) wrl[i] = P.wr[i]; }
    f32x4 gv[4];
#pragma unroll
    for (int j = 0; j < 4; ++j) gv[j] = *(const f32x4*)(P.gain + 4 * F.lane + 256 * j);
    const int tstart = (F.G == 256) ? ((F.bx & 7) * 32 + (F.bx >> 3)) : F.bx, tstride = (F.G == 256) ? M / 256 : F.G;
    for (int tile = tstart; tile < M / 256; tile += tstride) {
        if (P.router) { if (F.tid < 8) hist[F.tid] = 0; }
        __syncthreads();
        f32x4 buf[RG][4]; u32x2 bub[RG][4];
#pragma unroll
        for (int q = 0; q < RG; ++q) {
            if (P.xsrc) { const float* xr = P.xsrc + (size_t)(tile * 256 + F.wave * 32 + q) * D + 4 * F.lane;
#pragma unroll
                for (int j = 0; j < 4; ++j) buf[q][j] = *(const f32x4*)(xr + 256 * j); }
            else { const bf16* xr = P.xbf + (size_t)(tile * 256 + F.wave * 32 + q) * XP + 4 * F.lane;
#pragma unroll
                for (int j = 0; j < 4; ++j) bub[q][j] = *(const u32x2*)(xr + 256 * j); } }
#pragma nounroll
        for (int i0 = 0; i0 < 32; i0 += RG) {
            const int rowb = tile * 256 + F.wave * 32 + i0;
            f32x4 v[RG][4];
#pragma unroll
            for (int q = 0; q < RG; ++q)
#pragma unroll
                for (int j = 0; j < 4; ++j) v[q][j] = P.xsrc ? buf[q][j] : (f32x4){bf_lo(bub[q][j].x), bf_hi(bub[q][j].x), bf_lo(bub[q][j].y), bf_hi(bub[q][j].y)};
            if (i0 + RG < 32) {
#pragma unroll
                for (int q = 0; q < RG; ++q) {
                    if (P.xsrc) { const float* xr = P.xsrc + (size_t)(rowb + RG + q) * D + 4 * F.lane;
#pragma unroll
                        for (int j = 0; j < 4; ++j) buf[q][j] = *(const f32x4*)(xr + 256 * j); }
                    else { const bf16* xr = P.xbf + (size_t)(rowb + RG + q) * XP + 4 * F.lane;
#pragma unroll
                        for (int j = 0; j < 4; ++j) bub[q][j] = *(const u32x2*)(xr + 256 * j); } }
            }
#pragma unroll
            for (int q = 0; q < RG; ++q) {
                const int row = rowb + q;
                if (P.combine) {
                    const int p0 = posg[2 * row], p1 = posg[2 * row + 1]; const float g0 = gateg[2 * row], g1 = gateg[2 * row + 1];
                    const bf16* y0 = YS + (size_t)p0 * D + 4 * F.lane; const bf16* y1 = YS + (size_t)p1 * D + 4 * F.lane;
#pragma unroll
                    for (int j = 0; j < 4; ++j) { const u32x2 a = *(const u32x2*)(y0 + 256 * j), b = *(const u32x2*)(y1 + 256 * j);
                        v[q][j][0] += g0 * bf_lo(a.x) + g1 * bf_lo(b.x); v[q][j][1] += g0 * bf_hi(a.x) + g1 * bf_hi(b.x);
                        v[q][j][2] += g0 * bf_lo(a.y) + g1 * bf_lo(b.y); v[q][j][3] += g0 * bf_hi(a.y) + g1 * bf_hi(b.y); }
                }
                if (P.xdst) {
                    bf16* xw = P.xdst + (size_t)row * XP + 4 * F.lane;
#pragma unroll
                    for (int j = 0; j < 4; ++j) { u32x2 w; w.x = pk2(v[q][j][0], v[q][j][1]); w.y = pk2(v[q][j][2], v[q][j][3]); *(u32x2*)(xw + 256 * j) = w; }
                }
                float s = 0.f;
#pragma unroll
                for (int j = 0; j < 4; ++j) s += (v[q][j][0] * v[q][j][0] + v[q][j][1] * v[q][j][1]) + (v[q][j][2] * v[q][j][2] + v[q][j][3] * v[q][j][3]);
                const float wsum = wave_sum(s);
                if (P.ssq) { if (F.lane < 4) *(f32x4*)(P.ssq + (size_t)row * 16 + 4 * F.lane) = (f32x4){F.lane == 0 ? wsum : 0.f, 0.f, 0.f, 0.f}; }
                const float rstd = 1.0f / sqrtf(wsum * (1.0f / D) + RMS_EPS);
#pragma unroll
                for (int j = 0; j < 4; ++j) v[q][j] = v[q][j] * rstd * gv[j];
                if (P.ob) {
                    bf16* o = P.ob + (size_t)row * P.obp + 4 * F.lane;
#pragma unroll
                    for (int j = 0; j < 4; ++j) { u32x2 w; w.x = pk2(v[q][j][0], v[q][j][1]); w.y = pk2(v[q][j][2], v[q][j][3]); *(u32x2*)(o + 256 * j) = w; }
                }
                if (P.ob8) {
                    unsigned char* o = P.ob8 + (size_t)row * D + 4 * F.lane;
#pragma unroll
                    for (int j = 0; j < 4; ++j) *(unsigned*)(o + 256 * j) = cvt4_fp8(v[q][j][0] * A8_SCALE, v[q][j][1] * A8_SCALE, v[q][j][2] * A8_SCALE, v[q][j][3] * A8_SCALE);
                }
                if (P.of) {
                    float* o = P.of + (size_t)row * D + 4 * F.lane;
#pragma unroll
                    for (int j = 0; j < 4; ++j) *(f32x4*)(o + 256 * j) = v[q][j];
                }
            }
            if (P.router) {
                float lg[RG][8];
#pragma unroll
                for (int q = 0; q < RG; ++q)
#pragma unroll
                    for (int e = 0; e < 8; ++e) lg[q][e] = 0.f;
#pragma unroll
                for (int j = 0; j < 4; ++j)
#pragma unroll
                    for (int c = 0; c < 4; ++c) { const LAS f32x4* w = (const LAS f32x4*)(wrl + (4 * F.lane + 256 * j + c) * 8); const f32x4 w0 = w[0], w1 = w[1];
#pragma unroll
                        for (int q = 0; q < RG; ++q) { const float h = v[q][j][c];
                            lg[q][0] += h * w0[0]; lg[q][1] += h * w0[1]; lg[q][2] += h * w0[2]; lg[q][3] += h * w0[3]; lg[q][4] += h * w1[0]; lg[q][5] += h * w1[1]; lg[q][6] += h * w1[2]; lg[q][7] += h * w1[3]; } }
#pragma unroll
                for (int q = 0; q < RG; ++q) {
                    const int row = rowb + q;
#pragma unroll
                    for (int e = 0; e < 8; ++e) lg[q][e] = wave_sum(lg[q][e]);
                    int e0 = 0; float b0 = lg[q][0];
#pragma unroll
                    for (int e = 1; e < 8; ++e) if (lg[q][e] > b0) { b0 = lg[q][e]; e0 = e; }
                    int e1 = -1; float b1 = -INFINITY;
#pragma unroll
                    for (int e = 0; e < 8; ++e) if (e != e0 && lg[q][e] > b1) { b1 = lg[q][e]; e1 = e; }
                    if (e1 < 0) { e1 = (e0 + 1) & 7; b1 = b0; }
                    const float g0 = 1.0f / (1.0f + expf(b1 - b0));
                    if (F.lane == 0) { e01g[row] = e0 | (e1 << 8); gatew[2 * row] = g0; gatew[2 * row + 1] = 1.0f - g0; lds_add(&hist[e0], 1); lds_add(&hist[e1], 1); }
                }
            }
        }
        __syncthreads();
        if (P.router) { if (F.tid < 8) tcnt[tile * 8 + F.tid] = hist[F.tid]; }
    }
}
__device__ __forceinline__ void phase_memnorm(Frame& F) {
    const int gw = F.bx * NWAVES + F.wave, NGW = F.G * NWAVES;
    bf16* MN = (bf16*)(F.ws + WS_MEMN4);
    const float* memp = INP(1); const float* gbase = INP(5);
    for (int r = gw; r < DEPTH * MROWS; r += NGW) {
        const int L = r / MROWS, row = r - L * MROWS;
        const float* xr = memp + (size_t)row * D + 4 * F.lane; const float* gain = gbase + (size_t)L * D + 4 * F.lane;
        f32x4 v[4]; float s = 0.f;
#pragma unroll
        for (int j = 0; j < 4; ++j) { v[j] = *(const f32x4*)(xr + 256 * j); s += (v[j][0] * v[j][0] + v[j][1] * v[j][1]) + (v[j][2] * v[j][2] + v[j][3] * v[j][3]); }
        const float rstd = 1.0f / sqrtf(wave_sum(s) * (1.0f / D) + RMS_EPS);
        bf16* o = MN + (size_t)r * D + 4 * F.lane;
#pragma unroll
        for (int j = 0; j < 4; ++j) { const f32x4 y = v[j] * rstd * *(const f32x4*)(gain + 256 * j); u32x2 w; w.x = pk2(y[0], y[1]); w.y = pk2(y[2], y[3]); *(u32x2*)(o + 256 * j) = w; }
    }
}

__device__ __forceinline__ void phase_moe_assign(Frame& F) {
    LAS int* sc = (LAS int*)(F.misc + MISC_SCR);
    LAS int* dst = (LAS int*)(F.lds);
    const int* tcnt = (const int*)(F.ws + WS_TCNT); const int* e01g = (const int*)(F.ws + WS_E01);
    int* posg = (int*)(F.ws + WS_POS); int* texp = (int*)(F.ws + WS_TEXP);
    const unsigned char* HB8 = F.ws + WS_HB; unsigned char* GA8 = F.ws + WS_GA8;
    const int tstart = (F.G == 256) ? ((F.bx & 7) * 32 + (F.bx >> 3)) : F.bx, tstride = (F.G == 256) ? M / 256 : F.G;
    for (int tile = tstart; tile < M / 256; tile += tstride) {
        __syncthreads();
        if (F.tid < 80) sc[F.tid] = 0;
        __syncthreads();
        if (F.tid < 256) {
            const int j = F.tid;
#pragma unroll
            for (int e = 0; e < 8; ++e) { const int c = tcnt[j * 8 + e]; lds_add(&sc[e], c); if (j < tile) lds_add(&sc[8 + e], c); }
        }
        __syncthreads();
        if (F.tid == 0) { int ps = 0; for (int e = 0; e < 8; ++e) { sc[64 + e] = ps; sc[16 + e] = ps + sc[8 + e]; ps += (sc[e] + 255) & ~255; } sc[72] = ps; }
        __syncthreads();
        if (tile == 0 && F.tid < 8) {
            const int e = F.tid; const int t0 = sc[64 + e] >> 8, t1 = (e == 7 ? sc[72] : sc[64 + e + 1]) >> 8;
            for (int t = t0; t < t1; ++t) texp[t] = e;
            if (e == 7) texp[MAXTILES] = sc[72] >> 8;
        }
        int e0 = 0, e1 = 0, r0 = 0, r1 = 0;
        if (F.tid < 256) {
            const int w = F.tid >> 6; const int pk = e01g[tile * 256 + F.tid]; e0 = pk & 255; e1 = pk >> 8;
            const unsigned long long below = (1ull << F.lane) - 1ull;
#pragma unroll
            for (int e = 0; e < 8; ++e) {
                const unsigned long long m0 = __ballot(e0 == e), m1 = __ballot(e1 == e);
                const int rk = __popcll(m0 & below) + __popcll(m1 & below);
                if (e0 == e) r0 = rk; if (e1 == e) r1 = rk;
                if (F.lane == 0) sc[32 + w * 8 + e] = __popcll(m0) + __popcll(m1);
            }
        }
        __syncthreads();
        if (F.tid < 256) {
            const int w = F.tid >> 6; int b0 = sc[16 + e0], b1 = sc[16 + e1];
            for (int ww = 0; ww < w; ++ww) { b0 += sc[32 + ww * 8 + e0]; b1 += sc[32 + ww * 8 + e1]; }
            const int d0 = b0 + r0, d1 = b1 + r1;
            dst[2 * F.tid] = d0; dst[2 * F.tid + 1] = d1;
            posg[2 * (tile * 256 + F.tid)] = d0; posg[2 * (tile * 256 + F.tid) + 1] = d1;
        }
        __syncthreads();
#pragma nounroll
        for (int t0 = F.wave * 32; t0 < F.wave * 32 + 32; t0 += 16) {
            u32x4 v[16];
#pragma unroll
            for (int j = 0; j < 16; ++j) v[j] = ((const u32x4*)(HB8 + (size_t)(tile * 256 + t0 + j) * D))[F.lane];
#pragma unroll
            for (int j = 0; j < 16; ++j) { const int d0 = dst[2 * (t0 + j)], d1 = dst[2 * (t0 + j) + 1];
                ((u32x4*)(GA8 + (size_t)d0 * D))[F.lane] = v[j]; ((u32x4*)(GA8 + (size_t)d1 * D))[F.lane] = v[j]; }
        }
    }
}

namespace att {
constexpr int L_OS = 0, L_MS = 32768, L_LS = 33792, L_SSQ = 34816, L_RPB = 51200, L_KV = 62976, KV_WAVE = 8832, KT_BYTES = 4608;
static_assert(L_KV + 8 * KV_WAVE <= MISC_OFF, "attention LDS map");
__device__ __forceinline__ f32x4 mfma16(bf16x8 a, bf16x8 b, f32x4 c) { return __builtin_amdgcn_mfma_f32_16x16x32_bf16(a, b, c, 0, 0, 0); }
__device__ __forceinline__ v4i16_t vtr(const LAS unsigned char* p) { return __builtin_amdgcn_ds_read_tr16_b64_v4i16((LAS v4i16_t*)p); }

struct St { float m, lp; f32x4 o[4]; };
__device__ __forceinline__ void st_init(St& s) { s.m = -1e30f; s.lp = 0.f;
#pragma unroll
    for (int d = 0; d < 4; ++d) s.o[d] = (f32x4){0.f, 0.f, 0.f, 0.f}; }

struct Ld { u32x4 k0, k1, k2, k3, v0, v1, v2, v3; };
__device__ __forceinline__ void ld_issue8(Ld& L, const bf16* k0p, const bf16* k1p, const bf16* k2p, const bf16* k3p, const bf16* v0p, const bf16* v1p, const bf16* v2p, const bf16* v3p) {
    L.k0 = *(const u32x4*)(k0p); L.k1 = *(const u32x4*)(k1p); L.k2 = *(const u32x4*)(k2p); L.k3 = *(const u32x4*)(k3p);
    L.v0 = *(const u32x4*)(v0p); L.v1 = *(const u32x4*)(v1p); L.v2 = *(const u32x4*)(v2p); L.v3 = *(const u32x4*)(v3p);
}
__device__ __forceinline__ void ld_issue(Ld& L, const bf16* kp, const bf16* vp, size_t r8) { ld_issue8(L, kp, kp + r8, kp + 2 * r8, kp + 3 * r8, vp, vp + r8, vp + 2 * r8, vp + 3 * r8); }
constexpr int VPL = 1056;
struct Kf { bf16x8 k00, k01, k10, k11; };
__device__ __forceinline__ void stage_kv(const Ld& L, LAS unsigned char* kvl, int lane) {
    LAS unsigned char* kw = kvl + (lane >> 3) * 144 + (lane & 7) * 16;
    *(LAS u32x4*)(kw) = L.k0; *(LAS u32x4*)(kw + 1152) = L.k1; *(LAS u32x4*)(kw + 2304) = L.k2; *(LAS u32x4*)(kw + 3456) = L.k3;
    const int c = lane & 7; LAS unsigned char* vw = kvl + KT_BYTES + (c >> 1) * VPL + (lane >> 3) * 32 + (c & 1) * 16;
    *(LAS u32x4*)(vw) = L.v0; *(LAS u32x4*)(vw + 256) = L.v1; *(LAS u32x4*)(vw + 512) = L.v2; *(LAS u32x4*)(vw + 768) = L.v3;
}
__device__ __forceinline__ Kf kf_read(const LAS unsigned char* kvl, int lq, int lg) {
    const LAS unsigned char* p = kvl + lq * 144 + lg * 16; Kf k;
    k.k00 = *(const LAS bf16x8*)(p); k.k01 = *(const LAS bf16x8*)(p + 64); k.k10 = *(const LAS bf16x8*)(p + 16 * 144); k.k11 = *(const LAS bf16x8*)(p + 16 * 144 + 64); return k;
}
__device__ __forceinline__ void qk(const Kf& L, const bf16x8 (&q)[2], f32x4& s0, f32x4& s1) {
    const f32x4 z = (f32x4){0.f, 0.f, 0.f, 0.f};
    s0 = mfma16(L.k00, q[0], z); s0 = mfma16(L.k01, q[1], s0); s1 = mfma16(L.k10, q[0], z); s1 = mfma16(L.k11, q[1], s1);
}
__device__ __forceinline__ void soft_pv(f32x4 s0, f32x4 s1, const LAS unsigned char* vl, int lq, int lg, St& S) {
    const float mx = vmax2(vmax3(s0[0], s0[1], s0[2]), vmax3(vmax3(s0[3], s1[0], s1[1]), s1[2], s1[3]));
    if (__any(mx > S.m + 8.0f)) {
        float mf = vmax2(mx, __shfl_xor(mx, 16)); mf = vmax2(mf, __shfl_xor(mf, 32));
        const float mn = vmax2(S.m, mf); const float alpha = __builtin_amdgcn_exp2f(S.m - mn); S.m = mn;
        S.lp *= alpha;
#pragma unroll
        for (int d = 0; d < 4; ++d) S.o[d] = S.o[d] * alpha;
    }
    const float mn = S.m;
    float p[8];
#pragma unroll
    for (int r = 0; r < 4; ++r) { p[r] = __builtin_amdgcn_exp2f(s0[r] - mn); p[4 + r] = __builtin_amdgcn_exp2f(s1[r] - mn); }
    S.lp += ((p[0] + p[1]) + (p[2] + p[3])) + ((p[4] + p[5]) + (p[6] + p[7]));
    u32x4 pw; pw.x = pg8::cvt_pk_bf16(p[0], p[1]); pw.y = pg8::cvt_pk_bf16(p[2], p[3]); pw.z = pg8::cvt_pk_bf16(p[4], p[5]); pw.w = pg8::cvt_pk_bf16(p[6], p[7]);
    const bf16x8 pf = __builtin_bit_cast(bf16x8, pw);
    const LAS unsigned char* tb = vl + KT_BYTES + (4 * lg + (lq >> 2)) * 32 + 8 * (lq & 3);
#pragma unroll
    for (int d = 0; d < 4; ++d) {
        const v4i16_t lo = vtr(tb + d * VPL), hi = vtr(tb + d * VPL + 512);
        const bf16x8 vf = (bf16x8){lo[0], lo[1], lo[2], lo[3], hi[0], hi[1], hi[2], hi[3]};
        S.o[d] = mfma16(vf, pf, S.o[d]);
    }
}
template <int NT>
__device__ __forceinline__ void multi_soft_pv(f32x4 (&s0)[NT], f32x4 (&s1)[NT], const LAS unsigned char* vl, int lq, int lg, St (&S)[NT], const int am = -1) {
    float mx[NT]; bool trig = false;
#pragma unroll
    for (int t = 0; t < NT; ++t) if (am & (1 << t)) { mx[t] = vmax2(vmax3(s0[t][0], s0[t][1], s0[t][2]), vmax3(vmax3(s0[t][3], s1[t][0], s1[t][1]), s1[t][2], s1[t][3])); trig = trig || (mx[t] > S[t].m + 8.0f); }
    if (__any(trig)) {
#pragma unroll
        for (int t = 0; t < NT; ++t) if (am & (1 << t)) {
            float mf = vmax2(mx[t], __shfl_xor(mx[t], 16)); mf = vmax2(mf, __shfl_xor(mf, 32));
            const float mn = vmax2(S[t].m, mf); const float alpha = __builtin_amdgcn_exp2f(S[t].m - mn); S[t].m = mn; S[t].lp *= alpha;
#pragma unroll
            for (int d = 0; d < 4; ++d) S[t].o[d] = S[t].o[d] * alpha;
        }
    }
    bf16x8 pf[NT];
#pragma unroll
    for (int t = 0; t < NT; ++t) if (am & (1 << t)) {
        const float mn = S[t].m; float p[8];
#pragma unroll
        for (int r = 0; r < 4; ++r) { p[r] = __builtin_amdgcn_exp2f(s0[t][r] - mn); p[4 + r] = __builtin_amdgcn_exp2f(s1[t][r] - mn); }
        S[t].lp += ((p[0] + p[1]) + (p[2] + p[3])) + ((p[4] + p[5]) + (p[6] + p[7]));
        u32x4 pw; pw.x = pg8::cvt_pk_bf16(p[0], p[1]); pw.y = pg8::cvt_pk_bf16(p[2], p[3]); pw.z = pg8::cvt_pk_bf16(p[4], p[5]); pw.w = pg8::cvt_pk_bf16(p[6], p[7]);
        pf[t] = __builtin_bit_cast(bf16x8, pw);
    }
    const LAS unsigned char* tb = vl + KT_BYTES + (4 * lg + (lq >> 2)) * 32 + 8 * (lq & 3);
#pragma unroll
    for (int d = 0; d < 4; ++d) {
        const v4i16_t lo = vtr(tb + d * VPL), hi = vtr(tb + d * VPL + 512);
        const bf16x8 vf = (bf16x8){lo[0], lo[1], lo[2], lo[3], hi[0], hi[1], hi[2], hi[3]};
#pragma unroll
        for (int t = 0; t < NT; ++t) if (am & (1 << t)) S[t].o[d] = mfma16(vf, pf[t], S[t].o[d]);
    }
}
__device__ __forceinline__ float lsum(float lp) { lp += __shfl_xor(lp, 16); lp += __shfl_xor(lp, 32); return lp; }

__device__ __forceinline__ void finish(const St& S, float l, bf16* yrow  , LAS float* ssq_slot, int lg) {
    const float inv = 1.0f / l; float ss = 0.f;
#pragma unroll
    for (int d = 0; d < 4; ++d) { const f32x4 v = S.o[d] * inv; ss += (v[0] * v[0] + v[1] * v[1]) + (v[2] * v[2] + v[3] * v[3]);
        u32x2 w; w.x = pg8::cvt_pk_bf16(v[0], v[1]); w.y = pg8::cvt_pk_bf16(v[2], v[3]); *(u32x2*)(yrow + 16 * d + 4 * lg) = w; }
    ss += __shfl_xor(ss, 16); ss += __shfl_xor(ss, 32);
    if (lg == 0) *ssq_slot = ss;
}

__device__ __forceinline__ void attn_unit(Frame& F, int b, int t0, int layer) {
    LAS unsigned char* lds = F.lds;
    int lane = F.lane, lq = lane & 15, lg = lane >> 4; const int wave = F.wave;
#define RELANE() do { asm volatile("" : "+v"(lane)); lq = lane & 15; lg = lane >> 4; } while (0)
    const bf16* QKV = (const bf16*)(F.ws + WS_BIG); const bf16* MKV = (const bf16*)(F.ws + WS_MEMKV4) + (size_t)layer * MROWS * 512; bf16* Y = (bf16*)(F.ws + WS_HB);
    LAS bf16* Os = (LAS bf16*)(lds + L_OS); LAS float* Ms = (LAS float*)(lds + L_MS); LAS float* Ls = (LAS float*)(lds + L_LS);
    LAS float* ssq = (LAS float*)(lds + L_SSQ); LAS float* rpb = (LAS float*)(lds + L_RPB);
    LAS unsigned char* vl = lds + L_KV + wave * KV_WAVE;
    const size_t rowb = (size_t)b * T;
    { const float* rp = INP(4) + (size_t)layer * 6 * 465; for (int i = F.tid; i < 6 * 480; i += 512) { const int hh = i / 480, rem = i - hh * 480, ro = rem >> 5, co = rem & 31; rpb[i] = co < 31 ? rp[hh * 465 + ro * 31 + co] * LOG2E : -INFINITY; } }
    __syncthreads();
    const int R0 = t0 >> 6;
#pragma nounroll
    for (int pass = 0; pass < 3; ++pass) {
        RELANE();
        const int h = 2 * pass + (wave >> 2), kq = wave & 3;
        const int qc = 16 * kq + lq, cs = (kq == 0) ? 0 : (kq == 1) ? 8 : (kq == 2) ? 24 : 32;
        int c0q = qc - 8; c0q = c0q < 0 ? 0 : (c0q > 48 ? 48 : c0q);
        unsigned bcol[8];
#pragma unroll
        for (int e = 0; e < 8; ++e) { const int c = cs + 16 * (e >> 2) + 4 * lg + (e & 3); const bool ok = (c >= c0q) && (c <= c0q + 15);
            bcol[e] = (unsigned)(uintptr_t)(rpb + h * 480) + 4u * (unsigned)(ok ? (c - qc + 15) : 31); }
        int r0v[4]; bf16x8 qf[4][2]; St S[4];
#pragma unroll
        for (int rr = 0; rr < 4; ++rr) { const int r = R0 + rr; int r0 = r - 4; r0 = r0 < 0 ? 0 : (r0 > 120 ? 120 : r0); r0v[rr] = r0;
            const size_t qrow = rowb + (size_t)r * 64 + qc;
            qf[rr][0] = *(const bf16x8*)(QKV + qrow * NQKV + OFF_QA + h * 64 + lg * 8); qf[rr][1] = *(const bf16x8*)(QKV + qrow * NQKV + OFF_QA + h * 64 + 32 + lg * 8);
            st_init(S[rr]); }
        const int krmin = r0v[0], nrows = r0v[3] + 8 - krmin;
        const bf16* kbase = QKV + (rowb + (size_t)krmin * 64 + cs + (lane >> 3)) * NQKV + OFF_KA + h * 64 + (lane & 7) * 8;
        const bf16* vbase = kbase + (OFF_VA - OFF_KA);
        const size_t v8 = (size_t)8 * NQKV;
        const size_t rstep = (size_t)64 * NQKV;
        auto na_row = [&](int kr) {
            const Kf kf = kf_read(vl, lq, lg);
            f32x4 s0[4], s1[4];
            int am = 0;
#pragma unroll
            for (int rr = 0; rr < 4; ++rr) am |= (kr >= r0v[rr] && kr < r0v[rr] + 8) ? (1 << rr) : 0;
            am = __builtin_amdgcn_readfirstlane(am);
#pragma unroll
            for (int rr = 0; rr < 4; ++rr) if (am & (1 << rr)) {
                const unsigned ro = (unsigned)(kr - (R0 + rr) + 7) * 128u;
                f32x4 a0, a1;
#pragma unroll
                for (int e = 0; e < 4; ++e) { a0[e] = *(const LAS float*)(uintptr_t)(bcol[e] + ro); a1[e] = *(const LAS float*)(uintptr_t)(bcol[4 + e] + ro); }
                qk(kf, qf[rr], s0[rr], s1[rr]);
                s0[rr] = s0[rr] + a0; s1[rr] = s1[rr] + a1;
            }
            multi_soft_pv<4>(s0, s1, vl, lq, lg, S, am);
            asm volatile("" ::: "memory");
        };
        Ld LA;
        ld_issue(LA, kbase, vbase, v8);
#pragma nounroll
        for (int j = 0; j < nrows; ++j) {
            stage_kv(LA, vl, lane);
            asm volatile("" ::: "memory");
            { const int jn = (j + 1 < nrows) ? j + 1 : nrows - 1; ld_issue(LA, kbase + (size_t)jn * rstep, vbase + (size_t)jn * rstep, v8); }
            na_row(krmin + j);
        }
#pragma unroll
        for (int rr = 0; rr < 4; ++rr) { const float l = lsum(S[rr].lp);
            finish(S[rr], l, Y + (rowb + (size_t)(R0 + rr) * 64 + qc) * D + h * 64, ssq + h * 256 + (rr * 64 + qc), lg); }
    }
#pragma nounroll
    for (int pass = 0; pass < 2; ++pass) {
        RELANE();
        const int h = 2 * pass + (wave >> 2), j0 = 4 * (wave & 3);
        bf16x8 qf[4][2]; St S[4];
#pragma unroll
        for (int t = 0; t < 4; ++t) { const size_t qrow = rowb + t0 + 16 * (j0 + t) + lq;
            qf[t][0] = *(const bf16x8*)(QKV + qrow * NQKV + OFF_QM + h * 64 + lg * 8); qf[t][1] = *(const bf16x8*)(QKV + qrow * NQKV + OFF_QM + h * 64 + 32 + lg * 8);
            st_init(S[t]); }
        const bf16* kbase = MKV + ((size_t)b * NMEM + (lane >> 3)) * 512 + h * 64 + (lane & 7) * 8;
        const bf16* vbase = kbase + 256;
        Ld LA;
        ld_issue(LA, kbase, vbase, (size_t)8 * 512);
#pragma nounroll
        for (int s = 0; s < 8; ++s) {
            stage_kv(LA, vl, lane);
            asm volatile("" ::: "memory");
            { const int sn = (s + 1 < 8) ? s + 1 : 7; ld_issue(LA, kbase + sn * 32 * 512, vbase + sn * 32 * 512, (size_t)8 * 512); }
            const Kf kf = kf_read(vl, lq, lg);
            f32x4 s0[4], s1[4];
#pragma unroll
            for (int t = 0; t < 4; ++t) qk(kf, qf[t], s0[t], s1[t]);
            multi_soft_pv<4>(s0, s1, vl, lq, lg, S);
            asm volatile("" ::: "memory");
        }
#pragma unroll
        for (int t = 0; t < 4; ++t) { const int idx = 16 * (j0 + t) + lq; const float l = lsum(S[t].lp);
            finish(S[t], l, Y + (rowb + t0 + idx) * D + 768 + h * 64, ssq + (12 + h) * 256 + idx, lg); }
    }
    __syncthreads();
    for (int h = 0; h < 6; ++h) {
#pragma nounroll
        for (int br = 0; br < 2; ++br) {
            RELANE();
            const int sh = 2 * br, dl = 1 << sh, seg = T >> sh;
            const int res = br ? (wave >> 1) : 0, m0 = br ? ((t0 >> 2) + 32 * (wave & 1)) : (t0 + 32 * wave);
            bf16x8 qf[2][2]; St S[2]; int idxv[2];
#pragma unroll
            for (int t = 0; t < 2; ++t) { const size_t qrow = rowb + (size_t)(m0 + 16 * t + lq) * dl + res;
                qf[t][0] = *(const bf16x8*)(QKV + qrow * NQKV + OFF_QB + h * 64 + lg * 8); qf[t][1] = *(const bf16x8*)(QKV + qrow * NQKV + OFF_QB + h * 64 + 32 + lg * 8);
                st_init(S[t]); idxv[t] = br ? (128 * (wave & 1) + 64 * t + 4 * lq + res) : (32 * wave + 16 * t + lq); }
            const bool edge = (m0 - 64 < 0) || (m0 + 95 >= seg);
            auto dload = [&](Ld& L, int s) {
                const int kb = m0 - 64 + 32 * s;
                int kv = kb + (lane >> 3);
                const bf16* kcol = QKV + (rowb + res) * NQKV + OFF_KB + h * 64 + (lane & 7) * 8; const bf16* vcol = kcol + (OFF_VB - OFF_KB);
                const size_t rs = (size_t)dl * NQKV;
                if (edge) {
                    int v0 = kv, v1 = kv + 8, v2 = kv + 16, v3 = kv + 24;
                    v0 = v0 < 0 ? 0 : (v0 >= seg ? seg - 1 : v0); v1 = v1 < 0 ? 0 : (v1 >= seg ? seg - 1 : v1); v2 = v2 < 0 ? 0 : (v2 >= seg ? seg - 1 : v2); v3 = v3 < 0 ? 0 : (v3 >= seg ? seg - 1 : v3);
                    ld_issue8(L, kcol + (size_t)v0 * rs, kcol + (size_t)v1 * rs, kcol + (size_t)v2 * rs, kcol + (size_t)v3 * rs, vcol + (size_t)v0 * rs, vcol + (size_t)v1 * rs, vcol + (size_t)v2 * rs, vcol + (size_t)v3 * rs);
                } else ld_issue(L, kcol + (size_t)kv * rs, vcol + (size_t)kv * rs, 8 * rs); };
            auto dstep = [&](int s) {
                const Kf kf = kf_read(vl, lq, lg);
                const int kb = m0 - 64 + 32 * s;
                f32x4 s0[2], s1[2];
#pragma unroll
                for (int t = 0; t < 2; ++t) {
                    qk(kf, qf[t], s0[t], s1[t]);
                    if (edge || s == 0 || s == 4) {
                        const int qm = m0 + 16 * t + lq;
#pragma unroll
                        for (int e = 0; e < 8; ++e) { const int km = kb + 16 * (e >> 2) + 4 * lg + (e & 3); const int dd = km - qm;
                            const bool ok = (km >= 0) && (km < seg) && (dd >= -64) && (dd <= 64); if (!ok) { if (e < 4) s0[t][e] = -INFINITY; else s1[t][e - 4] = -INFINITY; } }
                    }
                }
                multi_soft_pv<2>(s0, s1, vl, lq, lg, S);
                asm volatile("" ::: "memory");
            };
            { Ld LA;
              dload(LA, 0);
#pragma nounroll
              for (int s = 0; s < 5; ++s) {
                  stage_kv(LA, vl, lane);
                  asm volatile("" ::: "memory");
                  dload(LA, s + 1 < 5 ? s + 1 : 4);
                  dstep(s);
              } }
#pragma unroll
            for (int t = 0; t < 2; ++t) {
                const int idx = idxv[t]; float l = lsum(S[t].lp);
                LAS u32x2* osr = (LAS u32x2*)(Os + idx * 64 + 4 * lg);
                if (br > 0) {
                    const float m1 = Ms[idx], l1 = Ls[idx]; const float mn = vmax2(S[t].m, m1);
                    const float a1 = __builtin_amdgcn_exp2f(m1 - mn), a2 = __builtin_amdgcn_exp2f(S[t].m - mn);
#pragma unroll
                    for (int d = 0; d < 4; ++d) { const u32x2 w = osr[4 * d]; const f32x4 o1 = (f32x4){bf_lo(w.x), bf_hi(w.x), bf_lo(w.y), bf_hi(w.y)}; S[t].o[d] = o1 * a1 + S[t].o[d] * a2; }
                    l = l1 * a1 + l * a2; S[t].m = mn;
                }
#pragma unroll
                for (int d = 0; d < 4; ++d) { u32x2 w; w.x = pg8::cvt_pk_bf16(S[t].o[d][0], S[t].o[d][1]); w.y = pg8::cvt_pk_bf16(S[t].o[d][2], S[t].o[d][3]); osr[4 * d] = w; }
                if (lg == 0) { Ms[idx] = S[t].m; Ls[idx] = l; }
            }
            __syncthreads();
        }
        {
            constexpr int dl = 16, seg = T >> 4;
#pragma nounroll
            for (int tix = wave; tix < 16; tix += 8) {
                RELANE();
                const int res = tix, m0 = t0 >> 4, idx = 16 * lq + res;
                const size_t qrow = rowb + (size_t)(m0 + lq) * dl + res;
                bf16x8 qf[2];
                qf[0] = *(const bf16x8*)(QKV + qrow * NQKV + OFF_QB + h * 64 + lg * 8); qf[1] = *(const bf16x8*)(QKV + qrow * NQKV + OFF_QB + h * 64 + 32 + lg * 8);
                St S; st_init(S);
                const int qm = m0 + lq;
                const bool edge = (m0 - 64 < 0) || (m0 + 95 >= seg);
                auto dload = [&](Ld& L, int s) {
                    const int kb = m0 - 64 + 32 * s;
                    int kv = kb + (lane >> 3);
                    const bf16* kcol = QKV + (rowb + res) * NQKV + OFF_KB + h * 64 + (lane & 7) * 8; const bf16* vcol = kcol + (OFF_VB - OFF_KB);
                    const size_t rs = (size_t)dl * NQKV;
                    if (edge) {
                        int v0 = kv, v1 = kv + 8, v2 = kv + 16, v3 = kv + 24;
                        v0 = v0 < 0 ? 0 : (v0 >= seg ? seg - 1 : v0); v1 = v1 < 0 ? 0 : (v1 >= seg ? seg - 1 : v1); v2 = v2 < 0 ? 0 : (v2 >= seg ? seg - 1 : v2); v3 = v3 < 0 ? 0 : (v3 >= seg ? seg - 1 : v3);
                        ld_issue8(L, kcol + (size_t)v0 * rs, kcol + (size_t)v1 * rs, kcol + (size_t)v2 * rs, kcol + (size_t)v3 * rs, vcol + (size_t)v0 * rs, vcol + (size_t)v1 * rs, vcol + (size_t)v2 * rs, vcol + (size_t)v3 * rs);
                    } else ld_issue(L, kcol + (size_t)kv * rs, vcol + (size_t)kv * rs, 8 * rs); };
                auto dstep = [&](int s) {
                    const Kf kf = kf_read(vl, lq, lg);
                    const int kb = m0 - 64 + 32 * s;
                    f32x4 s0, s1; qk(kf, qf, s0, s1);
                    if (edge || s == 0 || s == 4) {
#pragma unroll
                        for (int e = 0; e < 8; ++e) { const int km = kb + 16 * (e >> 2) + 4 * lg + (e & 3); const int dd = km - qm;
                            const bool ok = (km >= 0) && (km < seg) && (dd >= -64) && (dd <= 64); if (!ok) { if (e < 4) s0[e] = -INFINITY; else s1[e - 4] = -INFINITY; } }
                    }
                    soft_pv(s0, s1, vl, lq, lg, S);
                    asm volatile("" ::: "memory");
                };
                { Ld LA;
                  dload(LA, 0);
#pragma nounroll
                  for (int s = 0; s < 5; ++s) {
                      stage_kv(LA, vl, lane);
                      asm volatile("" ::: "memory");
                      dload(LA, s + 1 < 5 ? s + 1 : 4);
                      dstep(s);
                  } }
                float l = lsum(S.lp);
                LAS u32x2* osr = (LAS u32x2*)(Os + idx * 64 + 4 * lg);
                { const float m1 = Ms[idx], l1 = Ls[idx]; const float mn = vmax2(S.m, m1);
                  const float a1 = __builtin_amdgcn_exp2f(m1 - mn), a2 = __builtin_amdgcn_exp2f(S.m - mn);
#pragma unroll
                  for (int d = 0; d < 4; ++d) { const u32x2 w = osr[4 * d]; const f32x4 o1 = (f32x4){bf_lo(w.x), bf_hi(w.x), bf_lo(w.y), bf_hi(w.y)}; S.o[d] = o1 * a1 + S.o[d] * a2; }
                  l = l1 * a1 + l * a2; S.m = mn; }
                finish(S, l, Y + qrow * D + 384 + h * 64, ssq + (6 + h) * 256 + idx, lg);
            }
            __syncthreads();
        }
    }
    VM_WAIT(); __syncthreads();
    RELANE();
    {
        const float* gm = INP(7) + (size_t)layer * D;
        const int c0 = 8 * lane, c1 = 512 + 8 * lane;
        const int g0 = c0 < 384 ? 0 : 1, g1 = c1 < 768 ? 1 : 2;
        f32x4 ga[2], gb[2];
        ga[0] = *(const f32x4*)(gm + c0); ga[1] = *(const f32x4*)(gm + c0 + 4); gb[0] = *(const f32x4*)(gm + c1); gb[1] = *(const f32x4*)(gm + c1 + 4);
#pragma nounroll
        for (int i0 = 0; i0 < 32; i0 += 4) {
            u32x4 w0[4], w1[4]; float s0v[4], s1v[4];
#pragma unroll
            for (int q = 0; q < 4; ++q) { const bf16* yr = Y + (rowb + t0 + wave * 32 + i0 + q) * D; w0[q] = *(const u32x4*)(yr + c0); w1[q] = *(const u32x4*)(yr + c1); }
#pragma unroll
            for (int q = 0; q < 4; ++q) {
                const int idx = wave * 32 + i0 + q;
                float sa = 0.f, sb = 0.f, sm = 0.f;
#pragma unroll
                for (int hh = 0; hh < 6; ++hh) { sa += ssq[hh * 256 + idx]; sb += ssq[(6 + hh) * 256 + idx]; }
#pragma unroll
                for (int hh = 0; hh < 4; ++hh) sm += ssq[(12 + hh) * 256 + idx];
                const float ra = 1.0f / sqrtf(sa * (1.0f / 384.f) + RMS_EPS), rb = 1.0f / sqrtf(sb * (1.0f / 384.f) + RMS_EPS), rm = 1.0f / sqrtf(sm * (1.0f / 256.f) + RMS_EPS);
                s0v[q] = g0 == 0 ? ra : rb; s1v[q] = g1 == 1 ? rb : rm;
            }
#pragma unroll
            for (int q = 0; q < 4; ++q) {
                bf16* yr = Y + (rowb + t0 + wave * 32 + i0 + q) * D; const float s0 = s0v[q], s1 = s1v[q]; const u32x4 a = w0[q], bb = w1[q];
                u32x4 o0, o1;
                o0.x = pk2(bf_lo(a.x) * s0 * ga[0][0], bf_hi(a.x) * s0 * ga[0][1]); o0.y = pk2(bf_lo(a.y) * s0 * ga[0][2], bf_hi(a.y) * s0 * ga[0][3]);
                o0.z = pk2(bf_lo(a.z) * s0 * ga[1][0], bf_hi(a.z) * s0 * ga[1][1]); o0.w = pk2(bf_lo(a.w) * s0 * ga[1][2], bf_hi(a.w) * s0 * ga[1][3]);
                o1.x = pk2(bf_lo(bb.x) * s1 * gb[0][0], bf_hi(bb.x) * s1 * gb[0][1]); o1.y = pk2(bf_lo(bb.y) * s1 * gb[0][2], bf_hi(bb.y) * s1 * gb[0][3]);
                o1.z = pk2(bf_lo(bb.z) * s1 * gb[1][0], bf_hi(bb.z) * s1 * gb[1][1]); o1.w = pk2(bf_lo(bb.w) * s1 * gb[1][2], bf_hi(bb.w) * s1 * gb[1][3]);
                *(u32x4*)(yr + c0) = o0; *(u32x4*)(yr + c1) = o1;
            }
        }
    }
    __syncthreads();
}
}

#ifdef NO_G1
#define GEMM_SITE1(x)
#else
#define GEMM_SITE1(x) x
#endif
#ifdef NO_G2
#define GEMM_SITE2(x)
#else
#define GEMM_SITE2(x) x
#endif
#ifdef NO_G3
#define GEMM_SITE3(x)
#else
#define GEMM_SITE3(x) x
#endif
#ifdef NO_G4
#define GEMM_SITE4(x)
#else
#define GEMM_SITE4(x) x
#endif
#ifdef NO_G5
#define GEMM_SITE5(x)
#else
#define GEMM_SITE5(x) x
#endif
#ifdef NO_G6
#define GEMM_SITE6(x)
#else
#define GEMM_SITE6(x) x
#endif
#ifdef NO_G7
#define GEMM_SITE7(x)
#else
#define GEMM_SITE7(x) x
#endif
struct Args { const float* in[18]; float* out; unsigned char* ws; int ph_lo, ph_hi, use_bar, pad; };
constexpr int PH_PER_LAYER = 16, SEQ_FINAL = 1 + DEPTH * PH_PER_LAYER, SEQ_END = SEQ_FINAL + 1;

__global__ void __launch_bounds__(NWAVES * 64, 2) fwd_kernel(Args args) {
    extern __shared__ __attribute__((aligned(16))) unsigned char lds_raw[];
    Frame F;
    F.lds = (LAS unsigned char*)lds_raw; F.misc = F.lds + MISC_OFF;
    F.tid = threadIdx.x; F.lane = F.tid & 63; F.wave = __builtin_amdgcn_readfirstlane(F.tid >> 6);
    F.G = gridDim.x; F.bx = blockIdx.x; F.ws = args.ws; F.out = args.out;
    if (F.tid == 0) {
#pragma unroll
        for (int i = 0; i < 18; ++i) ((LAS unsigned long long*)(F.misc + MISC_PTAB))[i] = (unsigned long long)args.in[i];
        ((LAS unsigned long long*)(F.misc + MISC_PTAB))[18] = (unsigned long long)args.ws; ((LAS unsigned long long*)(F.misc + MISC_PTAB))[19] = (unsigned long long)args.out;
    }
    gu32* ctl = (gu32*)(F.ws + WS_CTL);
    if (F.tid < 4) ((LAS unsigned*)(F.misc + MISC_BARW))[F.tid] = 0u;
    __syncthreads();
    XcdBarrier bar; bar.bar = (unsigned*)(ctl + CW_BAR); bar.x = 0; bar.st = nullptr;
    if (args.use_bar) { bar = xcd_barrier_post((unsigned*)(ctl + CW_BAR), (volatile LAS unsigned*)(F.misc + MISC_BARW)); if (F.tid == 0) ((volatile LAS unsigned*)(F.misc + MISC_BARW))[2] = bar.x; __syncthreads(); }
    const int lo = args.ph_lo, hi = args.ph_hi;
#define IN(k) (lo <= (k) && (k) < hi)
#define LAUNDER() do { unsigned lb_ = (unsigned)(uintptr_t)(LAS unsigned char*)lds_raw; asm volatile("" : "+v"(lb_)); lb_ = (unsigned)__builtin_amdgcn_readfirstlane((int)lb_); F.lds = (LAS unsigned char*)(uintptr_t)lb_; F.misc = F.lds + MISC_OFF; \
    F.ws = (unsigned char*)inp_ptr(F.misc, 18); F.out = (float*)inp_ptr(F.misc, 19); asm volatile("" : "+v"(F.tid), "+v"(F.lane)); F.wave = __builtin_amdgcn_readfirstlane(F.tid >> 6); \
    { int bx_ = F.bx, g_ = F.G; asm volatile("" : "+v"(bx_), "+v"(g_)); F.bx = __builtin_amdgcn_readfirstlane(bx_); F.G = __builtin_amdgcn_readfirstlane(g_); } } while (0)
#define SEAM(k) do { if (args.use_bar && (k) + 1 < hi) { XcdBarrier b_; b_.bar = (unsigned*)((unsigned char*)inp_ptr(F.misc, 18) + WS_CTL) + CW_BAR; b_.st = (volatile LAS unsigned*)(F.misc + MISC_BARW); \
        b_.x = (unsigned)__builtin_amdgcn_readfirstlane((int)((volatile LAS unsigned*)(F.misc + MISC_BARW))[2]); xcd_barrier(b_); if (PROBE_BAR2) xcd_barrier(b_); } else { VM_WAIT(); __syncthreads(); } } while (0)

#define HB ((bf16*)(F.ws + WS_HB))
#define QKV ((bf16*)(F.ws + WS_BIG))
    LAS int* texp_l = (LAS int*)(F.misc + MISC_TEXP);

    if (IN(0)) { LAUNDER(); for (int rep = 0; rep < PROBE_CONV_REPS; ++rep) phase_convert(F);
        if (!(args.use_bar && hi > 2)) SEAM(0); }


    for (int L = 0; L < DEPTH; ++L) {
        const int base = 1 + L * PH_PER_LAYER;
        if (hi <= base || lo >= base + PH_PER_LAYER) continue;
        const bool moe = (L & 1) != 0; const int fi = L >> 1;
        const bool f8 = moe || DENSE_UP8(L), f8d = moe || DENSE_DN8(L);
#define wc (F.ws + WS_WC + (size_t)L * WC_STRIDE)
        const int comb = (L > 0 && ((L - 1) & 1)) ? 1 : 0;
        if (IN(base + 0) && (L == 0 || comb)) {
            LAUNDER();
            RowPass P{}; P.xsrc = (L == 0) ? INP(0) : (const float*)nullptr; P.xbf = (const bf16*)F.out; P.combine = comb; P.xdst = (bf16*)F.out; P.gain = INP(2) + (size_t)L * D;
            P.ob = nullptr; P.obp = XP; P.ssq = (float*)(F.ws + WS_SSQ); P.ob8 = nullptr; P.of = nullptr; P.router = 0; P.wr = nullptr;
            phase_rows(F, P);
            if (L == 0) phase_memnorm(F);
            SEAM(base + 0);
        }
        if (IN(base + 1)) {
            LAUNDER();
#if QKV_FP8
            { pg8::Gemm g{HB, (const bf16*)(wc + WC_IN), M, NQKV, D / 2, 0}; pg8::TileOrder S; S.init(M, NQKV, F.G, F.bx, nullptr);
              pg8::EpiQKVT<true> E{QKV, (const float*)(F.ws + WS_COS), (const float*)(F.ws + WS_SIN), ACC8_SCALE};
              GEMM_SITE1(pg8::gemm_phase(F.lds, g, S, E, F.tid)); }
#else
            { pg8::Gemm g{(const bf16*)F.out, (const bf16*)(wc + WC_IN), M, NQKV, D, 0}; pg8::TileOrder S; S.init(M, NQKV, F.G, F.bx, nullptr);
              pg8::EpiQKVT<false> E{QKV, (const float*)(F.ws + WS_COS), (const float*)(F.ws + WS_SIN), 1.0f, (const float*)(F.ws + WS_SSQ), 1};
              GEMM_SITE1(pg8::gemm_phase(F.lds, g, S, E, F.tid)); }
#endif
            if (L == 0) {
                LAUNDER();
                __syncthreads();
                for (int i = F.tid; i < MAXTILES + 8; i += 512) texp_l[i] = i >> 3;
                __syncthreads();
                pg8::Gemm g{(const bf16*)(F.ws + WS_MEMN4), (const bf16*)(F.ws + WS_WC + WC_MKV), DEPTH * MROWS, 512, D, WC_STRIDE}; pg8::TileOrder S; S.init(DEPTH * MROWS, 512, F.G, F.bx, texp_l);
                pg8::EpiPlain E{(bf16*)(F.ws + WS_MEMKV4), 512};
                GEMM_SITE2(pg8::gemm_phase(F.lds, g, S, E, F.tid));
            }
            SEAM(base + 1);
        }
        if (IN(base + 2)) {
            LAUNDER();
#ifndef NO_ATT
            for (int rep = 0; rep < PROBE_ATT_REPS; ++rep)
            for (int v = F.bx; v < M / 256; v += F.G) { const int u = (F.G == 256) ? ((v & 7) * 32 + (v >> 3)) : v;
                att::attn_unit(F, u >> 5, (u & 31) * 256, L); }
#endif
            SEAM(base + 2);
        }
        if (IN(base + 3)) {
            LAUNDER();
            pg8::Gemm g{HB, (const bf16*)(wc + WC_OUT), M, D, D, 0}; pg8::TileOrder S; S.init(M, D, F.G, F.bx, nullptr);
            pg8::EpiResT<false> E{(const float*)nullptr, (bf16*)F.out, nullptr, D, 0, 1.0f};
            GEMM_SITE3(pg8::gemm_phase(F.lds, g, S, E, F.tid));
            SEAM(base + 3);
        }
        if (IN(base + 4)) {
            LAUNDER();
            RowPass P{}; P.xsrc = nullptr; P.xbf = (const bf16*)F.out; P.xdst = nullptr; P.combine = 0; P.gain = INP(9) + (size_t)L * D; P.ob = f8 ? nullptr : HB; P.obp = D; P.ssq = nullptr; P.ob8 = f8 ? (unsigned char*)(F.ws + WS_HB) : nullptr; P.of = nullptr; P.router = moe ? 1 : 0; P.wr = INP(13) + (size_t)fi * D * NE;
            phase_rows(F, P);
            if (PROBE_PE2) { __syncthreads(); phase_rows(F, P); }
            SEAM(base + 4);
        }
        if (moe && IN(base + 5)) { LAUNDER(); phase_moe_assign(F); SEAM(base + 5); }
        int nT = M / 256;
        if (moe && hi > base + 6 && lo < base + 16) nT = __builtin_amdgcn_readfirstlane(((const int*)(F.ws + WS_TEXP))[MAXTILES]);
        nT = nT < 0 ? 0 : (nT > MAXTILES ? MAXTILES : nT);
        const int ntail = (moe && nT > 2 * CHUNK_TILES) ? nT - 2 * CHUNK_TILES : 0;
        const int nsteps = !moe ? 2 : 4;
        for (int k = 0; k < nsteps; ++k) {
            const int pk = base + 6 + k;
            if (!IN(pk)) continue;
            LAUNDER();
            int dc = -1, uc = -1;
            if (!moe) { if (k == 0) uc = 0; else dc = 0; }
            else {
                if (k == 0) uc = 0; else if (k == 1) { dc = 0; uc = ntail ? 2 : -1; } else if (k == 2) { dc = ntail ? 2 : -1; uc = 1; } else dc = 1; }
            {
                __syncthreads();
                const int* tg = (const int*)(F.ws + WS_TEXP);
                for (int i = F.tid; i < MAXTILES + 8; i += 512) texp_l[i] = (moe && i < nT) ? tg[i] : 0;
                __syncthreads();
            }
#define CH_TILE0(ch) (moe ? (ch) * CHUNK_TILES : 0)
#define CH_NTILE(ch) (moe ? ((nT - CH_TILE0(ch)) < CHUNK_TILES ? (nT - CH_TILE0(ch)) : CHUNK_TILES) : M / 256)
#define CH_HID(ch) (moe ? ((ch) == 2 ? (bf16*)(F.ws + WS_MEMN4) : (bf16*)(F.ws + WS_HIDC)) : (bf16*)(F.ws + WS_BIG))
            if (dc >= 0) {
                const int tile0 = CH_TILE0(dc), ntile = CH_NTILE(dc); bf16* hid = CH_HID(dc);
                if (f8d) {
                    pg8::Gemm g{hid, moe ? (const bf16*)(F.ws + WS_WM + (size_t)fi * WM_STRIDE + WM_DOWN) : (const bf16*)(F.ws + WS_WD + (size_t)fi * WD_STRIDE + 14 * MiB), ntile * 256, D, FF / 2, WD8_ESTRIDE};
                    pg8::TileOrder S; S.init(ntile * 256, D, F.G, F.bx, texp_l + tile0);
                    pg8::EpiResT<true> E{nullptr, (bf16*)F.out, (bf16*)(F.ws + WS_GA) + (size_t)tile0 * 256 * D, D, moe ? 1 : 2, ACCD8_SCALE};
                    GEMM_SITE5(pg8::gemm_phase(F.lds, g, S, E, F.tid));
                } else {
                    pg8::Gemm g{hid, (const bf16*)(F.ws + WS_WD + (size_t)fi * WD_STRIDE + 14 * MiB), ntile * 256, D, FF, 0}; pg8::TileOrder S; S.init(ntile * 256, D, F.G, F.bx, texp_l + tile0);
                    pg8::EpiResT<false> E{nullptr, (bf16*)F.out, nullptr, D, 2, 1.0f};
                    GEMM_SITE7(pg8::gemm_phase(F.lds, g, S, E, F.tid));
                }
            }
            if (dc >= 0 && uc >= 0) { LAUNDER(); __syncthreads(); }
            if (uc >= 0) {
                const int tile0 = CH_TILE0(uc), ntile = CH_NTILE(uc); bf16* hid = CH_HID(uc);
                if (f8) {
                    pg8::Gemm g{moe ? (const bf16*)(F.ws + WS_GA8 + (size_t)tile0 * 256 * D) : (const bf16*)(F.ws + WS_HB),
                                moe ? (const bf16*)(F.ws + WS_WM + (size_t)fi * WM_STRIDE) : (const bf16*)(F.ws + WS_WD + (size_t)fi * WD_STRIDE), ntile * 256, 2 * FF, D / 2, (size_t)7 * MiB};
                    pg8::TileOrderSkew S; S.init(ntile * 256, 2 * FF, F.G, F.bx, texp_l + tile0);
                    const bool sk = moe && (dc == 2) && (ntile == F.G);
                    S.nsk = sk ? 4 * CH_NTILE(dc) : 0; S.kd = 3; S.per = 28;
                    pg8::EpiSwigluT<true> E{hid, ACC8_SCALE, f8d ? 0 : 1};
                    GEMM_SITE4(pg8::gemm_phase(F.lds, g, S, E, F.tid));
                } else {
                    pg8::Gemm g{HB, (const bf16*)(F.ws + WS_WD + (size_t)fi * WD_STRIDE), ntile * 256, 2 * FF, D, 0}; pg8::TileOrder S; S.init(ntile * 256, 2 * FF, F.G, F.bx, texp_l + tile0);
                    pg8::EpiSwigluT<false> E{hid, 1.0f, 1};
                    GEMM_SITE6(pg8::gemm_phase(F.lds, g, S, E, F.tid));
                }
            }
            SEAM(pk);
        }
    }
    if (IN(SEQ_FINAL)) {
        LAUNDER();
        RowPass P{}; P.xsrc = nullptr; P.xbf = (const bf16*)F.out; P.xdst = nullptr; P.combine = 1; P.gain = INP(17); P.ob = nullptr; P.obp = D; P.ssq = nullptr; P.of = F.out; P.router = 0; P.wr = nullptr;
        phase_rows(F, P);
    }
#undef IN
#undef SEAM
}

extern "C" void kernel_launch(void* const* d_in, const int* in_sizes, int n_in, void* d_out, int out_size, void* d_ws, size_t ws_size, hipStream_t stream) {
    static int grid = 0;
    if (grid == 0) {
        if (n_in != 18 || out_size != M * D || ws_size < WS_END) { fprintf(stderr, "kernel_launch: unexpected problem (n_in %d out %d ws %zu)\n", n_in, out_size, ws_size); grid = -1; return; }
        int dev = 0, cus = 0, per_cu = 0;
        if (hipGetDevice(&dev) != hipSuccess || hipDeviceGetAttribute(&cus, hipDeviceAttributeMultiprocessorCount, dev) != hipSuccess) { grid = -1; return; }
        if (hipFuncSetAttribute((const void*)fwd_kernel, hipFuncAttributeMaxDynamicSharedMemorySize, LDS_BYTES) != hipSuccess) { fprintf(stderr, "kernel_launch: hipFuncSetAttribute failed\n"); grid = -1; return; }
        if (hipOccupancyMaxActiveBlocksPerMultiprocessor(&per_cu, (const void*)fwd_kernel, NWAVES * 64, LDS_BYTES) != hipSuccess || per_cu < 1) fprintf(stderr, "kernel_launch: occupancy query says %d\n", per_cu);
        (void)hipGetLastError();
        grid = cus;
    }
    if (grid < 0) return;
    (void)hipMemsetAsync((char*)d_ws + WS_CTL, 0, CTL_ZERO_BYTES, stream);
    Args a{};
    for (int i = 0; i < 18; ++i) a.in[i] = (const float*)d_in[i];
    a.out = (float*)d_out; a.ws = (unsigned char*)d_ws; a.pad = 0;
#if MK_ONE_LAUNCH
    a.ph_lo = 0; a.ph_hi = SEQ_END; a.use_bar = 1;
    hipLaunchKernelGGL(fwd_kernel, dim3(grid), dim3(NWAVES * 64), LDS_BYTES, stream, a);
#else
    a.use_bar = 0;
#ifndef MAXSEQ
#define MAXSEQ 1000
#ifndef PROBE_ATT_REPS
#define PROBE_ATT_REPS 1
#endif
#ifndef PROBE_QKV_REPS
#define PROBE_QKV_REPS 1
#endif
#ifndef PROBE_CONV_REPS
#define PROBE_CONV_REPS 1
#endif
#endif
    auto run = [&](int k) { if (k >= MAXSEQ) return; a.ph_lo = k; a.ph_hi = k + 1; hipLaunchKernelGGL(fwd_kernel, dim3(grid), dim3(NWAVES * 64), LDS_BYTES, stream, a); };
    run(0);
    for (int L = 0; L < DEPTH; ++L) {
        const int base = 1 + L * PH_PER_LAYER; const bool moe = (L & 1) != 0;
        for (int k = 0; k < 5; ++k) run(base + k);
        if (moe) { run(base + 5); for (int c = 0; c < NCHUNK; ++c) { run(base + 6 + 2 * c); run(base + 7 + 2 * c); } }
        else { run(base + 6); run(base + 7); }
    }
    run(SEQ_FINAL);
#endif
}
```

```cpp
#include <hip/hip_runtime.h>
#include <cstdio>
#include <cstdint>

#ifndef MK_ONE_LAUNCH
#define MK_ONE_LAUNCH 1
#endif
#define MAXSEQ 1000
#ifndef PROBE_ATT_REPS
#define PROBE_ATT_REPS 1
#endif
#ifndef PROBE_QKV_REPS
#define PROBE_QKV_REPS 1
#endif
#ifndef DENSE_UP8_MASK
#define DENSE_UP8_MASK 5
#endif
#ifndef DENSE_DN8_MASK
#define DENSE_DN8_MASK 5
#endif
#define DENSE_UP8(L) (((DENSE_UP8_MASK) >> (L)) & 1)
#define DENSE_DN8(L) (((DENSE_DN8_MASK) >> (L)) & 1)
#ifndef QKV_FP8
#define QKV_FP8 0
#endif
#ifndef PROBE_BAR2
#define PROBE_BAR2 0
#endif
#ifndef PROBE_PE2
#define PROBE_PE2 0
#endif
#ifndef PROBE_SAMPLE
#define PROBE_SAMPLE 0
#endif
#ifndef PROBE_CONV_REPS
#define PROBE_CONV_REPS 1
#endif

#define GAS __attribute__((address_space(1)))
#define LAS __attribute__((address_space(3)))
typedef unsigned short bf16;
typedef short bf16x8 __attribute__((ext_vector_type(8)));
typedef float f32x4 __attribute__((ext_vector_type(4)));
typedef float f32x2 __attribute__((ext_vector_type(2)));
typedef unsigned u32x4 __attribute__((ext_vector_type(4)));
typedef unsigned u32x2 __attribute__((ext_vector_type(2)));
typedef short v4i16_t __attribute__((ext_vector_type(4)));

constexpr int BATCH = 8, T = 8192, D = 1024, M = BATCH * T, DEPTH = 4;
constexpr int NQKV = 2560, FF = 3584, NE = 8, NMEM = 256, MROWS = BATCH * NMEM;
constexpr int OFF_QA = 0, OFF_KA = 384, OFF_VA = 768, OFF_QB = 1152, OFF_KB = 1536, OFF_VB = 1920, OFF_QM = 2304;
constexpr float RMS_EPS = 1e-6f;
constexpr float LOG2E = 1.4426950408889634f;
constexpr float QSCALE = 0.125f * LOG2E;
constexpr int XP = 2 * D;
constexpr int NWAVES = 8;
constexpr int MAXTILES = 520;
constexpr int CHUNK_TILES = 256;
constexpr int NCHUNK = 5;

constexpr size_t MiB = 1u << 20;
constexpr size_t WS_CTL = 0, CTL_ZERO_BYTES = 1 * MiB;
constexpr size_t WS_COS = 2 * MiB, WS_SIN = 2 * MiB + 256 * 1024;
constexpr size_t WS_E01 = 4 * MiB;
constexpr size_t WS_GATE = 4 * MiB + 256 * 1024;
constexpr size_t WS_POS = 5 * MiB;
constexpr size_t WS_TCNT = 6 * MiB;
constexpr size_t WS_TEXP = 6 * MiB + 64 * 1024;
constexpr size_t WS_SSQ = 8 * MiB;
constexpr size_t WS_WC = 16 * MiB, WC_STRIDE = 8 * MiB;
constexpr size_t WC_IN = 0, WC_MKV = 5 * MiB, WC_OUT = 6 * MiB;
constexpr size_t WS_WD = 48 * MiB, WD_STRIDE = 21 * MiB;
constexpr size_t WS_WM = 90 * MiB, WM_STRIDE = 112 * MiB;
constexpr size_t WM_DOWN = 56 * MiB;
constexpr size_t WS_HB = 314 * MiB;
constexpr size_t WS_BIG = 442 * MiB;
constexpr size_t WS_GA = WS_BIG, WS_HIDC = WS_BIG + 260 * MiB;
constexpr size_t WS_GA8 = 926 * MiB;
constexpr size_t WS_MEMN4 = 1056 * MiB;
constexpr size_t WS_MEMKV4 = 1072 * MiB;
constexpr size_t WS_END = 1080 * MiB;
static_assert(WS_HIDC + (size_t)CHUNK_TILES * 256 * FF <= WS_GA8 && WS_BIG + (size_t)M * FF * 2 <= WS_GA8 && WS_GA8 + (size_t)MAXTILES * 256 * D <= WS_END, "ws map");
constexpr float A8_SCALE = 32.0f, W8_SCALE = 1024.0f, ACC8_SCALE = 1.0f / 32768.0f;
constexpr float H8_SCALE = 16.0f, WD8_SCALE = 4096.0f, ACCD8_SCALE = 1.0f / 65536.0f;
constexpr size_t WD8_ESTRIDE = (size_t)D * FF;

constexpr int CW_TMO = 0, CW_CODE = 1, CW_BAR = 4096;

constexpr int RING_BYTES = 131072;
constexpr int MISC_OFF = 139264;
constexpr int LDS_BYTES = 155648;
constexpr int MISC_BARW = 0;
constexpr int MISC_TEXP = 64;
constexpr int MISC_PTAB = 2560;
constexpr int MISC_SCR = 4096;

__device__ __forceinline__ float vmax2(float a, float b) { return __builtin_amdgcn_fmed3f(a, b, INFINITY); }
__device__ __forceinline__ float vmax3(float a, float b, float c) { return vmax2(vmax2(a, b), c); }
__device__ __forceinline__ float clamp8(float x) { return __builtin_amdgcn_fmed3f(x, -448.0f, 448.0f); }
__device__ __forceinline__ unsigned cvt4_fp8(float a, float b, float c, float d) {
    unsigned w = 0; w = __builtin_amdgcn_cvt_pk_fp8_f32(clamp8(a), clamp8(b), w, false); w = __builtin_amdgcn_cvt_pk_fp8_f32(clamp8(c), clamp8(d), w, true); return w; }
namespace pg8 {
#define PG8_LAS __attribute__((address_space(3)))
typedef unsigned short bf16_t;
constexpr int BM = 256, BK = 64, HALF = 128, HTB = HALF * BK * 2, STAGE_BYTES = 8 * HTB, NXCD = 8, WGM = 8;

__host__ __device__ __forceinline__ int lds_byte(int r, int c) { const int st = (r >> 4) * 2 + (c >> 5), rr = r & 15, cc = c & 31, ob = rr * 64 + cc * 2; return st * 1024 + (ob ^ (((ob >> 9) & 1) << 5)); }
__host__ __device__ __forceinline__ void stage_rc(int b, int& R, int& C) { const int st = b / 1024, sb = b % 1024, swz = sb ^ (((sb >> 9) & 1) << 5); R = (st >> 1) * 16 + swz / 64; C = (st & 1) * 32 + (swz % 64) / 2; }
__host__ __device__ __forceinline__ int perm32(int rho) { const int n = rho >> 4, i = rho & 15; return 8 * (i >> 2) + 4 * n + (i & 3); }

struct Unit { int pm, pn, e; };
struct Gemm { const bf16_t* A; const bf16_t* Bt; int M, N, K; size_t estride; };

struct TileOrder {
    int nM, nN, nwg, G, c; const PG8_LAS int* texp;
    __device__ void init(int Mr, int N, int G_, int c_, const PG8_LAS int* texp_) { nM = Mr / BM; nN = N / BM; nwg = nM * nN; G = G_; c = c_; texp = texp_; }
    __device__ bool next(int i, Unit& u) const {
        const long L = (long)i * G + c; if (L >= nwg) return false;
        int wgid = (int)L; { const int q = nwg / NXCD, r = nwg % NXCD, xcd = wgid % NXCD, off = wgid / NXCD; wgid = (xcd < r ? xcd * (q + 1) : r * (q + 1) + (xcd - r) * q) + off; }
        const int nig = WGM * nN, gid = wgid / nig, fm = gid * WGM, gsz = (nM - fm) < WGM ? (nM - fm) : WGM;
        u.pm = fm + ((wgid % nig) % gsz); u.pn = (wgid % nig) / gsz; u.e = texp ? __builtin_amdgcn_readfirstlane(texp[u.pm]) : 0; return true;
    }
};

struct TileOrderSkew : TileOrder {
    int nsk, kd, per;
    __device__ bool next(int i, Unit& u) const {
        int cc = c, ii = i;
        if (nsk > 0) {
            if (c < nsk) { if (i >= per - kd) return false; }
            else if (i == per) { const int S = (nsk + 7) & ~7, j = c / S - 1, c2 = c % S; if (c < S || j >= kd || c2 >= nsk) return false; cc = c2; ii = per - kd + j; }
            else if (i > per) return false;
        }
        const long L = (long)ii * G + cc; if (L >= nwg) return false;
        int wgid = (int)L; { const int q = nwg / NXCD, r = nwg % NXCD, xcd = wgid % NXCD, off = wgid / NXCD; wgid = (xcd < r ? xcd * (q + 1) : r * (q + 1) + (xcd - r) * q) + off; }
        const int nig = WGM * nN, gid = wgid / nig, fm = gid * WGM, gsz = (nM - fm) < WGM ? (nM - fm) : WGM;
        u.pm = fm + ((wgid % nig) % gsz); u.pn = (wgid % nig) / gsz; u.e = texp ? __builtin_amdgcn_readfirstlane(texp[u.pm]) : 0; return true;
    }
};

typedef int i32x8 __attribute__((ext_vector_type(8)));
typedef int i32x4 __attribute__((ext_vector_type(4)));
__device__ __forceinline__ i32x8 cat8(bf16x8 a, bf16x8 b) { const i32x4 x = __builtin_bit_cast(i32x4, a), y = __builtin_bit_cast(i32x4, b); return __builtin_shufflevector(x, y, 0, 1, 2, 3, 4, 5, 6, 7); }
__device__ __forceinline__ void mfma8(f32x4& acc, const i32x8 a, const i32x8 b) { int sc = 0x7f7f7f7f;
    asm volatile("v_mfma_scale_f32_16x16x128_f8f6f4 %0, %1, %2, %0, %3, %3 op_sel_hi:[0,0,0]" : "+v"(acc) : "v"(a), "v"(b), "v"(sc)); }
__device__ __forceinline__ unsigned cvt_pk_bf16(float lo, float hi) { unsigned r; asm volatile("v_cvt_pk_bf16_f32 %0, %1, %2" : "=v"(r) : "v"(lo), "v"(hi)); return r; }


struct EpiPlain {
    static constexpr bool PERM = true, FP8 = false; static constexpr int LDA = 0;
    bf16_t* O; int ldc;
    __device__ __forceinline__ void operator()(const f32x4 (&acc)[2][2][4][2], const Unit& u, int wr, int wc, int fr, int fq) const {
        const int row0 = u.pm * BM + wr * 64 + fr, col0 = u.pn * BM + wc * 32 + 8 * fq;
#pragma unroll
        for (int ai = 0; ai < 2; ++ai)
#pragma unroll
            for (int m = 0; m < 4; ++m) { bf16_t* rowp = O + (size_t)(row0 + ai * HALF + m * 16) * ldc + col0;
#pragma unroll
                for (int bj = 0; bj < 2; ++bj) { const f32x4 v0 = acc[ai][bj][m][0], v1 = acc[ai][bj][m][1];
                    u32x4 w; w.x = cvt_pk_bf16(v0[0], v0[1]); w.y = cvt_pk_bf16(v0[2], v0[3]); w.z = cvt_pk_bf16(v1[0], v1[1]); w.w = cvt_pk_bf16(v1[2], v1[3]);
                    *(u32x4*)(rowp + bj * HALF) = w; } }
    }
};
template <bool F8> struct EpiQKVT {
    static constexpr bool PERM = true, FP8 = F8; static constexpr int LDA = F8 ? 0 : XP;
    bf16_t* O; const float* cosT; const float* sinT; float insc;
    const float* ssq; int npart;
    __device__ __forceinline__ void operator()(const f32x4 (&acc)[2][2][4][2], const Unit& u, int wr, int wc, int fr, int fq) const {
        const int row0 = u.pm * BM + wr * 64 + fr, col0 = u.pn * BM + wc * 32 + 8 * fq;
        const bool lane_rot = ((wc & 1) == 0) && (fq < 2);
        float rsv[2][4];
        if (npart) {
            f32x4 pp[2][4];
#pragma unroll
            for (int ai = 0; ai < 2; ++ai)
#pragma unroll
                for (int m = 0; m < 4; ++m) pp[ai][m] = *(const f32x4*)(ssq + (size_t)(row0 + ai * HALF + m * 16) * 16 + 4 * fq);
#pragma unroll
            for (int ai = 0; ai < 2; ++ai)
#pragma unroll
                for (int m = 0; m < 4; ++m) { float sq = (pp[ai][m][0] + pp[ai][m][1]) + (pp[ai][m][2] + pp[ai][m][3]); sq += __shfl_xor(sq, 16); sq += __shfl_xor(sq, 32);
                    rsv[ai][m] = insc * __builtin_amdgcn_rsqf(sq * (1.0f / D) + RMS_EPS); }
        } else {
#pragma unroll
            for (int ai = 0; ai < 2; ++ai)
#pragma unroll
                for (int m = 0; m < 4; ++m) rsv[ai][m] = insc;
        }
        const bool anyrot = (u.pn >= 4) && (u.pn <= 7);
#pragma unroll
        for (int ai = 0; ai < 2; ++ai) {
            f32x4 rc[4], rn[4];
#pragma unroll
            for (int m = 0; m < 4; ++m) { rc[m] = (f32x4){0.f, 0.f, 0.f, 0.f}; rn[m] = rc[m]; }
            if (anyrot) {
#pragma unroll
                for (int m = 0; m < 4; ++m) { const int t = (row0 + ai * HALF + m * 16) & (T - 1); rc[m] = *(const f32x4*)(cosT + t * 8 + 4 * (fq & 1)); rn[m] = *(const f32x4*)(sinT + t * 8 + 4 * (fq & 1)); }
            }
#pragma unroll
            for (int m = 0; m < 4; ++m) {
                const int row = row0 + ai * HALF + m * 16;
                const float rs = rsv[ai][m];
#pragma unroll
                for (int bj = 0; bj < 2; ++bj) {
                    const int idx = 2 * u.pn + bj;
                    const float sc = ((idx < 3 || (idx >= 9 && idx < 12) || idx >= 18) ? QSCALE : 1.0f) * rs;
                    const bool rot = (idx >= 9 && idx < 15) && lane_rot;
                    f32x4 v0 = acc[ai][bj][m][0] * sc, v1 = acc[ai][bj][m][1] * sc;
                    if (rot) {
                        const f32x4 c = rc[m], s = rn[m];
                        f32x4 a, b;
                        a[0] = v0[0] * c[0] - v0[1] * s[0]; a[1] = v0[1] * c[0] + v0[0] * s[0];
                        a[2] = v0[2] * c[1] - v0[3] * s[1]; a[3] = v0[3] * c[1] + v0[2] * s[1];
                        b[0] = v1[0] * c[2] - v1[1] * s[2]; b[1] = v1[1] * c[2] + v1[0] * s[2];
                        b[2] = v1[2] * c[3] - v1[3] * s[3]; b[3] = v1[3] * c[3] + v1[2] * s[3];
                        v0 = a; v1 = b;
                    }
                    u32x4 w; w.x = cvt_pk_bf16(v0[0], v0[1]); w.y = cvt_pk_bf16(v0[2], v0[3]); w.z = cvt_pk_bf16(v1[0], v1[1]); w.w = cvt_pk_bf16(v1[2], v1[3]);
                    *(u32x4*)(O + (size_t)row * NQKV + col0 + bj * HALF) = w;
                }
            }
        }
    }
};
template <bool F8> struct EpiSwigluT {
    static constexpr bool PERM = true, FP8 = F8; static constexpr int LDA = 0;
    bf16_t* O; float insc; int out_bf16;
    __device__ __forceinline__ void operator()(const f32x4 (&acc)[2][2][4][2], const Unit& u, int wr, int wc, int fr, int fq) const {
        const int row0 = u.pm * BM + wr * 64 + fr, col0 = u.pn * HALF + wc * 32 + 8 * fq;
#pragma unroll
        for (int ai = 0; ai < 2; ++ai)
#pragma unroll
            for (int m = 0; m < 4; ++m) {
                float h[8];
#pragma unroll
                for (int n = 0; n < 2; ++n)
#pragma unroll
                    for (int j = 0; j < 4; ++j) { const float g = acc[ai][0][m][n][j] * insc, up = acc[ai][1][m][n][j] * insc;
                        const float sg = g * __builtin_amdgcn_rcpf(1.0f + __builtin_amdgcn_exp2f(-g * LOG2E)); h[4 * n + j] = sg * up; }
                if (F8 && !out_bf16) {
                    u32x2 w; w.x = cvt4_fp8(h[0] * H8_SCALE, h[1] * H8_SCALE, h[2] * H8_SCALE, h[3] * H8_SCALE); w.y = cvt4_fp8(h[4] * H8_SCALE, h[5] * H8_SCALE, h[6] * H8_SCALE, h[7] * H8_SCALE);
                    *(u32x2*)((unsigned char*)O + (size_t)(row0 + ai * HALF + m * 16) * FF + col0) = w;
                } else {
                    u32x4 w; w.x = cvt_pk_bf16(h[0], h[1]); w.y = cvt_pk_bf16(h[2], h[3]); w.z = cvt_pk_bf16(h[4], h[5]); w.w = cvt_pk_bf16(h[6], h[7]);
                    *(u32x4*)(O + (size_t)(row0 + ai * HALF + m * 16) * FF + col0) = w;
                }
            }
    }
};
template <bool F8> struct EpiResT {
    static constexpr bool PERM = true, FP8 = F8; static constexpr int LDA = 0;
    const float* src; bf16_t* xbf; bf16_t* ob; int ldc; int as_bf16; float insc;
    __device__ __forceinline__ void operator()(const f32x4 (&acc)[2][2][4][2], const Unit& u, int wr, int wc, int fr, int fq) const {
        const int row0 = u.pm * BM + wr * 64 + fr, col0 = u.pn * BM + wc * 32 + 8 * fq;
        float* ssqp = nullptr;
        if (as_bf16 == 2) {
            extern __shared__ __attribute__((aligned(16))) unsigned char lds_epi[];
            const unsigned long long v = ((const PG8_LAS unsigned long long*)((PG8_LAS unsigned char*)lds_epi + MISC_OFF + MISC_PTAB))[18];
            const unsigned lo = __builtin_amdgcn_readfirstlane((unsigned)v), hi = __builtin_amdgcn_readfirstlane((unsigned)(v >> 32));
            ssqp = (float*)((unsigned char*)(((unsigned long long)hi << 32) | lo) + WS_SSQ); }
        if (as_bf16 == 1) {
#pragma unroll
            for (int ai = 0; ai < 2; ++ai)
#pragma unroll
                for (int m = 0; m < 4; ++m) { bf16_t* rowp = ob + (size_t)(row0 + ai * HALF + m * 16) * ldc + col0;
#pragma unroll
                    for (int bj = 0; bj < 2; ++bj) { const f32x4 v0 = acc[ai][bj][m][0] * insc, v1 = acc[ai][bj][m][1] * insc;
                        u32x4 w; w.x = cvt_pk_bf16(v0[0], v0[1]); w.y = cvt_pk_bf16(v0[2], v0[3]); w.z = cvt_pk_bf16(v1[0], v1[1]); w.w = cvt_pk_bf16(v1[2], v1[3]); *(u32x4*)(rowp + bj * HALF) = w; } }
        } else {
#pragma unroll
            for (int ai = 0; ai < 2; ++ai) {
                u32x4 rw[4][2];
#pragma unroll
                for (int m = 0; m < 4; ++m)
#pragma unroll
                    for (int bj = 0; bj < 2; ++bj) rw[m][bj] = *(const u32x4*)(xbf + (size_t)(row0 + ai * HALF + m * 16) * XP + col0 + bj * HALF);
#pragma unroll
                for (int m = 0; m < 4; ++m) { const size_t xoff = (size_t)(row0 + ai * HALF + m * 16) * XP + col0; float ss = 0.f;
#pragma unroll
                    for (int bj = 0; bj < 2; ++bj) { const u32x4 r = rw[m][bj];
                        const f32x4 b0 = (f32x4){__builtin_bit_cast(float, r.x << 16), __builtin_bit_cast(float, r.x & 0xffff0000u), __builtin_bit_cast(float, r.y << 16), __builtin_bit_cast(float, r.y & 0xffff0000u)};
                        const f32x4 b1 = (f32x4){__builtin_bit_cast(float, r.z << 16), __builtin_bit_cast(float, r.z & 0xffff0000u), __builtin_bit_cast(float, r.w << 16), __builtin_bit_cast(float, r.w & 0xffff0000u)};
                        const f32x4 x0 = b0 + acc[ai][bj][m][0] * insc, x1 = b1 + acc[ai][bj][m][1] * insc;
                        ss += ((x0[0] * x0[0] + x0[1] * x0[1]) + (x0[2] * x0[2] + x0[3] * x0[3])) + ((x1[0] * x1[0] + x1[1] * x1[1]) + (x1[2] * x1[2] + x1[3] * x1[3]));
                        u32x4 w; w.x = cvt_pk_bf16(x0[0], x0[1]); w.y = cvt_pk_bf16(x0[2], x0[3]); w.z = cvt_pk_bf16(x1[0], x1[1]); w.w = cvt_pk_bf16(x1[2], x1[3]);
                        *(u32x4*)(xbf + xoff + bj * HALF) = w; }
                    if (ssqp) { ss += __shfl_xor(ss, 16); ss += __shfl_xor(ss, 32); if (fq == 0) ssqp[(size_t)(row0 + ai * HALF + m * 16) * 16 + 4 * u.pn + wc] = ss; } }
                asm volatile("" ::: "memory");
            }
        }
    }
};

template <class Epi, class Sched>
__device__ __forceinline__ void gemm_phase(PG8_LAS unsigned char* lds, const Gemm g, const Sched& S, const Epi& E, const int tid) {
    const int wid = __builtin_amdgcn_readfirstlane(tid >> 6), lane = tid & 63, wr = wid >> 2, wc = wid & 3, fr = lane & 15, fq = lane >> 4;
    const int K = g.K, nt = K / BK;
    const int LDA_ = Epi::LDA ? Epi::LDA : K;
    unsigned voffA[2], voffB[2];
#pragma unroll
    for (int i = 0; i < 2; ++i) { int R, C; stage_rc(tid * 16 + i * 8192, R, C); const int Rb = Epi::PERM ? ((R & ~31) + perm32(R & 31)) : R;
        voffA[i] = (unsigned)(R * LDA_ + C) * 2u; voffB[i] = (unsigned)(Rb * K + C) * 2u; }
    const size_t kstep = (size_t)(BK * 2);
    const size_t hstep = (size_t)HALF * K * 2;
    const size_t tstep = 2 * hstep;
    const size_t hstepA = (size_t)HALF * LDA_ * 2, tstepA = 2 * hstepA;
    const unsigned ldsw = (unsigned)wid * 1024u;
    const int aoff = lds_byte(wr * 64 + fr, fq * 8), boff = lds_byte(wc * 32 + fr, fq * 8);
#define PG8_SA(b, h) (((b) * 2 + (h)) * HTB)
#define PG8_SB(b, h) ((4 + (b) * 2 + (h)) * HTB)
#define PG8_STAGE(bufoff, gbase, voff) do { _Pragma("unroll") for (int _i = 0; _i < 2; ++_i) \
        __builtin_amdgcn_global_load_lds((const unsigned*)((const char*)(gbase) + (voff)[_i]), (PG8_LAS unsigned*)(lds + (bufoff) + ldsw + _i * 8192), 16, 0, 0); } while (0)
#define PG8_LDA(dst, b, h) do { _Pragma("unroll") for (int m = 0; m < 4; ++m) _Pragma("unroll") for (int k = 0; k < 2; ++k) dst[m][k] = *(const PG8_LAS bf16x8*)(lds + PG8_SA(b, h) + aoff + m * 2048 + k * 1024); } while (0)
#define PG8_LDB(dst, b, h) do { _Pragma("unroll") for (int n = 0; n < 2; ++n) _Pragma("unroll") for (int k = 0; k < 2; ++k) dst[n][k] = *(const PG8_LAS bf16x8*)(lds + PG8_SB(b, h) + boff + n * 2048 + k * 1024); } while (0)
#define PG8_MMA(ai, bj, At, Bt) do { __builtin_amdgcn_s_setprio(1); \
        if constexpr (Epi::FP8) { _Pragma("unroll") for (int m = 0; m < 4; ++m) _Pragma("unroll") for (int n = 0; n < 2; ++n) \
            mfma8(acc[ai][bj][m][n], cat8(Bt[n][0], Bt[n][1]), cat8(At[m][0], At[m][1])); } \
        else { _Pragma("unroll") for (int m = 0; m < 4; ++m) _Pragma("unroll") for (int n = 0; n < 2; ++n) _Pragma("unroll") for (int k = 0; k < 2; ++k) \
            acc[ai][bj][m][n] = __builtin_amdgcn_mfma_f32_16x16x32_bf16(Bt[n][k], At[m][k], acc[ai][bj][m][n], 0, 0, 0); } \
        __builtin_amdgcn_s_setprio(0); } while (0)
#define PG8_WAIT_V(n) asm volatile("s_waitcnt vmcnt(" #n ")" ::: "memory")
#define PG8_WAIT_L(n) asm volatile("s_waitcnt lgkmcnt(" #n ")" ::: "memory")
#define PG8_BAR __builtin_amdgcn_s_barrier()
#define PG8_SCHED __builtin_amdgcn_sched_barrier(0)
    Unit cur, nxt; int ui = 0;
    if (!S.next(0, cur)) return;
    f32x4 acc[2][2][4][2];
#pragma unroll
    for (int a = 0; a < 2; ++a)
#pragma unroll
        for (int b = 0; b < 2; ++b)
#pragma unroll
            for (int m = 0; m < 4; ++m)
#pragma unroll
                for (int n = 0; n < 2; ++n) acc[a][b][m][n] = (f32x4){0.f, 0.f, 0.f, 0.f};
    bf16x8 At[4][2], B0[2][2], B1[2][2];
    const char* cA = (const char*)g.A + (size_t)cur.pm * tstepA; const char* cB = (const char*)g.Bt + (size_t)cur.e * g.estride + (size_t)cur.pn * tstep;
    PG8_STAGE(PG8_SB(0, 0), cB, voffB); PG8_STAGE(PG8_SB(0, 1), cB + hstep, voffB); PG8_STAGE(PG8_SA(0, 0), cA, voffA); PG8_STAGE(PG8_SA(0, 1), cA + hstepA, voffA);
    if (wr == 1) PG8_BAR;
    PG8_WAIT_V(2); PG8_BAR;
    PG8_STAGE(PG8_SB(1, 0), cB + kstep, voffB); PG8_STAGE(PG8_SA(1, 0), cA + kstep, voffA); PG8_STAGE(PG8_SB(1, 1), cB + hstep + kstep, voffB);
    PG8_WAIT_V(6); PG8_BAR;
    for (;;) {
        const bool has_next = S.next(ui + 1, nxt);
        const char* nA = has_next ? (const char*)g.A + (size_t)nxt.pm * tstepA : cA; const char* nB = has_next ? (const char*)g.Bt + (size_t)nxt.e * g.estride + (size_t)nxt.pn * tstep : cB;
        for (int t = 0; t < nt; t += 2) {
            const bool last = (t == nt - 2);
            const char* a1 = cA + (size_t)(t + 1) * kstep;
            const char* a2 = last ? nA : cA + (size_t)(t + 2) * kstep; const char* b2 = last ? nB : cB + (size_t)(t + 2) * kstep;
            const char* a3 = a2 + kstep; const char* b3 = b2 + kstep;
            PG8_LDB(B0, 0, 0); PG8_LDB(B1, 0, 1); PG8_SCHED; PG8_LDA(At, 0, 0); PG8_STAGE(PG8_SA(1, 1), a1 + hstepA, voffA);
            PG8_WAIT_V(8); PG8_WAIT_L(0); PG8_BAR; PG8_MMA(0, 0, At, B0); PG8_MMA(0, 1, At, B1); PG8_BAR; PG8_SCHED;
            PG8_LDA(At, 0, 1); PG8_STAGE(PG8_SB(0, 0), b2, voffB); PG8_STAGE(PG8_SB(0, 1), b2 + hstep, voffB); PG8_STAGE(PG8_SA(0, 0), a2, voffA);
            PG8_WAIT_V(8); PG8_WAIT_L(0); PG8_BAR; PG8_MMA(1, 0, At, B0); PG8_MMA(1, 1, At, B1); PG8_BAR; PG8_SCHED;
            PG8_LDB(B0, 1, 0); PG8_LDB(B1, 1, 1); PG8_SCHED; PG8_LDA(At, 1, 0); PG8_STAGE(PG8_SA(0, 1), a2 + hstepA, voffA);
            PG8_WAIT_V(8); PG8_WAIT_L(0); PG8_BAR; PG8_MMA(0, 0, At, B0); PG8_MMA(0, 1, At, B1); PG8_BAR; PG8_SCHED;
            PG8_LDA(At, 1, 1); PG8_STAGE(PG8_SB(1, 0), b3, voffB); PG8_STAGE(PG8_SB(1, 1), b3 + hstep, voffB); PG8_STAGE(PG8_SA(1, 0), a3, voffA);
            PG8_WAIT_V(8); PG8_WAIT_L(0); PG8_BAR; PG8_MMA(1, 0, At, B0); PG8_MMA(1, 1, At, B1); PG8_BAR; PG8_SCHED;
        }
        if (wr == 0) PG8_BAR;
        if constexpr (Epi::FP8) {
#pragma unroll
            for (int a = 0; a < 2; ++a)
#pragma unroll
                for (int b = 0; b < 2; ++b)
                    asm volatile("s_nop 15\n\ts_nop 15" : "+v"(acc[a][b][0][0]), "+v"(acc[a][b][0][1]), "+v"(acc[a][b][1][0]), "+v"(acc[a][b][1][1]), "+v"(acc[a][b][2][0]), "+v"(acc[a][b][2][1]), "+v"(acc[a][b][3][0]), "+v"(acc[a][b][3][1]));
        }
        E(acc, cur, wr, wc, fr, fq);
        if (!has_next) break;
#pragma unroll
        for (int a = 0; a < 2; ++a)
#pragma unroll
            for (int b = 0; b < 2; ++b)
#pragma unroll
                for (int m = 0; m < 4; ++m)
#pragma unroll
                    for (int n = 0; n < 2; ++n) acc[a][b][m][n] = (f32x4){0.f, 0.f, 0.f, 0.f};
        cur = nxt; cA = nA; cB = nB; ++ui;
        if (wr == 1) PG8_BAR;
    }
    PG8_WAIT_V(0);
    PG8_BAR;
#undef PG8_SA
#undef PG8_SB
#undef PG8_STAGE
#undef PG8_LDA
#undef PG8_LDB
#undef PG8_MMA
#undef PG8_WAIT_V
#undef PG8_WAIT_L
#undef PG8_BAR
#undef PG8_SCHED
}
}

typedef GAS unsigned gu32;
#define RLX_AGENT __ATOMIC_RELAXED, __HIP_MEMORY_SCOPE_AGENT
#define LDS_WAIT() asm volatile("s_waitcnt lgkmcnt(0)" ::: "memory")
#define VM_WAIT() asm volatile("s_waitcnt vmcnt(0)" ::: "memory")
__device__ __forceinline__ unsigned f2bf(float f) { unsigned u = __builtin_bit_cast(unsigned, f); return (u + 0x7fffu + ((u >> 16) & 1u)) >> 16; }
__device__ __forceinline__ unsigned pk2(float lo, float hi) { return f2bf(lo) | (f2bf(hi) << 16); }
__device__ __forceinline__ float bf_lo(unsigned w) { return __builtin_bit_cast(float, w << 16); }
__device__ __forceinline__ float bf_hi(unsigned w) { return __builtin_bit_cast(float, w & 0xffff0000u); }

#define XB_TMO      128
#define XB_XCNT(j)  (256  + 64 * (j))
#define XB_XSUB(j)  (1280 + 64 * (j))
#define XB_XGEN(j)  (2304 + 64 * (j))
#define XB_TOP      3328
#define XB_TOPGEN   3392
#define XCD_BAR_WORDS 3456
#define XB_SPIN_CAP (1u << 18)

__device__ __forceinline__ unsigned xb_ld(unsigned* p)              { return __hip_atomic_load(p, __ATOMIC_RELAXED, __HIP_MEMORY_SCOPE_AGENT); }
__device__ __forceinline__ unsigned xb_add(unsigned* p, unsigned v) { return __hip_atomic_fetch_add(p, v, __ATOMIC_RELAXED, __HIP_MEMORY_SCOPE_AGENT); }
__device__ __forceinline__ unsigned xb_xcc_id() { return (unsigned)__builtin_amdgcn_s_getreg((3 << 11) | 20) & 0xFu; }
#define XB_SPIN(cond, bar) do { unsigned _sp = 0; while (cond) { __builtin_amdgcn_s_sleep(1); \
    if ((++_sp & 255u) == 0u) { if (xb_ld(&(bar)[XB_TMO])) break; if (_sp > XB_SPIN_CAP) { atomicAdd(&(bar)[XB_TMO], 1u); break; } } } } while (0)

struct XcdBarrier { unsigned* bar; unsigned x; volatile LAS unsigned* st; };

__device__ __forceinline__ XcdBarrier xcd_barrier_post(unsigned* bar, volatile LAS unsigned* st) {
    XcdBarrier b; b.bar = bar; b.x = xb_xcc_id(); b.st = st;
    if (threadIdx.x == 0) (void)xb_add(&bar[XB_XCNT(b.x)], 1u);
    return b;
}
__device__ __forceinline__ void xcd_barrier_complete(unsigned* bar, unsigned x, unsigned& nloc, unsigned& nx) {
    const unsigned G = gridDim.x * gridDim.y * gridDim.z;
    unsigned sum, cnt, mine, sp = 0u;
    for (;;) {
        sum = 0u; cnt = 0u; mine = 0u;
#pragma unroll
        for (unsigned j = 0; j < 16; ++j) { const unsigned c = xb_ld(&bar[XB_XCNT(j)]); sum += c; cnt += (c > 0u) ? 1u : 0u; mine = (j == x) ? c : mine; }
        if (sum == G) break;
        __builtin_amdgcn_s_sleep(1);
        if ((++sp & 255u) == 0u) { if (xb_ld(&bar[XB_TMO])) break; if (sp > XB_SPIN_CAP) { atomicAdd(&bar[XB_TMO], 1u); break; } }
    }
    nloc = mine > 0u ? mine : 1u; nx = cnt > 0u ? cnt : 1u;
}
__device__ __forceinline__ void xcd_barrier(const XcdBarrier& b) {
    asm volatile("s_waitcnt vmcnt(0)" ::: "memory");
    __syncthreads();
    if (threadIdx.x == 0) {
        unsigned* bar = b.bar;
        __builtin_amdgcn_s_waitcnt(0);
        unsigned nloc = b.st[0], nx = b.st[1];
        if (nloc == 0u) { xcd_barrier_complete(bar, b.x, nloc, nx); b.st[0] = nloc; b.st[1] = nx; }
        const unsigned old = xb_add(&bar[XB_XSUB(b.x)], 1u);
        const unsigned gen = old / nloc;
        if (old + 1u == (gen + 1u) * nloc) {
            __builtin_amdgcn_fence(__ATOMIC_RELEASE, "agent");
            asm volatile("s_waitcnt vmcnt(0)" ::: "memory");
            const unsigned og = xb_add(&bar[XB_TOP], 1u);
            const unsigned tg = og / nx;
            if (og + 1u == (tg + 1u) * nx) xb_add(&bar[XB_TOPGEN], 1u);
            else XB_SPIN(xb_ld(&bar[XB_TOPGEN]) == tg, bar);
            __builtin_amdgcn_fence(__ATOMIC_ACQUIRE, "agent");
            xb_add(&bar[XB_XGEN(b.x)], 1u);
            asm volatile("s_waitcnt vmcnt(0)" ::: "memory");
        } else {
            XB_SPIN(xb_ld(&bar[XB_XGEN(b.x)]) == gen, bar);
            __builtin_amdgcn_fence(__ATOMIC_ACQUIRE, "agent");
            asm volatile("s_waitcnt vmcnt(0)" ::: "memory");
        }
    }
    __syncthreads();
}

struct Frame {
    LAS unsigned char* lds;
    LAS unsigned char* misc;
    unsigned char* ws;
    int tid, lane, wave, G, bx;
    float* out;
};
__device__ __forceinline__ const float* inp_ptr(LAS unsigned char* misc, int i) {
    const unsigned long long v = ((const LAS unsigned long long*)(misc + MISC_PTAB))[i];
    const unsigned lo = __builtin_amdgcn_readfirstlane((unsigned)v), hi = __builtin_amdgcn_readfirstlane((unsigned)(v >> 32));
    return (const float*)(GAS const float*)(((unsigned long long)hi << 32) | lo);
}
#define INP(i) inp_ptr(F.misc, (i))

__device__ __forceinline__ void lds_add(LAS int* p, int v) { (void)__hip_atomic_fetch_add(p, v, __ATOMIC_RELAXED, __HIP_MEMORY_SCOPE_WORKGROUP); }
__device__ __forceinline__ float wave_sum(float v) {
#pragma unroll
    for (int o = 1; o < 64; o <<= 1) v += __shfl_xor(v, o);
    return v;
}

__device__ __forceinline__ int map_row(int n, int mode) {
    if (mode == 1) { if (n >= OFF_QB && n < OFF_VB) { const int d = (n - OFF_QB) & 63; if (d < 16) { const int dn = d < 8 ? 2 * d : 2 * (d - 8) + 1; return n - d + dn; } } return n; }
    if (mode == 2) return ((n >> 7) << 8) + (n & 127);
    if (mode == 3) return ((n >> 7) << 8) + 128 + (n & 127);
    return n;
}
template <bool F8>
__device__ __forceinline__ void convert_mat(const float* W, int K, int N, unsigned char* WT, int mode, float wscale, int& base, int gw, int NGW, int lane, const float* kgain = nullptr) {
    constexpr int KI = F8 ? 128 : 64;
    const int nblk = N >> 6, nitems = (K / KI) * nblk;
    int r = gw - (base % NGW); if (r < 0) r += NGW;
    base += nitems;
    const int q = lane >> 4, c4 = lane & 15;
#pragma nounroll
    for (; r < nitems; r += NGW) {
        const int kb = r / nblk, nb = r - kb * nblk, k0 = kb * KI, n = nb * 64 + 4 * c4;
        const GAS float* src = (const GAS float*)W + (size_t)k0 * N + n;
        size_t drow[4];
#pragma unroll
        for (int c = 0; c < 4; ++c) drow[c] = (size_t)map_row(n + c, mode) * K + k0;
#pragma nounroll
        for (int sgm = 0; sgm < 2; ++sgm) {
            f32x4 v[16];
            if (F8) {
                const int kq = 64 * sgm + 16 * q;
#pragma unroll
                for (int j = 0; j < 16; ++j) v[j] = *(const GAS f32x4*)(src + (size_t)(kq + j) * N) * wscale;
#pragma unroll
                for (int c = 0; c < 4; ++c) { u32x4 o; o.x = cvt4_fp8(v[0][c], v[1][c], v[2][c], v[3][c]); o.y = cvt4_fp8(v[4][c], v[5][c], v[6][c], v[7][c]);
                    o.z = cvt4_fp8(v[8][c], v[9][c], v[10][c], v[11][c]); o.w = cvt4_fp8(v[12][c], v[13][c], v[14][c], v[15][c]);
                    *(GAS u32x4*)(WT + drow[c] + kq) = o; }
            } else {
                const int kq = 32 * sgm + 8 * q;
#pragma unroll
                for (int j = 0; j < 8; ++j) v[j] = *(const GAS f32x4*)(src + (size_t)(kq + j) * N);
                if (kgain) {
#pragma unroll
                    for (int j = 0; j < 8; ++j) v[j] = v[j] * kgain[k0 + kq + j]; }
#pragma unroll
                for (int c = 0; c < 4; ++c) { u32x4 o; o.x = pk2(v[0][c], v[1][c]); o.y = pk2(v[2][c], v[3][c]); o.z = pk2(v[4][c], v[5][c]); o.w = pk2(v[6][c], v[7][c]);
                    *(GAS u32x4*)((bf16*)WT + drow[c] + kq) = o; }
            }
        }
    }
}
__device__ __forceinline__ void phase_convert(Frame& F) {
    const int gw = F.bx * NWAVES + F.wave, NGW = F.G * NWAVES;
    int base = 0;
#pragma nounroll
    for (int L = 0; L < DEPTH; ++L) { unsigned char* wc = F.ws + WS_WC + (size_t)L * WC_STRIDE;
#if QKV_FP8
        convert_mat<true>(INP(3) + (size_t)L * D * NQKV, D, NQKV, wc + WC_IN, 1, W8_SCALE, base, gw, NGW, F.lane);
#else
        convert_mat<false>(INP(3) + (size_t)L * D * NQKV, D, NQKV, wc + WC_IN, 1, 1.0f, base, gw, NGW, F.lane, INP(2) + (size_t)L * D);
#endif
        convert_mat<false>(INP(6) + (size_t)L * D * 512, D, 512, wc + WC_MKV, 0, 1.0f, base, gw, NGW, F.lane);
        convert_mat<false>(INP(8) + (size_t)L * D * D, D, D, wc + WC_OUT, 0, 1.0f, base, gw, NGW, F.lane); }
#pragma nounroll
    for (int i = 0; i < 2; ++i) { unsigned char* wd = F.ws + WS_WD + (size_t)i * WD_STRIDE;
        if (DENSE_UP8(2 * i)) { convert_mat<true>(INP(10) + (size_t)i * D * FF, D, FF, wd, 2, W8_SCALE, base, gw, NGW, F.lane); convert_mat<true>(INP(11) + (size_t)i * D * FF, D, FF, wd, 3, W8_SCALE, base, gw, NGW, F.lane); }
        else { convert_mat<false>(INP(10) + (size_t)i * D * FF, D, FF, wd, 2, 1.0f, base, gw, NGW, F.lane); convert_mat<false>(INP(11) + (size_t)i * D * FF, D, FF, wd, 3, 1.0f, base, gw, NGW, F.lane); }
        if (DENSE_DN8(2 * i)) convert_mat<true>(INP(12) + (size_t)i * FF * D, FF, D, wd + 14 * MiB, 0, WD8_SCALE, base, gw, NGW, F.lane);
        else convert_mat<false>(INP(12) + (size_t)i * FF * D, FF, D, wd + 14 * MiB, 0, 1.0f, base, gw, NGW, F.lane); }
#pragma nounroll
    for (int ie = 0; ie < 2 * NE; ++ie) { const int i = ie >> 3, e = ie & 7; unsigned char* wm = F.ws + WS_WM + (size_t)i * WM_STRIDE; const size_t eo = (size_t)ie * D * FF;
        convert_mat<true>(INP(14) + eo, D, FF, wm + (size_t)e * 7 * MiB, 2, W8_SCALE, base, gw, NGW, F.lane);
        convert_mat<true>(INP(15) + eo, D, FF, wm + (size_t)e * 7 * MiB, 3, W8_SCALE, base, gw, NGW, F.lane);
        convert_mat<true>(INP(16) + eo, FF, D, wm + WM_DOWN + (size_t)e * WD8_ESTRIDE, 0, WD8_SCALE, base, gw, NGW, F.lane); }
    float* cosT = (float*)(F.ws + WS_COS); float* sinT = (float*)(F.ws + WS_SIN);
    for (int idx = F.bx * 512 + F.tid; idx < T * 8; idx += F.G * 512) {
        const int t = idx >> 3, i = idx & 7;
        const double f = (i == 0) ? 0.15915494309189535 : (i == 1) ? 0.03086376340470123 : (i == 2) ? 0.005985185712713705 : (i == 3) ? 0.001160663641240061
                       : (i == 4) ? 0.00022507907903927653 : (i == 5) ? 4.364795279280289e-05 : (i == 6) ? 8.464330808241401e-06 : 1.6414262627950345e-06;
        double rev = (double)t * f; rev -= (double)(long long)rev;
        const float rf = (float)rev;
        cosT[idx] = __builtin_amdgcn_cosf(rf); sinT[idx] = __builtin_amdgcn_sinf(rf);
    }
}

struct RowPass {
    const float* xsrc; const bf16* xbf; bf16* xdst;
    const float* gain;
    bf16* ob; float* of;
    int obp; float* ssq;
    unsigned char* ob8;
    int combine;
    int router; const float* wr;
};
constexpr int RG = 2;
__device__ __forceinline__ void phase_rows(Frame& F, const RowPass P) {
    LAS float* wrl = (LAS float*)F.lds;
    LAS int* hist = (LAS int*)(F.misc + MISC_SCR);
    const bf16* YS = (const bf16*)(F.ws + WS_GA);
    const int* posg = (const int*)(F.ws + WS_POS); const float* gateg = (const float*)(F.ws + WS_GATE);
    int* e01g = (int*)(F.ws + WS_E01); float* gatew = (float*)(F.ws + WS_GATE); int* tcnt = (int*)(F.ws + WS_TCNT);
    if (P.router) { for (int i = F.tid; i < D * 8; i += 512) wrl[i] = P.wr[i]; }
    f32x4 gv[4];
#pragma unroll
    for (int j = 0; j < 4; ++j) gv[j] = *(const f32x4*)(P.gain + 4 * F.lane + 256 * j);
    const int tstart = (F.G == 256) ? ((F.bx & 7) * 32 + (F.bx >> 3)) : F.bx, tstride = (F.G == 256) ? M / 256 : F.G;
    for (int tile = tstart; tile < M / 256; tile += tstride) {
        if (P.router) { if (F.tid < 8) hist[F.tid] = 0; }
        __syncthreads();
        f32x4 buf[RG][4]; u32x2 bub[RG][4];
#pragma unroll
        for (int q = 0; q < RG; ++q) {
            if (P.xsrc) { const float* xr = P.xsrc + (size_t)(tile * 256 + F.wave * 32 + q) * D + 4 * F.lane;
#pragma unroll
                for (int j = 0; j < 4; ++j) buf[q][j] = __builtin_nontemporal_load((const f32x4*)(xr + 256 * j)); }
            else { const bf16* xr = P.xbf + (size_t)(tile * 256 + F.wave * 32 + q) * XP + 4 * F.lane;
#pragma unroll
                for (int j = 0; j < 4; ++j) bub[q][j] = *(const u32x2*)(xr + 256 * j); } }
#pragma nounroll
        for (int i0 = 0; i0 < 32; i0 += RG) {
            const int rowb = tile * 256 + F.wave * 32 + i0;
            f32x4 v[RG][4];
#pragma unroll
            for (int q = 0; q < RG; ++q)
#pragma unroll
                for (int j = 0; j < 4; ++j) v[q][j] = P.xsrc ? buf[q][j] : (f32x4){bf_lo(bub[q][j].x), bf_hi(bub[q][j].x), bf_lo(bub[q][j].y), bf_hi(bub[q][j].y)};
            if (i0 + RG < 32) {
#pragma unroll
                for (int q = 0; q < RG; ++q) {
                    if (P.xsrc) { const float* xr = P.xsrc + (size_t)(rowb + RG + q) * D + 4 * F.lane;
#pragma unroll
                        for (int j = 0; j < 4; ++j) buf[q][j] = __builtin_nontemporal_load((const f32x4*)(xr + 256 * j)); }
                    else { const bf16* xr = P.xbf + (size_t)(rowb + RG + q) * XP + 4 * F.lane;
#pragma unroll
                        for (int j = 0; j < 4; ++j) bub[q][j] = *(const u32x2*)(xr + 256 * j); } }
            }
#pragma unroll
            for (int q = 0; q < RG; ++q) {
                const int row = rowb + q;
                if (P.combine) {
                    const int p0 = posg[2 * row], p1 = posg[2 * row + 1]; const float g0 = gateg[2 * row], g1 = gateg[2 * row + 1];
                    const bf16* y0 = YS + (size_t)p0 * D + 4 * F.lane; const bf16* y1 = YS + (size_t)p1 * D + 4 * F.lane;
#pragma unroll
                    for (int j = 0; j < 4; ++j) { const u32x2 a = *(const u32x2*)(y0 + 256 * j), b = *(const u32x2*)(y1 + 256 * j);
                        v[q][j][0] += g0 * bf_lo(a.x) + g1 * bf_lo(b.x); v[q][j][1] += g0 * bf_hi(a.x) + g1 * bf_hi(b.x);
                        v[q][j][2] += g0 * bf_lo(a.y) + g1 * bf_lo(b.y); v[q][j][3] += g0 * bf_hi(a.y) + g1 * bf_hi(b.y); }
                }
                if (P.xdst) {
                    bf16* xw = P.xdst + (size_t)row * XP + 4 * F.lane;
#pragma unroll
                    for (int j = 0; j < 4; ++j) { u32x2 w; w.x = pk2(v[q][j][0], v[q][j][1]); w.y = pk2(v[q][j][2], v[q][j][3]); *(u32x2*)(xw + 256 * j) = w; }
                }
                float s = 0.f;
#pragma unroll
                for (int j = 0; j < 4; ++j) s += (v[q][j][0] * v[q][j][0] + v[q][j][1] * v[q][j][1]) + (v[q][j][2] * v[q][j][2] + v[q][j][3] * v[q][j][3]);
                const float wsum = wave_sum(s);
                if (P.ssq) { if (F.lane < 4) *(f32x4*)(P.ssq + (size_t)row * 16 + 4 * F.lane) = (f32x4){F.lane == 0 ? wsum : 0.f, 0.f, 0.f, 0.f}; }
                const float rstd = 1.0f / sqrtf(wsum * (1.0f / D) + RMS_EPS);
#pragma unroll
                for (int j = 0; j < 4; ++j) v[q][j] = v[q][j] * rstd * gv[j];
                if (P.ob) {
                    bf16* o = P.ob + (size_t)row * P.obp + 4 * F.lane;
#pragma unroll
                    for (int j = 0; j < 4; ++j) { u32x2 w; w.x = pk2(v[q][j][0], v[q][j][1]); w.y = pk2(v[q][j][2], v[q][j][3]); *(u32x2*)(o + 256 * j) = w; }
                }
                if (P.ob8) {
                    unsigned char* o = P.ob8 + (size_t)row * D + 4 * F.lane;
#pragma unroll
                    for (int j = 0; j < 4; ++j) *(unsigned*)(o + 256 * j) = cvt4_fp8(v[q][j][0] * A8_SCALE, v[q][j][1] * A8_SCALE, v[q][j][2] * A8_SCALE, v[q][j][3] * A8_SCALE);
                }
                if (P.of) {
                    float* o = P.of + (size_t)row * D + 4 * F.lane;
#pragma unroll
                    for (int j = 0; j < 4; ++j) __builtin_nontemporal_store(v[q][j], (f32x4*)(o + 256 * j));
                }
            }
            if (P.router) {
                float lg[RG][8];
#pragma unroll
                for (int q = 0; q < RG; ++q)
#pragma unroll
                    for (int e = 0; e < 8; ++e) lg[q][e] = 0.f;
#pragma unroll
                for (int j = 0; j < 4; ++j)
#pragma unroll
                    for (int c = 0; c < 4; ++c) { const LAS f32x4* w = (const LAS f32x4*)(wrl + (4 * F.lane + 256 * j + c) * 8); const f32x4 w0 = w[0], w1 = w[1];
#pragma unroll
                        for (int q = 0; q < RG; ++q) { const float h = v[q][j][c];
                            lg[q][0] += h * w0[0]; lg[q][1] += h * w0[1]; lg[q][2] += h * w0[2]; lg[q][3] += h * w0[3]; lg[q][4] += h * w1[0]; lg[q][5] += h * w1[1]; lg[q][6] += h * w1[2]; lg[q][7] += h * w1[3]; } }
#pragma unroll
                for (int q = 0; q < RG; ++q) {
                    const int row = rowb + q;
#pragma unroll
                    for (int e = 0; e < 8; ++e) lg[q][e] = wave_sum(lg[q][e]);
                    int e0 = 0; float b0 = lg[q][0];
#pragma unroll
                    for (int e = 1; e < 8; ++e) if (lg[q][e] > b0) { b0 = lg[q][e]; e0 = e; }
                    int e1 = -1; float b1 = -INFINITY;
#pragma unroll
                    for (int e = 0; e < 8; ++e) if (e != e0 && lg[q][e] > b1) { b1 = lg[q][e]; e1 = e; }
                    if (e1 < 0) { e1 = (e0 + 1) & 7; b1 = b0; }
                    const float g0 = 1.0f / (1.0f + expf(b1 - b0));
                    if (F.lane == 0) { e01g[row] = e0 | (e1 << 8); gatew[2 * row] = g0; gatew[2 * row + 1] = 1.0f - g0; lds_add(&hist[e0], 1); lds_add(&hist[e1], 1); }
                }
            }
        }
        __syncthreads();
        if (P.router) { if (F.tid < 8) tcnt[tile * 8 + F.tid] = hist[F.tid]; }
    }
}
__device__ __forceinline__ void phase_memnorm(Frame& F) {
    const int gw = F.bx * NWAVES + F.wave, NGW = F.G * NWAVES;
    bf16* MN = (bf16*)(F.ws + WS_MEMN4);
    const float* memp = INP(1); const float* gbase = INP(5);
    for (int r = gw; r < DEPTH * MROWS; r += NGW) {
        const int L = r / MROWS, row = r - L * MROWS;
        const float* xr = memp + (size_t)row * D + 4 * F.lane; const float* gain = gbase + (size_t)L * D + 4 * F.lane;
        f32x4 v[4]; float s = 0.f;
#pragma unroll
        for (int j = 0; j < 4; ++j) { v[j] = *(const f32x4*)(xr + 256 * j); s += (v[j][0] * v[j][0] + v[j][1] * v[j][1]) + (v[j][2] * v[j][2] + v[j][3] * v[j][3]); }
        const float rstd = 1.0f / sqrtf(wave_sum(s) * (1.0f / D) + RMS_EPS);
        bf16* o = MN + (size_t)r * D + 4 * F.lane;
#pragma unroll
        for (int j = 0; j < 4; ++j) { const f32x4 y = v[j] * rstd * *(const f32x4*)(gain + 256 * j); u32x2 w; w.x = pk2(y[0], y[1]); w.y = pk2(y[2], y[3]); *(u32x2*)(o + 256 * j) = w; }
    }
}

__device__ __forceinline__ void phase_moe_assign(Frame& F) {
    LAS int* sc = (LAS int*)(F.misc + MISC_SCR);
    LAS int* dst = (LAS int*)(F.lds);
    const int* tcnt = (const int*)(F.ws + WS_TCNT); const int* e01g = (const int*)(F.ws + WS_E01);
    int* posg = (int*)(F.ws + WS_POS); int* texp = (int*)(F.ws + WS_TEXP);
    const unsigned char* HB8 = F.ws + WS_HB; unsigned char* GA8 = F.ws + WS_GA8;
    const int tstart = (F.G == 256) ? ((F.bx & 7) * 32 + (F.bx >> 3)) : F.bx, tstride = (F.G == 256) ? M / 256 : F.G;
    for (int tile = tstart; tile < M / 256; tile += tstride) {
        __syncthreads();
        if (F.tid < 80) sc[F.tid] = 0;
        __syncthreads();
        if (F.tid < 256) {
            const int j = F.tid;
#pragma unroll
            for (int e = 0; e < 8; ++e) { const int c = tcnt[j * 8 + e]; lds_add(&sc[e], c); if (j < tile) lds_add(&sc[8 + e], c); }
        }
        __syncthreads();
        if (F.tid == 0) { int ps = 0; for (int e = 0; e < 8; ++e) { sc[64 + e] = ps; sc[16 + e] = ps + sc[8 + e]; ps += (sc[e] + 255) & ~255; } sc[72] = ps; }
        __syncthreads();
        if (tile == 0 && F.tid < 8) {
            const int e = F.tid; const int t0 = sc[64 + e] >> 8, t1 = (e == 7 ? sc[72] : sc[64 + e + 1]) >> 8;
            for (int t = t0; t < t1; ++t) texp[t] = e;
            if (e == 7) texp[MAXTILES] = sc[72] >> 8;
        }
        int e0 = 0, e1 = 0, r0 = 0, r1 = 0;
        if (F.tid < 256) {
            const int w = F.tid >> 6; const int pk = e01g[tile * 256 + F.tid]; e0 = pk & 255; e1 = pk >> 8;
            const unsigned long long below = (1ull << F.lane) - 1ull;
#pragma unroll
            for (int e = 0; e < 8; ++e) {
                const unsigned long long m0 = __ballot(e0 == e), m1 = __ballot(e1 == e);
                const int rk = __popcll(m0 & below) + __popcll(m1 & below);
                if (e0 == e) r0 = rk; if (e1 == e) r1 = rk;
                if (F.lane == 0) sc[32 + w * 8 + e] = __popcll(m0) + __popcll(m1);
            }
        }
        __syncthreads();
        if (F.tid < 256) {
            const int w = F.tid >> 6; int b0 = sc[16 + e0], b1 = sc[16 + e1];
            for (int ww = 0; ww < w; ++ww) { b0 += sc[32 + ww * 8 + e0]; b1 += sc[32 + ww * 8 + e1]; }
            const int d0 = b0 + r0, d1 = b1 + r1;
            dst[2 * F.tid] = d0; dst[2 * F.tid + 1] = d1;
            posg[2 * (tile * 256 + F.tid)] = d0; posg[2 * (tile * 256 + F.tid) + 1] = d1;
        }
        __syncthreads();
#pragma nounroll
        for (int t0 = F.wave * 32; t0 < F.wave * 32 + 32; t0 += 16) {
            u32x4 v[16];
#pragma unroll
            for (int j = 0; j < 16; ++j) v[j] = ((const u32x4*)(HB8 + (size_t)(tile * 256 + t0 + j) * D))[F.lane];
#pragma unroll
            for (int j = 0; j < 16; ++j) { const int d0 = dst[2 * (t0 + j)], d1 = dst[2 * (t0 + j) + 1];
                ((u32x4*)(GA8 + (size_t)d0 * D))[F.lane] = v[j]; ((u32x4*)(GA8 + (size_t)d1 * D))[F.lane] = v[j]; }
        }
    }
}

namespace att {
constexpr int L_OS = 0, L_MS = 32768, L_LS = 33792, L_SSQ = 34816, L_RPB = 51200, L_KV = 62976, KV_WAVE = 8832, KT_BYTES = 4608;
static_assert(L_KV + 8 * KV_WAVE <= MISC_OFF, "attention LDS map");
__device__ __forceinline__ f32x4 mfma16(bf16x8 a, bf16x8 b, f32x4 c) { return __builtin_amdgcn_mfma_f32_16x16x32_bf16(a, b, c, 0, 0, 0); }
__device__ __forceinline__ v4i16_t vtr(const LAS unsigned char* p) { return __builtin_amdgcn_ds_read_tr16_b64_v4i16((LAS v4i16_t*)p); }

struct St { float m, lp; f32x4 o[4]; };
__device__ __forceinline__ void st_init(St& s) { s.m = -1e30f; s.lp = 0.f;
#pragma unroll
    for (int d = 0; d < 4; ++d) s.o[d] = (f32x4){0.f, 0.f, 0.f, 0.f}; }

struct Ld { u32x4 k0, k1, k2, k3, v0, v1, v2, v3; };
__device__ __forceinline__ void ld_issue8(Ld& L, const bf16* k0p, const bf16* k1p, const bf16* k2p, const bf16* k3p, const bf16* v0p, const bf16* v1p, const bf16* v2p, const bf16* v3p) {
    L.k0 = *(const u32x4*)(k0p); L.k1 = *(const u32x4*)(k1p); L.k2 = *(const u32x4*)(k2p); L.k3 = *(const u32x4*)(k3p);
    L.v0 = *(const u32x4*)(v0p); L.v1 = *(const u32x4*)(v1p); L.v2 = *(const u32x4*)(v2p); L.v3 = *(const u32x4*)(v3p);
}
__device__ __forceinline__ void ld_issue(Ld& L, const bf16* kp, const bf16* vp, size_t r8) { ld_issue8(L, kp, kp + r8, kp + 2 * r8, kp + 3 * r8, vp, vp + r8, vp + 2 * r8, vp + 3 * r8); }
constexpr int VPL = 1056;
struct Kf { bf16x8 k00, k01, k10, k11; };
__device__ __forceinline__ void stage_kv(const Ld& L, LAS unsigned char* kvl, int lane) {
    LAS unsigned char* kw = kvl + (lane >> 3) * 144 + (lane & 7) * 16;
    *(LAS u32x4*)(kw) = L.k0; *(LAS u32x4*)(kw + 1152) = L.k1; *(LAS u32x4*)(kw + 2304) = L.k2; *(LAS u32x4*)(kw + 3456) = L.k3;
    const int c = lane & 7; LAS unsigned char* vw = kvl + KT_BYTES + (c >> 1) * VPL + (lane >> 3) * 32 + (c & 1) * 16;
    *(LAS u32x4*)(vw) = L.v0; *(LAS u32x4*)(vw + 256) = L.v1; *(LAS u32x4*)(vw + 512) = L.v2; *(LAS u32x4*)(vw + 768) = L.v3;
}
__device__ __forceinline__ Kf kf_read(const LAS unsigned char* kvl, int lq, int lg) {
    const LAS unsigned char* p = kvl + lq * 144 + lg * 16; Kf k;
    k.k00 = *(const LAS bf16x8*)(p); k.k01 = *(const LAS bf16x8*)(p + 64); k.k10 = *(const LAS bf16x8*)(p + 16 * 144); k.k11 = *(const LAS bf16x8*)(p + 16 * 144 + 64); return k;
}
__device__ __forceinline__ void qk(const Kf& L, const bf16x8 (&q)[2], f32x4& s0, f32x4& s1) {
    const f32x4 z = (f32x4){0.f, 0.f, 0.f, 0.f};
    s0 = mfma16(L.k00, q[0], z); s0 = mfma16(L.k01, q[1], s0); s1 = mfma16(L.k10, q[0], z); s1 = mfma16(L.k11, q[1], s1);
}
__device__ __forceinline__ void soft_pv(f32x4 s0, f32x4 s1, const LAS unsigned char* vl, int lq, int lg, St& S) {
    const float mx = vmax2(vmax3(s0[0], s0[1], s0[2]), vmax3(vmax3(s0[3], s1[0], s1[1]), s1[2], s1[3]));
    if (__any(mx > S.m + 8.0f)) {
        float mf = vmax2(mx, __shfl_xor(mx, 16)); mf = vmax2(mf, __shfl_xor(mf, 32));
        const float mn = vmax2(S.m, mf); const float alpha = __builtin_amdgcn_exp2f(S.m - mn); S.m = mn;
        S.lp *= alpha;
#pragma unroll
        for (int d = 0; d < 4; ++d) S.o[d] = S.o[d] * alpha;
    }
    const float mn = S.m;
    float p[8];
#pragma unroll
    for (int r = 0; r < 4; ++r) { p[r] = __builtin_amdgcn_exp2f(s0[r] - mn); p[4 + r] = __builtin_amdgcn_exp2f(s1[r] - mn); }
    S.lp += ((p[0] + p[1]) + (p[2] + p[3])) + ((p[4] + p[5]) + (p[6] + p[7]));
    u32x4 pw; pw.x = pg8::cvt_pk_bf16(p[0], p[1]); pw.y = pg8::cvt_pk_bf16(p[2], p[3]); pw.z = pg8::cvt_pk_bf16(p[4], p[5]); pw.w = pg8::cvt_pk_bf16(p[6], p[7]);
    const bf16x8 pf = __builtin_bit_cast(bf16x8, pw);
    const LAS unsigned char* tb = vl + KT_BYTES + (4 * lg + (lq >> 2)) * 32 + 8 * (lq & 3);
#pragma unroll
    for (int d = 0; d < 4; ++d) {
        const v4i16_t lo = vtr(tb + d * VPL), hi = vtr(tb + d * VPL + 512);
        const bf16x8 vf = (bf16x8){lo[0], lo[1], lo[2], lo[3], hi[0], hi[1], hi[2], hi[3]};
        S.o[d] = mfma16(vf, pf, S.o[d]);
    }
}
template <int NT>
__device__ __forceinline__ void multi_soft_pv(f32x4 (&s0)[NT], f32x4 (&s1)[NT], const LAS unsigned char* vl, int lq, int lg, St (&S)[NT], const int am = -1) {
    float mx[NT]; bool trig = false;
#pragma unroll
    for (int t = 0; t < NT; ++t) if (am & (1 << t)) { mx[t] = vmax2(vmax3(s0[t][0], s0[t][1], s0[t][2]), vmax3(vmax3(s0[t][3], s1[t][0], s1[t][1]), s1[t][2], s1[t][3])); trig = trig || (mx[t] > S[t].m + 8.0f); }
    if (__any(trig)) {
#pragma unroll
        for (int t = 0; t < NT; ++t) if (am & (1 << t)) {
            float mf = vmax2(mx[t], __shfl_xor(mx[t], 16)); mf = vmax2(mf, __shfl_xor(mf, 32));
            const float mn = vmax2(S[t].m, mf); const float alpha = __builtin_amdgcn_exp2f(S[t].m - mn); S[t].m = mn; S[t].lp *= alpha;
#pragma unroll
            for (int d = 0; d < 4; ++d) S[t].o[d] = S[t].o[d] * alpha;
        }
    }
    bf16x8 pf[NT];
#pragma unroll
    for (int t = 0; t < NT; ++t) if (am & (1 << t)) {
        const float mn = S[t].m; float p[8];
#pragma unroll
        for (int r = 0; r < 4; ++r) { p[r] = __builtin_amdgcn_exp2f(s0[t][r] - mn); p[4 + r] = __builtin_amdgcn_exp2f(s1[t][r] - mn); }
        S[t].lp += ((p[0] + p[1]) + (p[2] + p[3])) + ((p[4] + p[5]) + (p[6] + p[7]));
        u32x4 pw; pw.x = pg8::cvt_pk_bf16(p[0], p[1]); pw.y = pg8::cvt_pk_bf16(p[2], p[3]); pw.z = pg8::cvt_pk_bf16(p[4], p[5]); pw.w = pg8::cvt_pk_bf16(p[6], p[7]);
        pf[t] = __builtin_bit_cast(bf16x8, pw);
    }
    const LAS unsigned char* tb = vl + KT_BYTES + (4 * lg + (lq >> 2)) * 32 + 8 * (lq & 3);
#pragma unroll
    for (int d = 0; d < 4; ++d) {
        const v4i16_t lo = vtr(tb + d * VPL), hi = vtr(tb + d * VPL + 512);
        const bf16x8 vf = (bf16x8){lo[0], lo[1], lo[2], lo[3], hi[0], hi[1], hi[2], hi[3]};
#pragma unroll
        for (int t = 0; t < NT; ++t) if (am & (1 << t)) S[t].o[d] = mfma16(vf, pf[t], S[t].o[d]);
    }
}
__device__ __forceinline__ float lsum(float lp) { lp += __shfl_xor(lp, 16); lp += __shfl_xor(lp, 32); return lp; }

__device__ __forceinline__ void finish(const St& S, float l, bf16* yrow  , LAS float* ssq_slot, int lg) {
    const float inv = 1.0f / l; float ss = 0.f;
#pragma unroll
    for (int d = 0; d < 4; ++d) { const f32x4 v = S.o[d] * inv; ss += (v[0] * v[0] + v[1] * v[1]) + (v[2] * v[2] + v[3] * v[3]);
        u32x2 w; w.x = pg8::cvt_pk_bf16(v[0], v[1]); w.y = pg8::cvt_pk_bf16(v[2], v[3]); *(u32x2*)(yrow + 16 * d + 4 * lg) = w; }
    ss += __shfl_xor(ss, 16); ss += __shfl_xor(ss, 32);
    if (lg == 0) *ssq_slot = ss;
}

__device__ __forceinline__ void attn_unit(Frame& F, int b, int t0, int layer) {
    LAS unsigned char* lds = F.lds;
    int lane = F.lane, lq = lane & 15, lg = lane >> 4; const int wave = F.wave;
#define RELANE() do { asm volatile("" : "+v"(lane)); lq = lane & 15; lg = lane >> 4; } while (0)
    const bf16* QKV = (const bf16*)(F.ws + WS_BIG); const bf16* MKV = (const bf16*)(F.ws + WS_MEMKV4) + (size_t)layer * MROWS * 512; bf16* Y = (bf16*)(F.ws + WS_HB);
    LAS bf16* Os = (LAS bf16*)(lds + L_OS); LAS float* Ms = (LAS float*)(lds + L_MS); LAS float* Ls = (LAS float*)(lds + L_LS);
    LAS float* ssq = (LAS float*)(lds + L_SSQ); LAS float* rpb = (LAS float*)(lds + L_RPB);
    LAS unsigned char* vl = lds + L_KV + wave * KV_WAVE;
    const size_t rowb = (size_t)b * T;
    { const float* rp = INP(4) + (size_t)layer * 6 * 465; for (int i = F.tid; i < 6 * 480; i += 512) { const int hh = i / 480, rem = i - hh * 480, ro = rem >> 5, co = rem & 31; rpb[i] = co < 31 ? rp[hh * 465 + ro * 31 + co] * LOG2E : -INFINITY; } }
    __syncthreads();
    const int R0 = t0 >> 6;
#pragma nounroll
    for (int pass = 0; pass < 3; ++pass) {
        RELANE();
        const int h = 2 * pass + (wave >> 2), kq = wave & 3;
        const int qc = 16 * kq + lq, cs = (kq == 0) ? 0 : (kq == 1) ? 8 : (kq == 2) ? 24 : 32;
        int c0q = qc - 8; c0q = c0q < 0 ? 0 : (c0q > 48 ? 48 : c0q);
        unsigned bcol[8];
#pragma unroll
        for (int e = 0; e < 8; ++e) { const int c = cs + 16 * (e >> 2) + 4 * lg + (e & 3); const bool ok = (c >= c0q) && (c <= c0q + 15);
            bcol[e] = (unsigned)(uintptr_t)(rpb + h * 480) + 4u * (unsigned)(ok ? (c - qc + 15) : 31); }
        int r0v[4]; bf16x8 qf[4][2]; St S[4];
#pragma unroll
        for (int rr = 0; rr < 4; ++rr) { const int r = R0 + rr; int r0 = r - 4; r0 = r0 < 0 ? 0 : (r0 > 120 ? 120 : r0); r0v[rr] = r0;
            const size_t qrow = rowb + (size_t)r * 64 + qc;
            qf[rr][0] = *(const bf16x8*)(QKV + qrow * NQKV + OFF_QA + h * 64 + lg * 8); qf[rr][1] = *(const bf16x8*)(QKV + qrow * NQKV + OFF_QA + h * 64 + 32 + lg * 8);
            st_init(S[rr]); }
        const int krmin = r0v[0], nrows = r0v[3] + 8 - krmin;
        const bf16* kbase = QKV + (rowb + (size_t)krmin * 64 + cs + (lane >> 3)) * NQKV + OFF_KA + h * 64 + (lane & 7) * 8;
        const bf16* vbase = kbase + (OFF_VA - OFF_KA);
        const size_t v8 = (size_t)8 * NQKV;
        const size_t rstep = (size_t)64 * NQKV;
        auto na_row = [&](int kr) {
            const Kf kf = kf_read(vl, lq, lg);
            f32x4 s0[4], s1[4];
            int am = 0;
#pragma unroll
            for (int rr = 0; rr < 4; ++rr) am |= (kr >= r0v[rr] && kr < r0v[rr] + 8) ? (1 << rr) : 0;
            am = __builtin_amdgcn_readfirstlane(am);
#pragma unroll
            for (int rr = 0; rr < 4; ++rr) if (am & (1 << rr)) {
                const unsigned ro = (unsigned)(kr - (R0 + rr) + 7) * 128u;
                f32x4 a0, a1;
#pragma unroll
                for (int e = 0; e < 4; ++e) { a0[e] = *(const LAS float*)(uintptr_t)(bcol[e] + ro); a1[e] = *(const LAS float*)(uintptr_t)(bcol[4 + e] + ro); }
                qk(kf, qf[rr], s0[rr], s1[rr]);
                s0[rr] = s0[rr] + a0; s1[rr] = s1[rr] + a1;
            }
            multi_soft_pv<4>(s0, s1, vl, lq, lg, S, am);
            asm volatile("" ::: "memory");
        };
        Ld LA;
        ld_issue(LA, kbase, vbase, v8);
#pragma nounroll
        for (int j = 0; j < nrows; ++j) {
            stage_kv(LA, vl, lane);
            asm volatile("" ::: "memory");
            { const int jn = (j + 1 < nrows) ? j + 1 : nrows - 1; ld_issue(LA, kbase + (size_t)jn * rstep, vbase + (size_t)jn * rstep, v8); }
            na_row(krmin + j);
        }
#pragma unroll
        for (int rr = 0; rr < 4; ++rr) { const float l = lsum(S[rr].lp);
            finish(S[rr], l, Y + (rowb + (size_t)(R0 + rr) * 64 + qc) * D + h * 64, ssq + h * 256 + (rr * 64 + qc), lg); }
    }
#pragma nounroll
    for (int pass = 0; pass < 2; ++pass) {
        RELANE();
        const int h = 2 * pass + (wave >> 2), j0 = 4 * (wave & 3);
        bf16x8 qf[4][2]; St S[4];
#pragma unroll
        for (int t = 0; t < 4; ++t) { const size_t qrow = rowb + t0 + 16 * (j0 + t) + lq;
            qf[t][0] = *(const bf16x8*)(QKV + qrow * NQKV + OFF_QM + h * 64 + lg * 8); qf[t][1] = *(const bf16x8*)(QKV + qrow * NQKV + OFF_QM + h * 64 + 32 + lg * 8);
            st_init(S[t]); }
        const bf16* kbase = MKV + ((size_t)b * NMEM + (lane >> 3)) * 512 + h * 64 + (lane & 7) * 8;
        const bf16* vbase = kbase + 256;
        Ld LA;
        ld_issue(LA, kbase, vbase, (size_t)8 * 512);
#pragma nounroll
        for (int s = 0; s < 8; ++s) {
            stage_kv(LA, vl, lane);
            asm volatile("" ::: "memory");
            { const int sn = (s + 1 < 8) ? s + 1 : 7; ld_issue(LA, kbase + sn * 32 * 512, vbase + sn * 32 * 512, (size_t)8 * 512); }
            const Kf kf = kf_read(vl, lq, lg);
            f32x4 s0[4], s1[4];
#pragma unroll
            for (int t = 0; t < 4; ++t) qk(kf, qf[t], s0[t], s1[t]);
            multi_soft_pv<4>(s0, s1, vl, lq, lg, S);
            asm volatile("" ::: "memory");
        }
#pragma unroll
        for (int t = 0; t < 4; ++t) { const int idx = 16 * (j0 + t) + lq; const float l = lsum(S[t].lp);
            finish(S[t], l, Y + (rowb + t0 + idx) * D + 768 + h * 64, ssq + (12 + h) * 256 + idx, lg); }
    }
    __syncthreads();
    for (int h = 0; h < 6; ++h) {
#pragma nounroll
        for (int br = 0; br < 2; ++br) {
            RELANE();
            const int sh = 2 * br, dl = 1 << sh, seg = T >> sh;
            const int res = br ? (wave >> 1) : 0, m0 = br ? ((t0 >> 2) + 32 * (wave & 1)) : (t0 + 32 * wave);
            bf16x8 qf[2][2]; St S[2]; int idxv[2];
#pragma unroll
            for (int t = 0; t < 2; ++t) { const size_t qrow = rowb + (size_t)(m0 + 16 * t + lq) * dl + res;
                qf[t][0] = *(const bf16x8*)(QKV + qrow * NQKV + OFF_QB + h * 64 + lg * 8); qf[t][1] = *(const bf16x8*)(QKV + qrow * NQKV + OFF_QB + h * 64 + 32 + lg * 8);
                st_init(S[t]); idxv[t] = br ? (128 * (wave & 1) + 64 * t + 4 * lq + res) : (32 * wave + 16 * t + lq); }
            const bool edge = (m0 - 64 < 0) || (m0 + 95 >= seg);
            auto dload = [&](Ld& L, int s) {
                const int kb = m0 - 64 + 32 * s;
                int kv = kb + (lane >> 3);
                const bf16* kcol = QKV + (rowb + res) * NQKV + OFF_KB + h * 64 + (lane & 7) * 8; const bf16* vcol = kcol + (OFF_VB - OFF_KB);
                const size_t rs = (size_t)dl * NQKV;
                if (edge) {
                    int v0 = kv, v1 = kv + 8, v2 = kv + 16, v3 = kv + 24;
                    v0 = v0 < 0 ? 0 : (v0 >= seg ? seg - 1 : v0); v1 = v1 < 0 ? 0 : (v1 >= seg ? seg - 1 : v1); v2 = v2 < 0 ? 0 : (v2 >= seg ? seg - 1 : v2); v3 = v3 < 0 ? 0 : (v3 >= seg ? seg - 1 : v3);
                    ld_issue8(L, kcol + (size_t)v0 * rs, kcol + (size_t)v1 * rs, kcol + (size_t)v2 * rs, kcol + (size_t)v3 * rs, vcol + (size_t)v0 * rs, vcol + (size_t)v1 * rs, vcol + (size_t)v2 * rs, vcol + (size_t)v3 * rs);
                } else ld_issue(L, kcol + (size_t)kv * rs, vcol + (size_t)kv * rs, 8 * rs); };
            auto dstep = [&](int s) {
                const Kf kf = kf_read(vl, lq, lg);
                const int kb = m0 - 64 + 32 * s;
                f32x4 s0[2], s1[2];
#pragma unroll
                for (int t = 0; t < 2; ++t) {
                    qk(kf, qf[t], s0[t], s1[t]);
                    if (edge || s == 0 || s == 4) {
                        const int qm = m0 + 16 * t + lq;
#pragma unroll
                        for (int e = 0; e < 8; ++e) { const int km = kb + 16 * (e >> 2) + 4 * lg + (e & 3); const int dd = km - qm;
                            const bool ok = (km >= 0) && (km < seg) && (dd >= -64) && (dd <= 64); if (!ok) { if (e < 4) s0[t][e] = -INFINITY; else s1[t][e - 4] = -INFINITY; } }
                    }
                }
                multi_soft_pv<2>(s0, s1, vl, lq, lg, S);
                asm volatile("" ::: "memory");
            };
            { Ld LA;
              dload(LA, 0);
#pragma nounroll
              for (int s = 0; s < 5; ++s) {
                  stage_kv(LA, vl, lane);
                  asm volatile("" ::: "memory");
                  dload(LA, s + 1 < 5 ? s + 1 : 4);
                  dstep(s);
              } }
#pragma unroll
            for (int t = 0; t < 2; ++t) {
                const int idx = idxv[t]; float l = lsum(S[t].lp);
                LAS u32x2* osr = (LAS u32x2*)(Os + idx * 64 + 4 * lg);
                if (br > 0) {
                    const float m1 = Ms[idx], l1 = Ls[idx]; const float mn = vmax2(S[t].m, m1);
                    const float a1 = __builtin_amdgcn_exp2f(m1 - mn), a2 = __builtin_amdgcn_exp2f(S[t].m - mn);
#pragma unroll
                    for (int d = 0; d < 4; ++d) { const u32x2 w = osr[4 * d]; const f32x4 o1 = (f32x4){bf_lo(w.x), bf_hi(w.x), bf_lo(w.y), bf_hi(w.y)}; S[t].o[d] = o1 * a1 + S[t].o[d] * a2; }
                    l = l1 * a1 + l * a2; S[t].m = mn;
                }
#pragma unroll
                for (int d = 0; d < 4; ++d) { u32x2 w; w.x = pg8::cvt_pk_bf16(S[t].o[d][0], S[t].o[d][1]); w.y = pg8::cvt_pk_bf16(S[t].o[d][2], S[t].o[d][3]); osr[4 * d] = w; }
                if (lg == 0) { Ms[idx] = S[t].m; Ls[idx] = l; }
            }
            __syncthreads();
        }
        {
            constexpr int dl = 16, seg = T >> 4;
#pragma nounroll
            for (int tix = wave; tix < 16; tix += 8) {
                RELANE();
                const int res = tix, m0 = t0 >> 4, idx = 16 * lq + res;
                const size_t qrow = rowb + (size_t)(m0 + lq) * dl + res;
                bf16x8 qf[2];
                qf[0] = *(const bf16x8*)(QKV + qrow * NQKV + OFF_QB + h * 64 + lg * 8); qf[1] = *(const bf16x8*)(QKV + qrow * NQKV + OFF_QB + h * 64 + 32 + lg * 8);
                St S; st_init(S);
                const int qm = m0 + lq;
                const bool edge = (m0 - 64 < 0) || (m0 + 95 >= seg);
                auto dload = [&](Ld& L, int s) {
                    const int kb = m0 - 64 + 32 * s;
                    int kv = kb + (lane >> 3);
                    const bf16* kcol = QKV + (rowb + res) * NQKV + OFF_KB + h * 64 + (lane & 7) * 8; const bf16* vcol = kcol + (OFF_VB - OFF_KB);
                    const size_t rs = (size_t)dl * NQKV;
                    if (edge) {
                        int v0 = kv, v1 = kv + 8, v2 = kv + 16, v3 = kv + 24;
                        v0 = v0 < 0 ? 0 : (v0 >= seg ? seg - 1 : v0); v1 = v1 < 0 ? 0 : (v1 >= seg ? seg - 1 : v1); v2 = v2 < 0 ? 0 : (v2 >= seg ? seg - 1 : v2); v3 = v3 < 0 ? 0 : (v3 >= seg ? seg - 1 : v3);
                        ld_issue8(L, kcol + (size_t)v0 * rs, kcol + (size_t)v1 * rs, kcol + (size_t)v2 * rs, kcol + (size_t)v3 * rs, vcol + (size_t)v0 * rs, vcol + (size_t)v1 * rs, vcol + (size_t)v2 * rs, vcol + (size_t)v3 * rs);
                    } else ld_issue(L, kcol + (size_t)kv * rs, vcol + (size_t)kv * rs, 8 * rs); };
                auto dstep = [&](int s) {
                    const Kf kf = kf_read(vl, lq, lg);
                    const int kb = m0 - 64 + 32 * s;
                    f32x4 s0, s1; qk(kf, qf, s0, s1);
                    if (edge || s == 0 || s == 4) {
#pragma unroll
                        for (int e = 0; e < 8; ++e) { const int km = kb + 16 * (e >> 2) + 4 * lg + (e & 3); const int dd = km - qm;
                            const bool ok = (km >= 0) && (km < seg) && (dd >= -64) && (dd <= 64); if (!ok) { if (e < 4) s0[e] = -INFINITY; else s1[e - 4] = -INFINITY; } }
                    }
                    soft_pv(s0, s1, vl, lq, lg, S);
                    asm volatile("" ::: "memory");
                };
                { Ld LA;
                  dload(LA, 0);
#pragma nounroll
                  for (int s = 0; s < 5; ++s) {
                      stage_kv(LA, vl, lane);
                      asm volatile("" ::: "memory");
                      dload(LA, s + 1 < 5 ? s + 1 : 4);
                      dstep(s);
                  } }
                float l = lsum(S.lp);
                LAS u32x2* osr = (LAS u32x2*)(Os + idx * 64 + 4 * lg);
                { const float m1 = Ms[idx], l1 = Ls[idx]; const float mn = vmax2(S.m, m1);
                  const float a1 = __builtin_amdgcn_exp2f(m1 - mn), a2 = __builtin_amdgcn_exp2f(S.m - mn);
#pragma unroll
                  for (int d = 0; d < 4; ++d) { const u32x2 w = osr[4 * d]; const f32x4 o1 = (f32x4){bf_lo(w.x), bf_hi(w.x), bf_lo(w.y), bf_hi(w.y)}; S.o[d] = o1 * a1 + S.o[d] * a2; }
                  l = l1 * a1 + l * a2; S.m = mn; }
                finish(S, l, Y + qrow * D + 384 + h * 64, ssq + (6 + h) * 256 + idx, lg);
            }
            __syncthreads();
        }
    }
    VM_WAIT(); __syncthreads();
    RELANE();
    {
        const float* gm = INP(7) + (size_t)layer * D;
        const int c0 = 8 * lane, c1 = 512 + 8 * lane;
        const int g0 = c0 < 384 ? 0 : 1, g1 = c1 < 768 ? 1 : 2;
        f32x4 ga[2], gb[2];
        ga[0] = *(const f32x4*)(gm + c0); ga[1] = *(const f32x4*)(gm + c0 + 4); gb[0] = *(const f32x4*)(gm + c1); gb[1] = *(const f32x4*)(gm + c1 + 4);
#pragma nounroll
        for (int i0 = 0; i0 < 32; i0 += 4) {
            u32x4 w0[4], w1[4]; float s0v[4], s1v[4];
#pragma unroll
            for (int q = 0; q < 4; ++q) { const bf16* yr = Y + (rowb + t0 + wave * 32 + i0 + q) * D; w0[q] = *(const u32x4*)(yr + c0); w1[q] = *(const u32x4*)(yr + c1); }
#pragma unroll
            for (int q = 0; q < 4; ++q) {
                const int idx = wave * 32 + i0 + q;
                float sa = 0.f, sb = 0.f, sm = 0.f;
#pragma unroll
                for (int hh = 0; hh < 6; ++hh) { sa += ssq[hh * 256 + idx]; sb += ssq[(6 + hh) * 256 + idx]; }
#pragma unroll
                for (int hh = 0; hh < 4; ++hh) sm += ssq[(12 + hh) * 256 + idx];
                const float ra = 1.0f / sqrtf(sa * (1.0f / 384.f) + RMS_EPS), rb = 1.0f / sqrtf(sb * (1.0f / 384.f) + RMS_EPS), rm = 1.0f / sqrtf(sm * (1.0f / 256.f) + RMS_EPS);
                s0v[q] = g0 == 0 ? ra : rb; s1v[q] = g1 == 1 ? rb : rm;
            }
#pragma unroll
            for (int q = 0; q < 4; ++q) {
                bf16* yr = Y + (rowb + t0 + wave * 32 + i0 + q) * D; const float s0 = s0v[q], s1 = s1v[q]; const u32x4 a = w0[q], bb = w1[q];
                u32x4 o0, o1;
                o0.x = pk2(bf_lo(a.x) * s0 * ga[0][0], bf_hi(a.x) * s0 * ga[0][1]); o0.y = pk2(bf_lo(a.y) * s0 * ga[0][2], bf_hi(a.y) * s0 * ga[0][3]);
                o0.z = pk2(bf_lo(a.z) * s0 * ga[1][0], bf_hi(a.z) * s0 * ga[1][1]); o0.w = pk2(bf_lo(a.w) * s0 * ga[1][2], bf_hi(a.w) * s0 * ga[1][3]);
                o1.x = pk2(bf_lo(bb.x) * s1 * gb[0][0], bf_hi(bb.x) * s1 * gb[0][1]); o1.y = pk2(bf_lo(bb.y) * s1 * gb[0][2], bf_hi(bb.y) * s1 * gb[0][3]);
                o1.z = pk2(bf_lo(bb.z) * s1 * gb[1][0], bf_hi(bb.z) * s1 * gb[1][1]); o1.w = pk2(bf_lo(bb.w) * s1 * gb[1][2], bf_hi(bb.w) * s1 * gb[1][3]);
                *(u32x4*)(yr + c0) = o0; *(u32x4*)(yr + c1) = o1;
            }
        }
    }
    __syncthreads();
}
}

#ifdef NO_G1
#define GEMM_SITE1(x)
#else
#define GEMM_SITE1(x) x
#endif
#ifdef NO_G2
#define GEMM_SITE2(x)
#else
#define GEMM_SITE2(x) x
#endif
#ifdef NO_G3
#define GEMM_SITE3(x)
#else
#define GEMM_SITE3(x) x
#endif
#ifdef NO_G4
#define GEMM_SITE4(x)
#else
#define GEMM_SITE4(x) x
#endif
#ifdef NO_G5
#define GEMM_SITE5(x)
#else
#define GEMM_SITE5(x) x
#endif
#ifdef NO_G6
#define GEMM_SITE6(x)
#else
#define GEMM_SITE6(x) x
#endif
#ifdef NO_G7
#define GEMM_SITE7(x)
#else
#define GEMM_SITE7(x) x
#endif
struct Args { const float* in[18]; float* out; unsigned char* ws; int ph_lo, ph_hi, use_bar, pad; };
constexpr int PH_PER_LAYER = 16, SEQ_FINAL = 1 + DEPTH * PH_PER_LAYER, SEQ_END = SEQ_FINAL + 1;

__global__ void __launch_bounds__(NWAVES * 64, 2) fwd_kernel(Args args) {
    extern __shared__ __attribute__((aligned(16))) unsigned char lds_raw[];
    Frame F;
    F.lds = (LAS unsigned char*)lds_raw; F.misc = F.lds + MISC_OFF;
    F.tid = threadIdx.x; F.lane = F.tid & 63; F.wave = __builtin_amdgcn_readfirstlane(F.tid >> 6);
    F.G = gridDim.x; F.bx = blockIdx.x; F.ws = args.ws; F.out = args.out;
    if (F.tid == 0) {
#pragma unroll
        for (int i = 0; i < 18; ++i) ((LAS unsigned long long*)(F.misc + MISC_PTAB))[i] = (unsigned long long)args.in[i];
        ((LAS unsigned long long*)(F.misc + MISC_PTAB))[18] = (unsigned long long)args.ws; ((LAS unsigned long long*)(F.misc + MISC_PTAB))[19] = (unsigned long long)args.out;
    }
    gu32* ctl = (gu32*)(F.ws + WS_CTL);
    if (F.tid < 4) ((LAS unsigned*)(F.misc + MISC_BARW))[F.tid] = 0u;
    __syncthreads();
    XcdBarrier bar; bar.bar = (unsigned*)(ctl + CW_BAR); bar.x = 0; bar.st = nullptr;
    if (args.use_bar) { bar = xcd_barrier_post((unsigned*)(ctl + CW_BAR), (volatile LAS unsigned*)(F.misc + MISC_BARW)); if (F.tid == 0) ((volatile LAS unsigned*)(F.misc + MISC_BARW))[2] = bar.x; __syncthreads(); }
    const int lo = args.ph_lo, hi = args.ph_hi;
#define IN(k) (lo <= (k) && (k) < hi)
#define LAUNDER() do { unsigned lb_ = (unsigned)(uintptr_t)(LAS unsigned char*)lds_raw; asm volatile("" : "+v"(lb_)); lb_ = (unsigned)__builtin_amdgcn_readfirstlane((int)lb_); F.lds = (LAS unsigned char*)(uintptr_t)lb_; F.misc = F.lds + MISC_OFF; \
    F.ws = (unsigned char*)inp_ptr(F.misc, 18); F.out = (float*)inp_ptr(F.misc, 19); asm volatile("" : "+v"(F.tid), "+v"(F.lane)); F.wave = __builtin_amdgcn_readfirstlane(F.tid >> 6); \
    { int bx_ = F.bx, g_ = F.G; asm volatile("" : "+v"(bx_), "+v"(g_)); F.bx = __builtin_amdgcn_readfirstlane(bx_); F.G = __builtin_amdgcn_readfirstlane(g_); } } while (0)
#define SEAM(k) do { if (args.use_bar && (k) + 1 < hi) { XcdBarrier b_; b_.bar = (unsigned*)((unsigned char*)inp_ptr(F.misc, 18) + WS_CTL) + CW_BAR; b_.st = (volatile LAS unsigned*)(F.misc + MISC_BARW); \
        b_.x = (unsigned)__builtin_amdgcn_readfirstlane((int)((volatile LAS unsigned*)(F.misc + MISC_BARW))[2]); xcd_barrier(b_); if (PROBE_BAR2) xcd_barrier(b_); } else { VM_WAIT(); __syncthreads(); } } while (0)

#define HB ((bf16*)(F.ws + WS_HB))
#define QKV ((bf16*)(F.ws + WS_BIG))
    LAS int* texp_l = (LAS int*)(F.misc + MISC_TEXP);

    if (IN(0)) { LAUNDER(); for (int rep = 0; rep < PROBE_CONV_REPS; ++rep) phase_convert(F);
        if (!(args.use_bar && hi > 2)) SEAM(0); }


    for (int L = 0; L < DEPTH; ++L) {
        const int base = 1 + L * PH_PER_LAYER;
        if (hi <= base || lo >= base + PH_PER_LAYER) continue;
        const bool moe = (L & 1) != 0; const int fi = L >> 1;
        const bool f8 = moe || DENSE_UP8(L), f8d = moe || DENSE_DN8(L);
#define wc (F.ws + WS_WC + (size_t)L * WC_STRIDE)
        const int comb = (L > 0 && ((L - 1) & 1)) ? 1 : 0;
        if (IN(base + 0) && (L == 0 || comb)) {
            LAUNDER();
            RowPass P{}; P.xsrc = (L == 0) ? INP(0) : (const float*)nullptr; P.xbf = (const bf16*)F.out; P.combine = comb; P.xdst = (bf16*)F.out; P.gain = INP(2) + (size_t)L * D;
            P.ob = nullptr; P.obp = XP; P.ssq = (float*)(F.ws + WS_SSQ); P.ob8 = nullptr; P.of = nullptr; P.router = 0; P.wr = nullptr;
            phase_rows(F, P);
            if (L == 0) phase_memnorm(F);
            SEAM(base + 0);
        }
        if (IN(base + 1)) {
            LAUNDER();
#if QKV_FP8
            { pg8::Gemm g{HB, (const bf16*)(wc + WC_IN), M, NQKV, D / 2, 0}; pg8::TileOrder S; S.init(M, NQKV, F.G, F.bx, nullptr);
              pg8::EpiQKVT<true> E{QKV, (const float*)(F.ws + WS_COS), (const float*)(F.ws + WS_SIN), ACC8_SCALE};
              GEMM_SITE1(pg8::gemm_phase(F.lds, g, S, E, F.tid)); }
#else
            { pg8::Gemm g{(const bf16*)F.out, (const bf16*)(wc + WC_IN), M, NQKV, D, 0}; pg8::TileOrder S; S.init(M, NQKV, F.G, F.bx, nullptr);
              pg8::EpiQKVT<false> E{QKV, (const float*)(F.ws + WS_COS), (const float*)(F.ws + WS_SIN), 1.0f, (const float*)(F.ws + WS_SSQ), 1};
              GEMM_SITE1(pg8::gemm_phase(F.lds, g, S, E, F.tid)); }
#endif
            if (L == 0) {
                LAUNDER();
                __syncthreads();
                for (int i = F.tid; i < MAXTILES + 8; i += 512) texp_l[i] = i >> 3;
                __syncthreads();
                pg8::Gemm g{(const bf16*)(F.ws + WS_MEMN4), (const bf16*)(F.ws + WS_WC + WC_MKV), DEPTH * MROWS, 512, D, WC_STRIDE}; pg8::TileOrder S; S.init(DEPTH * MROWS, 512, F.G, F.bx, texp_l);
                pg8::EpiPlain E{(bf16*)(F.ws + WS_MEMKV4), 512};
                GEMM_SITE2(pg8::gemm_phase(F.lds, g, S, E, F.tid));
            }
            SEAM(base + 1);
        }
        if (IN(base + 2)) {
            LAUNDER();
#ifndef NO_ATT
            for (int rep = 0; rep < PROBE_ATT_REPS; ++rep)
            for (int v = F.bx; v < M / 256; v += F.G) { const int u = (F.G == 256) ? ((v & 7) * 32 + (v >> 3)) : v;
                att::attn_unit(F, u >> 5, (u & 31) * 256, L); }
#endif
            SEAM(base + 2);
        }
        if (IN(base + 3)) {
            LAUNDER();
            pg8::Gemm g{HB, (const bf16*)(wc + WC_OUT), M, D, D, 0}; pg8::TileOrder S; S.init(M, D, F.G, F.bx, nullptr);
            pg8::EpiResT<false> E{(const float*)nullptr, (bf16*)F.out, nullptr, D, 0, 1.0f};
            GEMM_SITE3(pg8::gemm_phase(F.lds, g, S, E, F.tid));
            SEAM(base + 3);
        }
        if (IN(base + 4)) {
            LAUNDER();
            RowPass P{}; P.xsrc = nullptr; P.xbf = (const bf16*)F.out; P.xdst = nullptr; P.combine = 0; P.gain = INP(9) + (size_t)L * D; P.ob = f8 ? nullptr : HB; P.obp = D; P.ssq = nullptr; P.ob8 = f8 ? (unsigned char*)(F.ws + WS_HB) : nullptr; P.of = nullptr; P.router = moe ? 1 : 0; P.wr = INP(13) + (size_t)fi * D * NE;
            phase_rows(F, P);
            if (PROBE_PE2) { __syncthreads(); phase_rows(F, P); }
            SEAM(base + 4);
        }
        if (moe && IN(base + 5)) { LAUNDER(); phase_moe_assign(F); SEAM(base + 5); }
        int nT = M / 256;
        if (moe && hi > base + 6 && lo < base + 16) nT = __builtin_amdgcn_readfirstlane(((const int*)(F.ws + WS_TEXP))[MAXTILES]);
        nT = nT < 0 ? 0 : (nT > MAXTILES ? MAXTILES : nT);
        const int ntail = (moe && nT > 2 * CHUNK_TILES) ? nT - 2 * CHUNK_TILES : 0;
        const int nsteps = !moe ? 2 : 4;
        for (int k = 0; k < nsteps; ++k) {
            const int pk = base + 6 + k;
            if (!IN(pk)) continue;
            LAUNDER();
            int dc = -1, uc = -1;
            if (!moe) { if (k == 0) uc = 0; else dc = 0; }
            else {
                if (k == 0) uc = 0; else if (k == 1) { dc = 0; uc = ntail ? 2 : -1; } else if (k == 2) { dc = ntail ? 2 : -1; uc = 1; } else dc = 1; }
            {
                __syncthreads();
                const int* tg = (const int*)(F.ws + WS_TEXP);
                for (int i = F.tid; i < MAXTILES + 8; i += 512) texp_l[i] = (moe && i < nT) ? tg[i] : 0;
                __syncthreads();
            }
#define CH_TILE0(ch) (moe ? (ch) * CHUNK_TILES : 0)
#define CH_NTILE(ch) (moe ? ((nT - CH_TILE0(ch)) < CHUNK_TILES ? (nT - CH_TILE0(ch)) : CHUNK_TILES) : M / 256)
#define CH_HID(ch) (moe ? ((ch) == 2 ? (bf16*)(F.ws + WS_MEMN4) : (bf16*)(F.ws + WS_HIDC)) : (bf16*)(F.ws + WS_BIG))
            if (dc >= 0) {
                const int tile0 = CH_TILE0(dc), ntile = CH_NTILE(dc); bf16* hid = CH_HID(dc);
                if (f8d) {
                    pg8::Gemm g{hid, moe ? (const bf16*)(F.ws + WS_WM + (size_t)fi * WM_STRIDE + WM_DOWN) : (const bf16*)(F.ws + WS_WD + (size_t)fi * WD_STRIDE + 14 * MiB), ntile * 256, D, FF / 2, WD8_ESTRIDE};
                    pg8::TileOrder S; S.init(ntile * 256, D, F.G, F.bx, texp_l + tile0);
                    pg8::EpiResT<true> E{nullptr, (bf16*)F.out, (bf16*)(F.ws + WS_GA) + (size_t)tile0 * 256 * D, D, moe ? 1 : 2, ACCD8_SCALE};
                    GEMM_SITE5(pg8::gemm_phase(F.lds, g, S, E, F.tid));
                } else {
                    pg8::Gemm g{hid, (const bf16*)(F.ws + WS_WD + (size_t)fi * WD_STRIDE + 14 * MiB), ntile * 256, D, FF, 0}; pg8::TileOrder S; S.init(ntile * 256, D, F.G, F.bx, texp_l + tile0);
                    pg8::EpiResT<false> E{nullptr, (bf16*)F.out, nullptr, D, 2, 1.0f};
                    GEMM_SITE7(pg8::gemm_phase(F.lds, g, S, E, F.tid));
                }
            }
            if (dc >= 0 && uc >= 0) { LAUNDER(); __syncthreads(); }
            if (uc >= 0) {
                const int tile0 = CH_TILE0(uc), ntile = CH_NTILE(uc); bf16* hid = CH_HID(uc);
                if (f8) {
                    pg8::Gemm g{moe ? (const bf16*)(F.ws + WS_GA8 + (size_t)tile0 * 256 * D) : (const bf16*)(F.ws + WS_HB),
                                moe ? (const bf16*)(F.ws + WS_WM + (size_t)fi * WM_STRIDE) : (const bf16*)(F.ws + WS_WD + (size_t)fi * WD_STRIDE), ntile * 256, 2 * FF, D / 2, (size_t)7 * MiB};
                    pg8::TileOrderSkew S; S.init(ntile * 256, 2 * FF, F.G, F.bx, texp_l + tile0);
                    const bool sk = moe && (dc == 2) && (ntile == F.G);
                    S.nsk = sk ? 4 * CH_NTILE(dc) : 0; S.kd = 3; S.per = 28;
                    pg8::EpiSwigluT<true> E{hid, ACC8_SCALE, f8d ? 0 : 1};
                    GEMM_SITE4(pg8::gemm_phase(F.lds, g, S, E, F.tid));
                } else {
                    pg8::Gemm g{HB, (const bf16*)(F.ws + WS_WD + (size_t)fi * WD_STRIDE), ntile * 256, 2 * FF, D, 0}; pg8::TileOrder S; S.init(ntile * 256, 2 * FF, F.G, F.bx, texp_l + tile0);
                    pg8::EpiSwigluT<false> E{hid, 1.0f, 1};
                    GEMM_SITE6(pg8::gemm_phase(F.lds, g, S, E, F.tid));
                }
            }
            SEAM(pk);
        }
    }
    if (IN(SEQ_FINAL)) {
        LAUNDER();
        RowPass P{}; P.xsrc = nullptr; P.xbf = (const bf16*)F.out; P.xdst = nullptr; P.combine = 1; P.gain = INP(17); P.ob = nullptr; P.obp = D; P.ssq = nullptr; P.of = F.out; P.router = 0; P.wr = nullptr;
        phase_rows(F, P);
    }
#undef IN
#undef SEAM
}

extern "C" void kernel_launch(void* const* d_in, const int* in_sizes, int n_in, void* d_out, int out_size, void* d_ws, size_t ws_size, hipStream_t stream) {
    static int grid = 0;
    if (grid == 0) {
        if (n_in != 18 || out_size != M * D || ws_size < WS_END) { fprintf(stderr, "kernel_launch: unexpected problem (n_in %d out %d ws %zu)\n", n_in, out_size, ws_size); grid = -1; return; }
        int dev = 0, cus = 0, per_cu = 0;
        if (hipGetDevice(&dev) != hipSuccess || hipDeviceGetAttribute(&cus, hipDeviceAttributeMultiprocessorCount, dev) != hipSuccess) { grid = -1; return; }
        if (hipFuncSetAttribute((const void*)fwd_kernel, hipFuncAttributeMaxDynamicSharedMemorySize, LDS_BYTES) != hipSuccess) { fprintf(stderr, "kernel_launch: hipFuncSetAttribute failed\n"); grid = -1; return; }
        if (hipOccupancyMaxActiveBlocksPerMultiprocessor(&per_cu, (const void*)fwd_kernel, NWAVES * 64, LDS_BYTES) != hipSuccess || per_cu < 1) fprintf(stderr, "kernel_launch: occupancy query says %d\n", per_cu);
        (void)hipGetLastError();
        grid = cus;
    }
    if (grid < 0) return;
    (void)hipMemsetAsync((char*)d_ws + WS_CTL, 0, CTL_ZERO_BYTES, stream);
    Args a{};
    for (int i = 0; i < 18; ++i) a.in[i] = (const float*)d_in[i];
    a.out = (float*)d_out; a.ws = (unsigned char*)d_ws; a.pad = 0;
#if MK_ONE_LAUNCH
    a.ph_lo = 0; a.ph_hi = SEQ_END; a.use_bar = 1;
    hipLaunchKernelGGL(fwd_kernel, dim3(grid), dim3(NWAVES * 64), LDS_BYTES, stream, a);
#else
    a.use_bar = 0;
#ifndef MAXSEQ
#define MAXSEQ 1000
#ifndef PROBE_ATT_REPS
#define PROBE_ATT_REPS 1
#endif
#ifndef PROBE_QKV_REPS
#define PROBE_QKV_REPS 1
#endif
#ifndef PROBE_CONV_REPS
#define PROBE_CONV_REPS 1
#endif
#endif
    auto run = [&](int k) { if (k >= MAXSEQ) return; a.ph_lo = k; a.ph_hi = k + 1; hipLaunchKernelGGL(fwd_kernel, dim3(grid), dim3(NWAVES * 64), LDS_BYTES, stream, a); };
    run(0);
    for (int L = 0; L < DEPTH; ++L) {
        const int base = 1 + L * PH_PER_LAYER; const bool moe = (L & 1) != 0;
        for (int k = 0; k < 5; ++k) run(base + k);
        if (moe) { run(base + 5); for (int c = 0; c < NCHUNK; ++c) { run(base + 6 + 2 * c); run(base + 7 + 2 * c); } }
        else { run(base + 6); run(base + 7); }
    }
    run(SEQ_FINAL);
#endif
}
```

```cpp
#include <hip/hip_runtime.h>
#include <cstdio>
#include <cstdint>

#ifndef MK_ONE_LAUNCH
#define MK_ONE_LAUNCH 1
#endif
#define MAXSEQ 1000
#ifndef PROBE_ATT_REPS
#define PROBE_ATT_REPS 1
#endif
#ifndef PROBE_QKV_REPS
#define PROBE_QKV_REPS 1
#endif
#ifndef DENSE_UP8_MASK
#define DENSE_UP8_MASK 5
#endif
#ifndef DENSE_DN8_MASK
#define DENSE_DN8_MASK 5
#endif
#define DENSE_UP8(L) (((DENSE_UP8_MASK) >> (L)) & 1)
#define DENSE_DN8(L) (((DENSE_DN8_MASK) >> (L)) & 1)
#ifndef QKV_FP8
#define QKV_FP8 0
#endif
#ifndef PROBE_BAR2
#define PROBE_BAR2 0
#endif
#ifndef PROBE_PE2
#define PROBE_PE2 0
#endif
#ifndef PROBE_SAMPLE
#define PROBE_SAMPLE 0
#endif
#ifndef PROBE_CONV_REPS
#define PROBE_CONV_REPS 1
#endif

#define GAS __attribute__((address_space(1)))
#define LAS __attribute__((address_space(3)))
typedef unsigned short bf16;
typedef short bf16x8 __attribute__((ext_vector_type(8)));
typedef float f32x4 __attribute__((ext_vector_type(4)));
typedef float f32x2 __attribute__((ext_vector_type(2)));
typedef unsigned u32x4 __attribute__((ext_vector_type(4)));
typedef unsigned u32x2 __attribute__((ext_vector_type(2)));
typedef short v4i16_t __attribute__((ext_vector_type(4)));

constexpr int BATCH = 8, T = 8192, D = 1024, M = BATCH * T, DEPTH = 4;
constexpr int NQKV = 2560, FF = 3584, NE = 8, NMEM = 256, MROWS = BATCH * NMEM;
constexpr int OFF_QA = 0, OFF_KA = 384, OFF_VA = 768, OFF_QB = 1152, OFF_KB = 1536, OFF_VB = 1920, OFF_QM = 2304;
constexpr float RMS_EPS = 1e-6f;
constexpr float LOG2E = 1.4426950408889634f;
constexpr float QSCALE = 0.125f * LOG2E;
constexpr int XP = 2 * D;
constexpr int NWAVES = 8;
constexpr int MAXTILES = 520;
constexpr int CHUNK_TILES = 256;
constexpr int NCHUNK = 5;

constexpr size_t MiB = 1u << 20;
constexpr size_t WS_CTL = 0, CTL_ZERO_BYTES = 1 * MiB;
constexpr size_t WS_COS = 2 * MiB, WS_SIN = 2 * MiB + 256 * 1024;
constexpr size_t WS_E01 = 4 * MiB;
constexpr size_t WS_GATE = 4 * MiB + 256 * 1024;
constexpr size_t WS_POS = 5 * MiB;
constexpr size_t WS_TCNT = 6 * MiB;
constexpr size_t WS_TEXP = 6 * MiB + 64 * 1024;
constexpr size_t WS_SSQ = 8 * MiB;
constexpr size_t WS_WC = 16 * MiB, WC_STRIDE = 8 * MiB;
constexpr size_t WC_IN = 0, WC_MKV = 5 * MiB, WC_OUT = 6 * MiB;
constexpr size_t WS_WD = 48 * MiB, WD_STRIDE = 21 * MiB;
constexpr size_t WS_WM = 90 * MiB, WM_STRIDE = 112 * MiB;
constexpr size_t WM_DOWN = 56 * MiB;
constexpr size_t WS_HB = 314 * MiB;
constexpr size_t WS_BIG = 442 * MiB;
constexpr size_t WS_GA = WS_BIG, WS_HIDC = WS_BIG + 260 * MiB;
constexpr size_t WS_GA8 = 926 * MiB;
constexpr size_t WS_MEMN4 = 1056 * MiB;
constexpr size_t WS_MEMKV4 = 1072 * MiB;
constexpr size_t WS_END = 1080 * MiB;
static_assert(WS_HIDC + (size_t)CHUNK_TILES * 256 * FF <= WS_GA8 && WS_BIG + (size_t)M * FF * 2 <= WS_GA8 && WS_GA8 + (size_t)MAXTILES * 256 * D <= WS_END, "ws map");
constexpr float A8_SCALE = 32.0f, W8_SCALE = 1024.0f, ACC8_SCALE = 1.0f / 32768.0f;
constexpr float H8_SCALE = 16.0f, WD8_SCALE = 4096.0f, ACCD8_SCALE = 1.0f / 65536.0f;
constexpr size_t WD8_ESTRIDE = (size_t)D * FF;

constexpr int CW_TMO = 0, CW_CODE = 1, CW_BAR = 4096;

constexpr int RING_BYTES = 131072;
constexpr int MISC_OFF = 139264;
constexpr int LDS_BYTES = 155648;
constexpr int MISC_BARW = 0;
constexpr int MISC_TEXP = 64;
constexpr int MISC_PTAB = 2560;
constexpr int MISC_SCR = 4096;

__device__ __forceinline__ float vmax2(float a, float b) { return __builtin_amdgcn_fmed3f(a, b, INFINITY); }
__device__ __forceinline__ float vmax3(float a, float b, float c) { return vmax2(vmax2(a, b), c); }
__device__ __forceinline__ float clamp8(float x) { return __builtin_amdgcn_fmed3f(x, -448.0f, 448.0f); }
__device__ __forceinline__ unsigned cvt4_fp8(float a, float b, float c, float d) {
    unsigned w = 0; w = __builtin_amdgcn_cvt_pk_fp8_f32(clamp8(a), clamp8(b), w, false); w = __builtin_amdgcn_cvt_pk_fp8_f32(clamp8(c), clamp8(d), w, true); return w; }
namespace pg8 {
#define PG8_LAS __attribute__((address_space(3)))
typedef unsigned short bf16_t;
constexpr int BM = 256, BK = 64, HALF = 128, HTB = HALF * BK * 2, STAGE_BYTES = 8 * HTB, NXCD = 8, WGM = 8;

__host__ __device__ __forceinline__ int lds_byte(int r, int c) { const int st = (r >> 4) * 2 + (c >> 5), rr = r & 15, cc = c & 31, ob = rr * 64 + cc * 2; return st * 1024 + (ob ^ (((ob >> 9) & 1) << 5)); }
__host__ __device__ __forceinline__ void stage_rc(int b, int& R, int& C) { const int st = b / 1024, sb = b % 1024, swz = sb ^ (((sb >> 9) & 1) << 5); R = (st >> 1) * 16 + swz / 64; C = (st & 1) * 32 + (swz % 64) / 2; }
__host__ __device__ __forceinline__ int perm32(int rho) { const int n = rho >> 4, i = rho & 15; return 8 * (i >> 2) + 4 * n + (i & 3); }

struct Unit { int pm, pn, e; };
struct Gemm { const bf16_t* A; const bf16_t* Bt; int M, N, K; size_t estride; };

struct TileOrder {
    int nM, nN, nwg, G, c; const PG8_LAS int* texp;
    __device__ void init(int Mr, int N, int G_, int c_, const PG8_LAS int* texp_) { nM = Mr / BM; nN = N / BM; nwg = nM * nN; G = G_; c = c_; texp = texp_; }
    __device__ bool next(int i, Unit& u) const {
        const long L = (long)i * G + c; if (L >= nwg) return false;
        int wgid = (int)L; { const int q = nwg / NXCD, r = nwg % NXCD, xcd = wgid % NXCD, off = wgid / NXCD; wgid = (xcd < r ? xcd * (q + 1) : r * (q + 1) + (xcd - r) * q) + off; }
        const int nig = WGM * nN, gid = wgid / nig, fm = gid * WGM, gsz = (nM - fm) < WGM ? (nM - fm) : WGM;
        u.pm = fm + ((wgid % nig) % gsz); u.pn = (wgid % nig) / gsz; u.e = texp ? __builtin_amdgcn_readfirstlane(texp[u.pm]) : 0; return true;
    }
};

struct TileOrderSkew : TileOrder {
    int nsk, kd, per;
    __device__ bool next(int i, Unit& u) const {
        int cc = c, ii = i;
        if (nsk > 0) {
            if (c < nsk) { if (i >= per - kd) return false; }
            else if (i == per) { const int S = (nsk + 7) & ~7, j = c / S - 1, c2 = c % S; if (c < S || j >= kd || c2 >= nsk) return false; cc = c2; ii = per - kd + j; }
            else if (i > per) return false;
        }
        const long L = (long)ii * G + cc; if (L >= nwg) return false;
        int wgid = (int)L; { const int q = nwg / NXCD, r = nwg % NXCD, xcd = wgid % NXCD, off = wgid / NXCD; wgid = (xcd < r ? xcd * (q + 1) : r * (q + 1) + (xcd - r) * q) + off; }
        const int nig = WGM * nN, gid = wgid / nig, fm = gid * WGM, gsz = (nM - fm) < WGM ? (nM - fm) : WGM;
        u.pm = fm + ((wgid % nig) % gsz); u.pn = (wgid % nig) / gsz; u.e = texp ? __builtin_amdgcn_readfirstlane(texp[u.pm]) : 0; return true;
    }
};

typedef int i32x8 __attribute__((ext_vector_type(8)));
typedef int i32x4 __attribute__((ext_vector_type(4)));
__device__ __forceinline__ i32x8 cat8(bf16x8 a, bf16x8 b) { const i32x4 x = __builtin_bit_cast(i32x4, a), y = __builtin_bit_cast(i32x4, b); return __builtin_shufflevector(x, y, 0, 1, 2, 3, 4, 5, 6, 7); }
__device__ __forceinline__ void mfma8(f32x4& acc, const i32x8 a, const i32x8 b) { int sc = 0x7f7f7f7f;
    asm volatile("v_mfma_scale_f32_16x16x128_f8f6f4 %0, %1, %2, %0, %3, %3 op_sel_hi:[0,0,0]" : "+v"(acc) : "v"(a), "v"(b), "v"(sc)); }
__device__ __forceinline__ unsigned cvt_pk_bf16(float lo, float hi) { unsigned r; asm volatile("v_cvt_pk_bf16_f32 %0, %1, %2" : "=v"(r) : "v"(lo), "v"(hi)); return r; }


struct EpiPlain {
    static constexpr bool PERM = true, FP8 = false; static constexpr int LDA = 0;
    bf16_t* O; int ldc;
    __device__ __forceinline__ void operator()(const f32x4 (&acc)[2][2][4][2], const Unit& u, int wr, int wc, int fr, int fq) const {
        const int row0 = u.pm * BM + wr * 64 + fr, col0 = u.pn * BM + wc * 32 + 8 * fq;
#pragma unroll
        for (int ai = 0; ai < 2; ++ai)
#pragma unroll
            for (int m = 0; m < 4; ++m) { bf16_t* rowp = O + (size_t)(row0 + ai * HALF + m * 16) * ldc + col0;
#pragma unroll
                for (int bj = 0; bj < 2; ++bj) { const f32x4 v0 = acc[ai][bj][m][0], v1 = acc[ai][bj][m][1];
                    u32x4 w; w.x = cvt_pk_bf16(v0[0], v0[1]); w.y = cvt_pk_bf16(v0[2], v0[3]); w.z = cvt_pk_bf16(v1[0], v1[1]); w.w = cvt_pk_bf16(v1[2], v1[3]);
                    *(u32x4*)(rowp + bj * HALF) = w; } }
    }
};
template <bool F8> struct EpiQKVT {
    static constexpr bool PERM = true, FP8 = F8; static constexpr int LDA = F8 ? 0 : XP;
    bf16_t* O; const float* cosT; const float* sinT; float insc;
    const float* ssq; int npart;
    __device__ __forceinline__ void operator()(const f32x4 (&acc)[2][2][4][2], const Unit& u, int wr, int wc, int fr, int fq) const {
        const int row0 = u.pm * BM + wr * 64 + fr, col0 = u.pn * BM + wc * 32 + 8 * fq;
        const bool lane_rot = ((wc & 1) == 0) && (fq < 2);
        float rsv[2][4];
        if (npart) {
            f32x4 pp[2][4];
#pragma unroll
            for (int ai = 0; ai < 2; ++ai)
#pragma unroll
                for (int m = 0; m < 4; ++m) pp[ai][m] = *(const f32x4*)(ssq + (size_t)(row0 + ai * HALF + m * 16) * 16 + 4 * fq);
#pragma unroll
            for (int ai = 0; ai < 2; ++ai)
#pragma unroll
                for (int m = 0; m < 4; ++m) { float sq = (pp[ai][m][0] + pp[ai][m][1]) + (pp[ai][m][2] + pp[ai][m][3]); sq += __shfl_xor(sq, 16); sq += __shfl_xor(sq, 32);
                    rsv[ai][m] = insc * __builtin_amdgcn_rsqf(sq * (1.0f / D) + RMS_EPS); }
        } else {
#pragma unroll
            for (int ai = 0; ai < 2; ++ai)
#pragma unroll
                for (int m = 0; m < 4; ++m) rsv[ai][m] = insc;
        }
        const bool anyrot = (u.pn >= 4) && (u.pn <= 7);
#pragma unroll
        for (int ai = 0; ai < 2; ++ai) {
            f32x4 rc[4], rn[4];
#pragma unroll
            for (int m = 0; m < 4; ++m) { rc[m] = (f32x4){0.f, 0.f, 0.f, 0.f}; rn[m] = rc[m]; }
            if (anyrot) {
#pragma unroll
                for (int m = 0; m < 4; ++m) { const int t = (row0 + ai * HALF + m * 16) & (T - 1); rc[m] = *(const f32x4*)(cosT + t * 8 + 4 * (fq & 1)); rn[m] = *(const f32x4*)(sinT + t * 8 + 4 * (fq & 1)); }
            }
#pragma unroll
            for (int m = 0; m < 4; ++m) {
                const int row = row0 + ai * HALF + m * 16;
                const float rs = rsv[ai][m];
#pragma unroll
                for (int bj = 0; bj < 2; ++bj) {
                    const int idx = 2 * u.pn + bj;
                    const float sc = ((idx < 3 || (idx >= 9 && idx < 12) || idx >= 18) ? QSCALE : 1.0f) * rs;
                    const bool rot = (idx >= 9 && idx < 15) && lane_rot;
                    f32x4 v0 = acc[ai][bj][m][0] * sc, v1 = acc[ai][bj][m][1] * sc;
                    if (rot) {
                        const f32x4 c = rc[m], s = rn[m];
                        f32x4 a, b;
                        a[0] = v0[0] * c[0] - v0[1] * s[0]; a[1] = v0[1] * c[0] + v0[0] * s[0];
                        a[2] = v0[2] * c[1] - v0[3] * s[1]; a[3] = v0[3] * c[1] + v0[2] * s[1];
                        b[0] = v1[0] * c[2] - v1[1] * s[2]; b[1] = v1[1] * c[2] + v1[0] * s[2];
                        b[2] = v1[2] * c[3] - v1[3] * s[3]; b[3] = v1[3] * c[3] + v1[2] * s[3];
                        v0 = a; v1 = b;
                    }
                    u32x4 w; w.x = cvt_pk_bf16(v0[0], v0[1]); w.y = cvt_pk_bf16(v0[2], v0[3]); w.z = cvt_pk_bf16(v1[0], v1[1]); w.w = cvt_pk_bf16(v1[2], v1[3]);
                    *(u32x4*)(O + (size_t)row * NQKV + col0 + bj * HALF) = w;
                }
            }
        }
    }
};
template <bool F8> struct EpiSwigluT {
    static constexpr bool PERM = true, FP8 = F8; static constexpr int LDA = 0;
    bf16_t* O; float insc; int out_bf16;
    __device__ __forceinline__ void operator()(const f32x4 (&acc)[2][2][4][2], const Unit& u, int wr, int wc, int fr, int fq) const {
        const int row0 = u.pm * BM + wr * 64 + fr, col0 = u.pn * HALF + wc * 32 + 8 * fq;
#pragma unroll
        for (int ai = 0; ai < 2; ++ai)
#pragma unroll
            for (int m = 0; m < 4; ++m) {
                float h[8];
#pragma unroll
                for (int n = 0; n < 2; ++n)
#pragma unroll
                    for (int j = 0; j < 4; ++j) { const float g = acc[ai][0][m][n][j] * insc, up = acc[ai][1][m][n][j] * insc;
                        const float sg = g * __builtin_amdgcn_rcpf(1.0f + __builtin_amdgcn_exp2f(-g * LOG2E)); h[4 * n + j] = sg * up; }
                if (F8 && !out_bf16) {
                    u32x2 w; w.x = cvt4_fp8(h[0] * H8_SCALE, h[1] * H8_SCALE, h[2] * H8_SCALE, h[3] * H8_SCALE); w.y = cvt4_fp8(h[4] * H8_SCALE, h[5] * H8_SCALE, h[6] * H8_SCALE, h[7] * H8_SCALE);
                    *(u32x2*)((unsigned char*)O + (size_t)(row0 + ai * HALF + m * 16) * FF + col0) = w;
                } else {
                    u32x4 w; w.x = cvt_pk_bf16(h[0], h[1]); w.y = cvt_pk_bf16(h[2], h[3]); w.z = cvt_pk_bf16(h[4], h[5]); w.w = cvt_pk_bf16(h[6], h[7]);
                    *(u32x4*)(O + (size_t)(row0 + ai * HALF + m * 16) * FF + col0) = w;
                }
            }
    }
};
template <bool F8> struct EpiResT {
    static constexpr bool PERM = true, FP8 = F8; static constexpr int LDA = 0;
    const float* src; bf16_t* xbf; bf16_t* ob; int ldc; int as_bf16; float insc;
    __device__ __forceinline__ void operator()(const f32x4 (&acc)[2][2][4][2], const Unit& u, int wr, int wc, int fr, int fq) const {
        const int row0 = u.pm * BM + wr * 64 + fr, col0 = u.pn * BM + wc * 32 + 8 * fq;
        float* ssqp = nullptr;
        if (as_bf16 == 2) {
            extern __shared__ __attribute__((aligned(16))) unsigned char lds_epi[];
            const unsigned long long v = ((const PG8_LAS unsigned long long*)((PG8_LAS unsigned char*)lds_epi + MISC_OFF + MISC_PTAB))[18];
            const unsigned lo = __builtin_amdgcn_readfirstlane((unsigned)v), hi = __builtin_amdgcn_readfirstlane((unsigned)(v >> 32));
            ssqp = (float*)((unsigned char*)(((unsigned long long)hi << 32) | lo) + WS_SSQ); }
        if (as_bf16 == 1) {
#pragma unroll
            for (int ai = 0; ai < 2; ++ai)
#pragma unroll
                for (int m = 0; m < 4; ++m) { bf16_t* rowp = ob + (size_t)(row0 + ai * HALF + m * 16) * ldc + col0;
#pragma unroll
                    for (int bj = 0; bj < 2; ++bj) { const f32x4 v0 = acc[ai][bj][m][0] * insc, v1 = acc[ai][bj][m][1] * insc;
                        u32x4 w; w.x = cvt_pk_bf16(v0[0], v0[1]); w.y = cvt_pk_bf16(v0[2], v0[3]); w.z = cvt_pk_bf16(v1[0], v1[1]); w.w = cvt_pk_bf16(v1[2], v1[3]); *(u32x4*)(rowp + bj * HALF) = w; } }
        } else {
#pragma unroll
            for (int ai = 0; ai < 2; ++ai) {
                u32x4 rw[4][2];
#pragma unroll
                for (int m = 0; m < 4; ++m)
#pragma unroll
                    for (int bj = 0; bj < 2; ++bj) rw[m][bj] = *(const u32x4*)(xbf + (size_t)(row0 + ai * HALF + m * 16) * XP + col0 + bj * HALF);
#pragma unroll
                for (int m = 0; m < 4; ++m) { const size_t xoff = (size_t)(row0 + ai * HALF + m * 16) * XP + col0; float ss = 0.f;
#pragma unroll
                    for (int bj = 0; bj < 2; ++bj) { const u32x4 r = rw[m][bj];
                        const f32x4 b0 = (f32x4){__builtin_bit_cast(float, r.x << 16), __builtin_bit_cast(float, r.x & 0xffff0000u), __builtin_bit_cast(float, r.y << 16), __builtin_bit_cast(float, r.y & 0xffff0000u)};
                        const f32x4 b1 = (f32x4){__builtin_bit_cast(float, r.z << 16), __builtin_bit_cast(float, r.z & 0xffff0000u), __builtin_bit_cast(float, r.w << 16), __builtin_bit_cast(float, r.w & 0xffff0000u)};
                        const f32x4 x0 = b0 + acc[ai][bj][m][0] * insc, x1 = b1 + acc[ai][bj][m][1] * insc;
                        ss += ((x0[0] * x0[0] + x0[1] * x0[1]) + (x0[2] * x0[2] + x0[3] * x0[3])) + ((x1[0] * x1[0] + x1[1] * x1[1]) + (x1[2] * x1[2] + x1[3] * x1[3]));
                        u32x4 w; w.x = cvt_pk_bf16(x0[0], x0[1]); w.y = cvt_pk_bf16(x0[2], x0[3]); w.z = cvt_pk_bf16(x1[0], x1[1]); w.w = cvt_pk_bf16(x1[2], x1[3]);
                        *(u32x4*)(xbf + xoff + bj * HALF) = w; }
                    if (ssqp) { ss += __shfl_xor(ss, 16); ss += __shfl_xor(ss, 32); if (fq == 0) ssqp[(size_t)(row0 + ai * HALF + m * 16) * 16 + 4 * u.pn + wc] = ss; } }
                asm volatile("" ::: "memory");
            }
        }
    }
};

template <class Epi, class Sched>
__device__ __forceinline__ void gemm_phase(PG8_LAS unsigned char* lds, const Gemm g, const Sched& S, const Epi& E, const int tid) {
    const int wid = __builtin_amdgcn_readfirstlane(tid >> 6), lane = tid & 63, wr = wid >> 2, wc = wid & 3, fr = lane & 15, fq = lane >> 4;
    const int K = g.K, nt = K / BK;
    const int LDA_ = Epi::LDA ? Epi::LDA : K;
    unsigned voffA[2], voffB[2];
#pragma unroll
    for (int i = 0; i < 2; ++i) { int R, C; stage_rc(tid * 16 + i * 8192, R, C); const int Rb = Epi::PERM ? ((R & ~31) + perm32(R & 31)) : R;
        voffA[i] = (unsigned)(R * LDA_ + C) * 2u; voffB[i] = (unsigned)(Rb * K + C) * 2u; }
    const size_t kstep = (size_t)(BK * 2);
    const size_t hstep = (size_t)HALF * K * 2;
    const size_t tstep = 2 * hstep;
    const size_t hstepA = (size_t)HALF * LDA_ * 2, tstepA = 2 * hstepA;
    const unsigned ldsw = (unsigned)wid * 1024u;
    const int aoff = lds_byte(wr * 64 + fr, fq * 8), boff = lds_byte(wc * 32 + fr, fq * 8);
#define PG8_SA(b, h) (((b) * 2 + (h)) * HTB)
#define PG8_SB(b, h) ((4 + (b) * 2 + (h)) * HTB)
#define PG8_STAGE(bufoff, gbase, voff) do { _Pragma("unroll") for (int _i = 0; _i < 2; ++_i) \
        __builtin_amdgcn_global_load_lds((const unsigned*)((const char*)(gbase) + (voff)[_i]), (PG8_LAS unsigned*)(lds + (bufoff) + ldsw + _i * 8192), 16, 0, 0); } while (0)
#define PG8_LDA(dst, b, h) do { _Pragma("unroll") for (int m = 0; m < 4; ++m) _Pragma("unroll") for (int k = 0; k < 2; ++k) dst[m][k] = *(const PG8_LAS bf16x8*)(lds + PG8_SA(b, h) + aoff + m * 2048 + k * 1024); } while (0)
#define PG8_LDB(dst, b, h) do { _Pragma("unroll") for (int n = 0; n < 2; ++n) _Pragma("unroll") for (int k = 0; k < 2; ++k) dst[n][k] = *(const PG8_LAS bf16x8*)(lds + PG8_SB(b, h) + boff + n * 2048 + k * 1024); } while (0)
#define PG8_MMA(ai, bj, At, Bt) do { __builtin_amdgcn_s_setprio(1); \
        if constexpr (Epi::FP8) { _Pragma("unroll") for (int m = 0; m < 4; ++m) _Pragma("unroll") for (int n = 0; n < 2; ++n) \
            mfma8(acc[ai][bj][m][n], cat8(Bt[n][0], Bt[n][1]), cat8(At[m][0], At[m][1])); } \
        else { _Pragma("unroll") for (int m = 0; m < 4; ++m) _Pragma("unroll") for (int n = 0; n < 2; ++n) _Pragma("unroll") for (int k = 0; k < 2; ++k) \
            acc[ai][bj][m][n] = __builtin_amdgcn_mfma_f32_16x16x32_bf16(Bt[n][k], At[m][k], acc[ai][bj][m][n], 0, 0, 0); } \
        __builtin_amdgcn_s_setprio(0); } while (0)
#define PG8_WAIT_V(n) asm volatile("s_waitcnt vmcnt(" #n ")" ::: "memory")
#define PG8_WAIT_L(n) asm volatile("s_waitcnt lgkmcnt(" #n ")" ::: "memory")
#define PG8_BAR __builtin_amdgcn_s_barrier()
#define PG8_SCHED __builtin_amdgcn_sched_barrier(0)
    Unit cur, nxt; int ui = 0;
    if (!S.next(0, cur)) return;
    f32x4 acc[2][2][4][2];
#pragma unroll
    for (int a = 0; a < 2; ++a)
#pragma unroll
        for (int b = 0; b < 2; ++b)
#pragma unroll
            for (int m = 0; m < 4; ++m)
#pragma unroll
                for (int n = 0; n < 2; ++n) acc[a][b][m][n] = (f32x4){0.f, 0.f, 0.f, 0.f};
    bf16x8 At[4][2], B0[2][2], B1[2][2];
    const char* cA = (const char*)g.A + (size_t)cur.pm * tstepA; const char* cB = (const char*)g.Bt + (size_t)cur.e * g.estride + (size_t)cur.pn * tstep;
    PG8_STAGE(PG8_SB(0, 0), cB, voffB); PG8_STAGE(PG8_SB(0, 1), cB + hstep, voffB); PG8_STAGE(PG8_SA(0, 0), cA, voffA); PG8_STAGE(PG8_SA(0, 1), cA + hstepA, voffA);
    if (wr == 1) PG8_BAR;
    PG8_WAIT_V(2); PG8_BAR;
    PG8_STAGE(PG8_SB(1, 0), cB + kstep, voffB); PG8_STAGE(PG8_SA(1, 0), cA + kstep, voffA); PG8_STAGE(PG8_SB(1, 1), cB + hstep + kstep, voffB);
    PG8_WAIT_V(6); PG8_BAR;
    for (;;) {
        const bool has_next = S.next(ui + 1, nxt);
        const char* nA = has_next ? (const char*)g.A + (size_t)nxt.pm * tstepA : cA; const char* nB = has_next ? (const char*)g.Bt + (size_t)nxt.e * g.estride + (size_t)nxt.pn * tstep : cB;
        for (int t = 0; t < nt; t += 2) {
            const bool last = (t == nt - 2);
            const char* a1 = cA + (size_t)(t + 1) * kstep;
            const char* a2 = last ? nA : cA + (size_t)(t + 2) * kstep; const char* b2 = last ? nB : cB + (size_t)(t + 2) * kstep;
            const char* a3 = a2 + kstep; const char* b3 = b2 + kstep;
            PG8_LDB(B0, 0, 0); PG8_LDB(B1, 0, 1); PG8_SCHED; PG8_LDA(At, 0, 0); PG8_STAGE(PG8_SA(1, 1), a1 + hstepA, voffA);
            PG8_WAIT_V(8); PG8_WAIT_L(0); PG8_BAR; PG8_MMA(0, 0, At, B0); PG8_MMA(0, 1, At, B1); PG8_BAR; PG8_SCHED;
            PG8_LDA(At, 0, 1); PG8_STAGE(PG8_SB(0, 0), b2, voffB); PG8_STAGE(PG8_SB(0, 1), b2 + hstep, voffB); PG8_STAGE(PG8_SA(0, 0), a2, voffA);
            PG8_WAIT_V(8); PG8_WAIT_L(0); PG8_BAR; PG8_MMA(1, 0, At, B0); PG8_MMA(1, 1, At, B1); PG8_BAR; PG8_SCHED;
            PG8_LDB(B0, 1, 0); PG8_LDB(B1, 1, 1); PG8_SCHED; PG8_LDA(At, 1, 0); PG8_STAGE(PG8_SA(0, 1), a2 + hstepA, voffA);
            PG8_WAIT_V(8); PG8_WAIT_L(0); PG8_BAR; PG8_MMA(0, 0, At, B0); PG8_MMA(0, 1, At, B1); PG8_BAR; PG8_SCHED;
            PG8_LDA(At, 1, 1); PG8_STAGE(PG8_SB(1, 0), b3, voffB); PG8_STAGE(PG8_SB(1, 1), b3 + hstep, voffB); PG8_STAGE(PG8_SA(1, 0), a3, voffA);
            PG8_WAIT_V(8); PG8_WAIT_L(0); PG8_BAR; PG8_MMA(1, 0, At, B0); PG8_MMA(1, 1, At, B1); PG8_BAR; PG8_SCHED;
        }
        if (wr == 0) PG8_BAR;
        if constexpr (Epi::FP8) {
#pragma unroll
            for (int a = 0; a < 2; ++a)
#pragma unroll
                for (int b = 0; b < 2; ++b)
                    asm volatile("s_nop 15\n\ts_nop 15" : "+v"(acc[a][b][0][0]), "+v"(acc[a][b][0][1]), "+v"(acc[a][b][1][0]), "+v"(acc[a][b][1][1]), "+v"(acc[a][b][2][0]), "+v"(acc[a][b][2][1]), "+v"(acc[a][b][3][0]), "+v"(acc[a][b][3][1]));
        }
        E(acc, cur, wr, wc, fr, fq);
        if (!has_next) break;
#pragma unroll
        for (int a = 0; a < 2; ++a)
#pragma unroll
            for (int b = 0; b < 2; ++b)
#pragma unroll
                for (int m = 0; m < 4; ++m)
#pragma unroll
                    for (int n = 0; n < 2; ++n) acc[a][b][m][n] = (f32x4){0.f, 0.f, 0.f, 0.f};
        cur = nxt; cA = nA; cB = nB; ++ui;
        if (wr == 1) PG8_BAR;
    }
    PG8_WAIT_V(0);
    PG8_BAR;
#undef PG8_SA
#undef PG8_SB
#undef PG8_STAGE
#undef PG8_LDA
#undef PG8_LDB
#undef PG8_MMA
#undef PG8_WAIT_V
#undef PG8_WAIT_L
#undef PG8_BAR
#undef PG8_SCHED
}
}

typedef GAS unsigned gu32;
#define RLX_AGENT __ATOMIC_RELAXED, __HIP_MEMORY_SCOPE_AGENT
#define LDS_WAIT() asm volatile("s_waitcnt lgkmcnt(0)" ::: "memory")
#define VM_WAIT() asm volatile("s_waitcnt vmcnt(0)" ::: "memory")
__device__ __forceinline__ unsigned f2bf(float f) { unsigned u = __builtin_bit_cast(unsigned, f); return (u + 0x7fffu + ((u >> 16) & 1u)) >> 16; }
__device__ __forceinline__ unsigned pk2(float lo, float hi) { return f2bf(lo) | (f2bf(hi) << 16); }
__device__ __forceinline__ float bf_lo(unsigned w) { return __builtin_bit_cast(float, w << 16); }
__device__ __forceinline__ float bf_hi(unsigned w) { return __builtin_bit_cast(float, w & 0xffff0000u); }

#define XB_TMO      128
#define XB_XCNT(j)  (256  + 64 * (j))
#define XB_XSUB(j)  (1280 + 64 * (j))
#define XB_XGEN(j)  (2304 + 64 * (j))
#define XB_TOP      3328
#define XB_TOPGEN   3392
#define XCD_BAR_WORDS 3456
#define XB_SPIN_CAP (1u << 18)

__device__ __forceinline__ unsigned xb_ld(unsigned* p)              { return __hip_atomic_load(p, __ATOMIC_RELAXED, __HIP_MEMORY_SCOPE_AGENT); }
__device__ __forceinline__ unsigned xb_add(unsigned* p, unsigned v) { return __hip_atomic_fetch_add(p, v, __ATOMIC_RELAXED, __HIP_MEMORY_SCOPE_AGENT); }
__device__ __forceinline__ unsigned xb_xcc_id() { return (unsigned)__builtin_amdgcn_s_getreg((3 << 11) | 20) & 0xFu; }
#define XB_SPIN(cond, bar) do { unsigned _sp = 0; while (cond) { __builtin_amdgcn_s_sleep(1); \
    if ((++_sp & 255u) == 0u) { if (xb_ld(&(bar)[XB_TMO])) break; if (_sp > XB_SPIN_CAP) { atomicAdd(&(bar)[XB_TMO], 1u); break; } } } } while (0)

struct XcdBarrier { unsigned* bar; unsigned x; volatile LAS unsigned* st; };

__device__ __forceinline__ XcdBarrier xcd_barrier_post(unsigned* bar, volatile LAS unsigned* st) {
    XcdBarrier b; b.bar = bar; b.x = xb_xcc_id(); b.st = st;
    if (threadIdx.x == 0) (void)xb_add(&bar[XB_XCNT(b.x)], 1u);
    return b;
}
__device__ __forceinline__ void xcd_barrier_complete(unsigned* bar, unsigned x, unsigned& nloc, unsigned& nx) {
    const unsigned G = gridDim.x * gridDim.y * gridDim.z;
    unsigned sum, cnt, mine, sp = 0u;
    for (;;) {
        sum = 0u; cnt = 0u; mine = 0u;
#pragma unroll
        for (unsigned j = 0; j < 16; ++j) { const unsigned c = xb_ld(&bar[XB_XCNT(j)]); sum += c; cnt += (c > 0u) ? 1u : 0u; mine = (j == x) ? c : mine; }
        if (sum == G) break;
        __builtin_amdgcn_s_sleep(1);
        if ((++sp & 255u) == 0u) { if (xb_ld(&bar[XB_TMO])) break; if (sp > XB_SPIN_CAP) { atomicAdd(&bar[XB_TMO], 1u); break; } }
    }
    nloc = mine > 0u ? mine : 1u; nx = cnt > 0u ? cnt : 1u;
}
__device__ __forceinline__ void xcd_barrier(const XcdBarrier& b) {
    asm volatile("s_waitcnt vmcnt(0)" ::: "memory");
    __syncthreads();
    if (threadIdx.x == 0) {
        unsigned* bar = b.bar;
        __builtin_amdgcn_s_waitcnt(0);
        unsigned nloc = b.st[0], nx = b.st[1];
        if (nloc == 0u) { xcd_barrier_complete(bar, b.x, nloc, nx); b.st[0] = nloc; b.st[1] = nx; }
        const unsigned old = xb_add(&bar[XB_XSUB(b.x)], 1u);
        const unsigned gen = old / nloc;
        if (old + 1u == (gen + 1u) * nloc) {
            __builtin_amdgcn_fence(__ATOMIC_RELEASE, "agent");
            asm volatile("s_waitcnt vmcnt(0)" ::: "memory");
            const unsigned og = xb_add(&bar[XB_TOP], 1u);
            const unsigned tg = og / nx;
            if (og + 1u == (tg + 1u) * nx) xb_add(&bar[XB_TOPGEN], 1u);
            else XB_SPIN(xb_ld(&bar[XB_TOPGEN]) == tg, bar);
            __builtin_amdgcn_fence(__ATOMIC_ACQUIRE, "agent");
            xb_add(&bar[XB_XGEN(b.x)], 1u);
            asm volatile("s_waitcnt vmcnt(0)" ::: "memory");
        } else {
            XB_SPIN(xb_ld(&bar[XB_XGEN(b.x)]) == gen, bar);
            __builtin_amdgcn_fence(__ATOMIC_ACQUIRE, "agent");
            asm volatile("s_waitcnt vmcnt(0)" ::: "memory");
        }
    }
    __syncthreads();
}

struct Frame {
    LAS unsigned char* lds;
    LAS unsigned char* misc;
    unsigned char* ws;
    int tid, lane, wave, G, bx;
    float* out;
};
__device__ __forceinline__ const float* inp_ptr(LAS unsigned char* misc, int i) {
    const unsigned long long v = ((const LAS unsigned long long*)(misc + MISC_PTAB))[i];
    const unsigned lo = __builtin_amdgcn_readfirstlane((unsigned)v), hi = __builtin_amdgcn_readfirstlane((unsigned)(v >> 32));
    return (const float*)(GAS const float*)(((unsigned long long)hi << 32) | lo);
}
#define INP(i) inp_ptr(F.misc, (i))

__device__ __forceinline__ void lds_add(LAS int* p, int v) { (void)__hip_atomic_fetch_add(p, v, __ATOMIC_RELAXED, __HIP_MEMORY_SCOPE_WORKGROUP); }
__device__ __forceinline__ float wave_sum(float v) {
#pragma unroll
    for (int o = 1; o < 64; o <<= 1) v += __shfl_xor(v, o);
    return v;
}

__device__ __forceinline__ int map_row(int n, int mode) {
    if (mode == 1) { if (n >= OFF_QB && n < OFF_VB) { const int d = (n - OFF_QB) & 63; if (d < 16) { const int dn = d < 8 ? 2 * d : 2 * (d - 8) + 1; return n - d + dn; } } return n; }
    if (mode == 2) return ((n >> 7) << 8) + (n & 127);
    if (mode == 3) return ((n >> 7) << 8) + 128 + (n & 127);
    return n;
}
template <bool F8>
__device__ __forceinline__ void convert_mat(const float* W, int K, int N, unsigned char* WT, int mode, float wscale, int& base, int gw, int NGW, int lane, const float* kgain = nullptr) {
    constexpr int KI = F8 ? 128 : 64;
    const int nblk = N >> 6, nitems = (K / KI) * nblk;
    int r = gw - (base % NGW); if (r < 0) r += NGW;
    base += nitems;
    const int q = lane >> 4, c4 = lane & 15;
#pragma nounroll
    for (; r < nitems; r += NGW) {
        const int kb = r / nblk, nb = r - kb * nblk, k0 = kb * KI, n = nb * 64 + 4 * c4;
        const GAS float* src = (const GAS float*)W + (size_t)k0 * N + n;
        size_t drow[4];
#pragma unroll
        for (int c = 0; c < 4; ++c) drow[c] = (size_t)map_row(n + c, mode) * K + k0;
#pragma nounroll
        for (int sgm = 0; sgm < 2; ++sgm) {
            f32x4 v[16];
            if (F8) {
                const int kq = 64 * sgm + 16 * q;
#pragma unroll
                for (int j = 0; j < 16; ++j) v[j] = __builtin_nontemporal_load((const GAS f32x4*)(src + (size_t)(kq + j) * N)) * wscale;
#pragma unroll
                for (int c = 0; c < 4; ++c) { u32x4 o; o.x = cvt4_fp8(v[0][c], v[1][c], v[2][c], v[3][c]); o.y = cvt4_fp8(v[4][c], v[5][c], v[6][c], v[7][c]);
                    o.z = cvt4_fp8(v[8][c], v[9][c], v[10][c], v[11][c]); o.w = cvt4_fp8(v[12][c], v[13][c], v[14][c], v[15][c]);
                    *(GAS u32x4*)(WT + drow[c] + kq) = o; }
            } else {
                const int kq = 32 * sgm + 8 * q;
#pragma unroll
                for (int j = 0; j < 8; ++j) v[j] = __builtin_nontemporal_load((const GAS f32x4*)(src + (size_t)(kq + j) * N));
                if (kgain) {
#pragma unroll
                    for (int j = 0; j < 8; ++j) v[j] = v[j] * kgain[k0 + kq + j]; }
#pragma unroll
                for (int c = 0; c < 4; ++c) { u32x4 o; o.x = pk2(v[0][c], v[1][c]); o.y = pk2(v[2][c], v[3][c]); o.z = pk2(v[4][c], v[5][c]); o.w = pk2(v[6][c], v[7][c]);
                    *(GAS u32x4*)((bf16*)WT + drow[c] + kq) = o; }
            }
        }
    }
}
__device__ __forceinline__ void phase_convert(Frame& F) {
    const int gw = F.bx * NWAVES + F.wave, NGW = F.G * NWAVES;
    int base = 0;
#pragma nounroll
    for (int L = 0; L < DEPTH; ++L) { unsigned char* wc = F.ws + WS_WC + (size_t)L * WC_STRIDE;
#if QKV_FP8
        convert_mat<true>(INP(3) + (size_t)L * D * NQKV, D, NQKV, wc + WC_IN, 1, W8_SCALE, base, gw, NGW, F.lane);
#else
        convert_mat<false>(INP(3) + (size_t)L * D * NQKV, D, NQKV, wc + WC_IN, 1, 1.0f, base, gw, NGW, F.lane, INP(2) + (size_t)L * D);
#endif
        convert_mat<false>(INP(6) + (size_t)L * D * 512, D, 512, wc + WC_MKV, 0, 1.0f, base, gw, NGW, F.lane);
        convert_mat<false>(INP(8) + (size_t)L * D * D, D, D, wc + WC_OUT, 0, 1.0f, base, gw, NGW, F.lane); }
#pragma nounroll
    for (int i = 0; i < 2; ++i) { unsigned char* wd = F.ws + WS_WD + (size_t)i * WD_STRIDE;
        if (DENSE_UP8(2 * i)) { convert_mat<true>(INP(10) + (size_t)i * D * FF, D, FF, wd, 2, W8_SCALE, base, gw, NGW, F.lane); convert_mat<true>(INP(11) + (size_t)i * D * FF, D, FF, wd, 3, W8_SCALE, base, gw, NGW, F.lane); }
        else { convert_mat<false>(INP(10) + (size_t)i * D * FF, D, FF, wd, 2, 1.0f, base, gw, NGW, F.lane); convert_mat<false>(INP(11) + (size_t)i * D * FF, D, FF, wd, 3, 1.0f, base, gw, NGW, F.lane); }
        if (DENSE_DN8(2 * i)) convert_mat<true>(INP(12) + (size_t)i * FF * D, FF, D, wd + 14 * MiB, 0, WD8_SCALE, base, gw, NGW, F.lane);
        else convert_mat<false>(INP(12) + (size_t)i * FF * D, FF, D, wd + 14 * MiB, 0, 1.0f, base, gw, NGW, F.lane); }
#pragma nounroll
    for (int ie = 0; ie < 2 * NE; ++ie) { const int i = ie >> 3, e = ie & 7; unsigned char* wm = F.ws + WS_WM + (size_t)i * WM_STRIDE; const size_t eo = (size_t)ie * D * FF;
        convert_mat<true>(INP(14) + eo, D, FF, wm + (size_t)e * 7 * MiB, 2, W8_SCALE, base, gw, NGW, F.lane);
        convert_mat<true>(INP(15) + eo, D, FF, wm + (size_t)e * 7 * MiB, 3, W8_SCALE, base, gw, NGW, F.lane);
        convert_mat<true>(INP(16) + eo, FF, D, wm + WM_DOWN + (size_t)e * WD8_ESTRIDE, 0, WD8_SCALE, base, gw, NGW, F.lane); }
    float* cosT = (float*)(F.ws + WS_COS); float* sinT = (float*)(F.ws + WS_SIN);
    for (int idx = F.bx * 512 + F.tid; idx < T * 8; idx += F.G * 512) {
        const int t = idx >> 3, i = idx & 7;
        const double f = (i == 0) ? 0.15915494309189535 : (i == 1) ? 0.03086376340470123 : (i == 2) ? 0.005985185712713705 : (i == 3) ? 0.001160663641240061
                       : (i == 4) ? 0.00022507907903927653 : (i == 5) ? 4.364795279280289e-05 : (i == 6) ? 8.464330808241401e-06 : 1.6414262627950345e-06;
        double rev = (double)t * f; rev -= (double)(long long)rev;
        const float rf = (float)rev;
        cosT[idx] = __builtin_amdgcn_cosf(rf); sinT[idx] = __builtin_amdgcn_sinf(rf);
    }
}

struct RowPass {
    const float* xsrc; const bf16* xbf; bf16* xdst;
    const float* gain;
    bf16* ob; float* of;
    int obp; float* ssq;
    unsigned char* ob8;
    int combine;
    int router; const float* wr;
};
constexpr int RG = 2;
__device__ __forceinline__ void phase_rows(Frame& F, const RowPass P) {
    LAS float* wrl = (LAS float*)F.lds;
    LAS int* hist = (LAS int*)(F.misc + MISC_SCR);
    const bf16* YS = (const bf16*)(F.ws + WS_GA);
    const int* posg = (const int*)(F.ws + WS_POS); const float* gateg = (const float*)(F.ws + WS_GATE);
    int* e01g = (int*)(F.ws + WS_E01); float* gatew = (float*)(F.ws + WS_GATE); int* tcnt = (int*)(F.ws + WS_TCNT);
    if (P.router) { for (int i = F.tid; i < D * 8; i += 512) wrl[i] = P.wr[i]; }
    f32x4 gv[4];
#pragma unroll
    for (int j = 0; j < 4; ++j) gv[j] = *(const f32x4*)(P.gain + 4 * F.lane + 256 * j);
    const int tstart = (F.G == 256) ? ((F.bx & 7) * 32 + (F.bx >> 3)) : F.bx, tstride = (F.G == 256) ? M / 256 : F.G;
    for (int tile = tstart; tile < M / 256; tile += tstride) {
        if (P.router) { if (F.tid < 8) hist[F.tid] = 0; }
        __syncthreads();
        f32x4 buf[RG][4]; u32x2 bub[RG][4];
#pragma unroll
        for (int q = 0; q < RG; ++q) {
            if (P.xsrc) { const float* xr = P.xsrc + (size_t)(tile * 256 + F.wave * 32 + q) * D + 4 * F.lane;
#pragma unroll
                for (int j = 0; j < 4; ++j) buf[q][j] = __builtin_nontemporal_load((const f32x4*)(xr + 256 * j)); }
            else { const bf16* xr = P.xbf + (size_t)(tile * 256 + F.wave * 32 + q) * XP + 4 * F.lane;
#pragma unroll
                for (int j = 0; j < 4; ++j) bub[q][j] = *(const u32x2*)(xr + 256 * j); } }
#pragma nounroll
        for (int i0 = 0; i0 < 32; i0 += RG) {
            const int rowb = tile * 256 + F.wave * 32 + i0;
            f32x4 v[RG][4];
#pragma unroll
            for (int q = 0; q < RG; ++q)
#pragma unroll
                for (int j = 0; j < 4; ++j) v[q][j] = P.xsrc ? buf[q][j] : (f32x4){bf_lo(bub[q][j].x), bf_hi(bub[q][j].x), bf_lo(bub[q][j].y), bf_hi(bub[q][j].y)};
            if (i0 + RG < 32) {
#pragma unroll
                for (int q = 0; q < RG; ++q) {
                    if (P.xsrc) { const float* xr = P.xsrc + (size_t)(rowb + RG + q) * D + 4 * F.lane;
#pragma unroll
                        for (int j = 0; j < 4; ++j) buf[q][j] = __builtin_nontemporal_load((const f32x4*)(xr + 256 * j)); }
                    else { const bf16* xr = P.xbf + (size_t)(rowb + RG + q) * XP + 4 * F.lane;
#pragma unroll
                        for (int j = 0; j < 4; ++j) bub[q][j] = *(const u32x2*)(xr + 256 * j); } }
            }
#pragma unroll
            for (int q = 0; q < RG; ++q) {
                const int row = rowb + q;
                if (P.combine) {
                    const int p0 = posg[2 * row], p1 = posg[2 * row + 1]; const float g0 = gateg[2 * row], g1 = gateg[2 * row + 1];
                    const bf16* y0 = YS + (size_t)p0 * D + 4 * F.lane; const bf16* y1 = YS + (size_t)p1 * D + 4 * F.lane;
#pragma unroll
                    for (int j = 0; j < 4; ++j) { const u32x2 a = __builtin_nontemporal_load((const u32x2*)(y0 + 256 * j)), b = __builtin_nontemporal_load((const u32x2*)(y1 + 256 * j));
                        v[q][j][0] += g0 * bf_lo(a.x) + g1 * bf_lo(b.x); v[q][j][1] += g0 * bf_hi(a.x) + g1 * bf_hi(b.x);
                        v[q][j][2] += g0 * bf_lo(a.y) + g1 * bf_lo(b.y); v[q][j][3] += g0 * bf_hi(a.y) + g1 * bf_hi(b.y); }
                }
                if (P.xdst) {
                    bf16* xw = P.xdst + (size_t)row * XP + 4 * F.lane;
#pragma unroll
                    for (int j = 0; j < 4; ++j) { u32x2 w; w.x = pk2(v[q][j][0], v[q][j][1]); w.y = pk2(v[q][j][2], v[q][j][3]); *(u32x2*)(xw + 256 * j) = w; }
                }
                float s = 0.f;
#pragma unroll
                for (int j = 0; j < 4; ++j) s += (v[q][j][0] * v[q][j][0] + v[q][j][1] * v[q][j][1]) + (v[q][j][2] * v[q][j][2] + v[q][j][3] * v[q][j][3]);
                const float wsum = wave_sum(s);
                if (P.ssq) { if (F.lane < 4) *(f32x4*)(P.ssq + (size_t)row * 16 + 4 * F.lane) = (f32x4){F.lane == 0 ? wsum : 0.f, 0.f, 0.f, 0.f}; }
                const float rstd = 1.0f / sqrtf(wsum * (1.0f / D) + RMS_EPS);
#pragma unroll
                for (int j = 0; j < 4; ++j) v[q][j] = v[q][j] * rstd * gv[j];
                if (P.ob) {
                    bf16* o = P.ob + (size_t)row * P.obp + 4 * F.lane;
#pragma unroll
                    for (int j = 0; j < 4; ++j) { u32x2 w; w.x = pk2(v[q][j][0], v[q][j][1]); w.y = pk2(v[q][j][2], v[q][j][3]); *(u32x2*)(o + 256 * j) = w; }
                }
                if (P.ob8) {
                    unsigned char* o = P.ob8 + (size_t)row * D + 4 * F.lane;
#pragma unroll
                    for (int j = 0; j < 4; ++j) *(unsigned*)(o + 256 * j) = cvt4_fp8(v[q][j][0] * A8_SCALE, v[q][j][1] * A8_SCALE, v[q][j][2] * A8_SCALE, v[q][j][3] * A8_SCALE);
                }
                if (P.of) {
                    float* o = P.of + (size_t)row * D + 4 * F.lane;
#pragma unroll
                    for (int j = 0; j < 4; ++j) __builtin_nontemporal_store(v[q][j], (f32x4*)(o + 256 * j));
                }
            }
            if (P.router) {
                float lg[RG][8];
#pragma unroll
                for (int q = 0; q < RG; ++q)
#pragma unroll
                    for (int e = 0; e < 8; ++e) lg[q][e] = 0.f;
#pragma unroll
                for (int j = 0; j < 4; ++j)
#pragma unroll
                    for (int c = 0; c < 4; ++c) { const LAS f32x4* w = (const LAS f32x4*)(wrl + (4 * F.lane + 256 * j + c) * 8); const f32x4 w0 = w[0], w1 = w[1];
#pragma unroll
                        for (int q = 0; q < RG; ++q) { const float h = v[q][j][c];
                            lg[q][0] += h * w0[0]; lg[q][1] += h * w0[1]; lg[q][2] += h * w0[2]; lg[q][3] += h * w0[3]; lg[q][4] += h * w1[0]; lg[q][5] += h * w1[1]; lg[q][6] += h * w1[2]; lg[q][7] += h * w1[3]; } }
#pragma unroll
                for (int q = 0; q < RG; ++q) {
                    const int row = rowb + q;
#pragma unroll
                    for (int e = 0; e < 8; ++e) lg[q][e] = wave_sum(lg[q][e]);
                    int e0 = 0; float b0 = lg[q][0];
#pragma unroll
                    for (int e = 1; e < 8; ++e) if (lg[q][e] > b0) { b0 = lg[q][e]; e0 = e; }
                    int e1 = -1; float b1 = -INFINITY;
#pragma unroll
                    for (int e = 0; e < 8; ++e) if (e != e0 && lg[q][e] > b1) { b1 = lg[q][e]; e1 = e; }
                    if (e1 < 0) { e1 = (e0 + 1) & 7; b1 = b0; }
                    const float g0 = 1.0f / (1.0f + expf(b1 - b0));
                    if (F.lane == 0) { e01g[row] = e0 | (e1 << 8); gatew[2 * row] = g0; gatew[2 * row + 1] = 1.0f - g0; lds_add(&hist[e0], 1); lds_add(&hist[e1], 1); }
                }
            }
        }
        __syncthreads();
        if (P.router) { if (F.tid < 8) tcnt[tile * 8 + F.tid] = hist[F.tid]; }
    }
}
__device__ __forceinline__ void phase_memnorm(Frame& F) {
    const int gw = F.bx * NWAVES + F.wave, NGW = F.G * NWAVES;
    bf16* MN = (bf16*)(F.ws + WS_MEMN4);
    const float* memp = INP(1); const float* gbase = INP(5);
    for (int r = gw; r < DEPTH * MROWS; r += NGW) {
        const int L = r / MROWS, row = r - L * MROWS;
        const float* xr = memp + (size_t)row * D + 4 * F.lane; const float* gain = gbase + (size_t)L * D + 4 * F.lane;
        f32x4 v[4]; float s = 0.f;
#pragma unroll
        for (int j = 0; j < 4; ++j) { v[j] = *(const f32x4*)(xr + 256 * j); s += (v[j][0] * v[j][0] + v[j][1] * v[j][1]) + (v[j][2] * v[j][2] + v[j][3] * v[j][3]); }
        const float rstd = 1.0f / sqrtf(wave_sum(s) * (1.0f / D) + RMS_EPS);
        bf16* o = MN + (size_t)r * D + 4 * F.lane;
#pragma unroll
        for (int j = 0; j < 4; ++j) { const f32x4 y = v[j] * rstd * *(const f32x4*)(gain + 256 * j); u32x2 w; w.x = pk2(y[0], y[1]); w.y = pk2(y[2], y[3]); *(u32x2*)(o + 256 * j) = w; }
    }
}

__device__ __forceinline__ void phase_moe_assign(Frame& F) {
    LAS int* sc = (LAS int*)(F.misc + MISC_SCR);
    LAS int* dst = (LAS int*)(F.lds);
    const int* tcnt = (const int*)(F.ws + WS_TCNT); const int* e01g = (const int*)(F.ws + WS_E01);
    int* posg = (int*)(F.ws + WS_POS); int* texp = (int*)(F.ws + WS_TEXP);
    const unsigned char* HB8 = F.ws + WS_HB; unsigned char* GA8 = F.ws + WS_GA8;
    const int tstart = (F.G == 256) ? ((F.bx & 7) * 32 + (F.bx >> 3)) : F.bx, tstride = (F.G == 256) ? M / 256 : F.G;
    for (int tile = tstart; tile < M / 256; tile += tstride) {
        __syncthreads();
        if (F.tid < 80) sc[F.tid] = 0;
        __syncthreads();
        if (F.tid < 256) {
            const int j = F.tid;
#pragma unroll
            for (int e = 0; e < 8; ++e) { const int c = tcnt[j * 8 + e]; lds_add(&sc[e], c); if (j < tile) lds_add(&sc[8 + e], c); }
        }
        __syncthreads();
        if (F.tid == 0) { int ps = 0; for (int e = 0; e < 8; ++e) { sc[64 + e] = ps; sc[16 + e] = ps + sc[8 + e]; ps += (sc[e] + 255) & ~255; } sc[72] = ps; }
        __syncthreads();
        if (tile == 0 && F.tid < 8) {
            const int e = F.tid; const int t0 = sc[64 + e] >> 8, t1 = (e == 7 ? sc[72] : sc[64 + e + 1]) >> 8;
            for (int t = t0; t < t1; ++t) texp[t] = e;
            if (e == 7) texp[MAXTILES] = sc[72] >> 8;
        }
        int e0 = 0, e1 = 0, r0 = 0, r1 = 0;
        if (F.tid < 256) {
            const int w = F.tid >> 6; const int pk = e01g[tile * 256 + F.tid]; e0 = pk & 255; e1 = pk >> 8;
            const unsigned long long below = (1ull << F.lane) - 1ull;
#pragma unroll
            for (int e = 0; e < 8; ++e) {
                const unsigned long long m0 = __ballot(e0 == e), m1 = __ballot(e1 == e);
                const int rk = __popcll(m0 & below) + __popcll(m1 & below);
                if (e0 == e) r0 = rk; if (e1 == e) r1 = rk;
                if (F.lane == 0) sc[32 + w * 8 + e] = __popcll(m0) + __popcll(m1);
            }
        }
        __syncthreads();
        if (F.tid < 256) {
            const int w = F.tid >> 6; int b0 = sc[16 + e0], b1 = sc[16 + e1];
            for (int ww = 0; ww < w; ++ww) { b0 += sc[32 + ww * 8 + e0]; b1 += sc[32 + ww * 8 + e1]; }
            const int d0 = b0 + r0, d1 = b1 + r1;
            dst[2 * F.tid] = d0; dst[2 * F.tid + 1] = d1;
            posg[2 * (tile * 256 + F.tid)] = d0; posg[2 * (tile * 256 + F.tid) + 1] = d1;
        }
        __syncthreads();
#pragma nounroll
        for (int t0 = F.wave * 32; t0 < F.wave * 32 + 32; t0 += 16) {
            u32x4 v[16];
#pragma unroll
            for (int j = 0; j < 16; ++j) v[j] = __builtin_nontemporal_load((const u32x4*)(HB8 + (size_t)(tile * 256 + t0 + j) * D) + F.lane);
#pragma unroll
            for (int j = 0; j < 16; ++j) { const int d0 = dst[2 * (t0 + j)], d1 = dst[2 * (t0 + j) + 1];
                ((u32x4*)(GA8 + (size_t)d0 * D))[F.lane] = v[j]; ((u32x4*)(GA8 + (size_t)d1 * D))[F.lane] = v[j]; }
        }
    }
}

namespace att {
constexpr int L_OS = 0, L_MS = 32768, L_LS = 33792, L_SSQ = 34816, L_RPB = 51200, L_KV = 62976, KV_WAVE = 8832, KT_BYTES = 4608;
static_assert(L_KV + 8 * KV_WAVE <= MISC_OFF, "attention LDS map");
__device__ __forceinline__ f32x4 mfma16(bf16x8 a, bf16x8 b, f32x4 c) { return __builtin_amdgcn_mfma_f32_16x16x32_bf16(a, b, c, 0, 0, 0); }
__device__ __forceinline__ v4i16_t vtr(const LAS unsigned char* p) { return __builtin_amdgcn_ds_read_tr16_b64_v4i16((LAS v4i16_t*)p); }

struct St { float m, lp; f32x4 o[4]; };
__device__ __forceinline__ void st_init(St& s) { s.m = -1e30f; s.lp = 0.f;
#pragma unroll
    for (int d = 0; d < 4; ++d) s.o[d] = (f32x4){0.f, 0.f, 0.f, 0.f}; }

struct Ld { u32x4 k0, k1, k2, k3, v0, v1, v2, v3; };
__device__ __forceinline__ void ld_issue8(Ld& L, const bf16* k0p, const bf16* k1p, const bf16* k2p, const bf16* k3p, const bf16* v0p, const bf16* v1p, const bf16* v2p, const bf16* v3p) {
    L.k0 = *(const u32x4*)(k0p); L.k1 = *(const u32x4*)(k1p); L.k2 = *(const u32x4*)(k2p); L.k3 = *(const u32x4*)(k3p);
    L.v0 = *(const u32x4*)(v0p); L.v1 = *(const u32x4*)(v1p); L.v2 = *(const u32x4*)(v2p); L.v3 = *(const u32x4*)(v3p);
}
__device__ __forceinline__ void ld_issue(Ld& L, const bf16* kp, const bf16* vp, size_t r8) { ld_issue8(L, kp, kp + r8, kp + 2 * r8, kp + 3 * r8, vp, vp + r8, vp + 2 * r8, vp + 3 * r8); }
constexpr int VPL = 1056;
struct Kf { bf16x8 k00, k01, k10, k11; };
__device__ __forceinline__ void stage_kv(const Ld& L, LAS unsigned char* kvl, int lane) {
    LAS unsigned char* kw = kvl + (lane >> 3) * 144 + (lane & 7) * 16;
    *(LAS u32x4*)(kw) = L.k0; *(LAS u32x4*)(kw + 1152) = L.k1; *(LAS u32x4*)(kw + 2304) = L.k2; *(LAS u32x4*)(kw + 3456) = L.k3;
    const int c = lane & 7; LAS unsigned char* vw = kvl + KT_BYTES + (c >> 1) * VPL + (lane >> 3) * 32 + (c & 1) * 16;
    *(LAS u32x4*)(vw) = L.v0; *(LAS u32x4*)(vw + 256) = L.v1; *(LAS u32x4*)(vw + 512) = L.v2; *(LAS u32x4*)(vw + 768) = L.v3;
}
__device__ __forceinline__ Kf kf_read(const LAS unsigned char* kvl, int lq, int lg) {
    const LAS unsigned char* p = kvl + lq * 144 + lg * 16; Kf k;
    k.k00 = *(const LAS bf16x8*)(p); k.k01 = *(const LAS bf16x8*)(p + 64); k.k10 = *(const LAS bf16x8*)(p + 16 * 144); k.k11 = *(const LAS bf16x8*)(p + 16 * 144 + 64); return k;
}
__device__ __forceinline__ void qk(const Kf& L, const bf16x8 (&q)[2], f32x4& s0, f32x4& s1) {
    const f32x4 z = (f32x4){0.f, 0.f, 0.f, 0.f};
    s0 = mfma16(L.k00, q[0], z); s0 = mfma16(L.k01, q[1], s0); s1 = mfma16(L.k10, q[0], z); s1 = mfma16(L.k11, q[1], s1);
}
__device__ __forceinline__ void soft_pv(f32x4 s0, f32x4 s1, const LAS unsigned char* vl, int lq, int lg, St& S) {
    const float mx = vmax2(vmax3(s0[0], s0[1], s0[2]), vmax3(vmax3(s0[3], s1[0], s1[1]), s1[2], s1[3]));
    if (__any(mx > S.m + 8.0f)) {
        float mf = vmax2(mx, __shfl_xor(mx, 16)); mf = vmax2(mf, __shfl_xor(mf, 32));
        const float mn = vmax2(S.m, mf); const float alpha = __builtin_amdgcn_exp2f(S.m - mn); S.m = mn;
        S.lp *= alpha;
#pragma unroll
        for (int d = 0; d < 4; ++d) S.o[d] = S.o[d] * alpha;
    }
    const float mn = S.m;
    float p[8];
#pragma unroll
    for (int r = 0; r < 4; ++r) { p[r] = __builtin_amdgcn_exp2f(s0[r] - mn); p[4 + r] = __builtin_amdgcn_exp2f(s1[r] - mn); }
    S.lp += ((p[0] + p[1]) + (p[2] + p[3])) + ((p[4] + p[5]) + (p[6] + p[7]));
    u32x4 pw; pw.x = pg8::cvt_pk_bf16(p[0], p[1]); pw.y = pg8::cvt_pk_bf16(p[2], p[3]); pw.z = pg8::cvt_pk_bf16(p[4], p[5]); pw.w = pg8::cvt_pk_bf16(p[6], p[7]);
    const bf16x8 pf = __builtin_bit_cast(bf16x8, pw);
    const LAS unsigned char* tb = vl + KT_BYTES + (4 * lg + (lq >> 2)) * 32 + 8 * (lq & 3);
#pragma unroll
    for (int d = 0; d < 4; ++d) {
        const v4i16_t lo = vtr(tb + d * VPL), hi = vtr(tb + d * VPL + 512);
        const bf16x8 vf = (bf16x8){lo[0], lo[1], lo[2], lo[3], hi[0], hi[1], hi[2], hi[3]};
        S.o[d] = mfma16(vf, pf, S.o[d]);
    }
}
template <int NT>
__device__ __forceinline__ void multi_soft_pv(f32x4 (&s0)[NT], f32x4 (&s1)[NT], const LAS unsigned char* vl, int lq, int lg, St (&S)[NT], const int am = -1) {
    float mx[NT]; bool trig = false;
#pragma unroll
    for (int t = 0; t < NT; ++t) if (am & (1 << t)) { mx[t] = vmax2(vmax3(s0[t][0], s0[t][1], s0[t][2]), vmax3(vmax3(s0[t][3], s1[t][0], s1[t][1]), s1[t][2], s1[t][3])); trig = trig || (mx[t] > S[t].m + 8.0f); }
    if (__any(trig)) {
#pragma unroll
        for (int t = 0; t < NT; ++t) if (am & (1 << t)) {
            float mf = vmax2(mx[t], __shfl_xor(mx[t], 16)); mf = vmax2(mf, __shfl_xor(mf, 32));
            const float mn = vmax2(S[t].m, mf); const float alpha = __builtin_amdgcn_exp2f(S[t].m - mn); S[t].m = mn; S[t].lp *= alpha;
#pragma unroll
            for (int d = 0; d < 4; ++d) S[t].o[d] = S[t].o[d] * alpha;
        }
    }
    bf16x8 pf[NT];
#pragma unroll
    for (int t = 0; t < NT; ++t) if (am & (1 << t)) {
        const float mn = S[t].m; float p[8];
#pragma unroll
        for (int r = 0; r < 4; ++r) { p[r] = __builtin_amdgcn_exp2f(s0[t][r] - mn); p[4 + r] = __builtin_amdgcn_exp2f(s1[t][r] - mn); }
        S[t].lp += ((p[0] + p[1]) + (p[2] + p[3])) + ((p[4] + p[5]) + (p[6] + p[7]));
        u32x4 pw; pw.x = pg8::cvt_pk_bf16(p[0], p[1]); pw.y = pg8::cvt_pk_bf16(p[2], p[3]); pw.z = pg8::cvt_pk_bf16(p[4], p[5]); pw.w = pg8::cvt_pk_bf16(p[6], p[7]);
        pf[t] = __builtin_bit_cast(bf16x8, pw);
    }
    const LAS unsigned char* tb = vl + KT_BYTES + (4 * lg + (lq >> 2)) * 32 + 8 * (lq & 3);
#pragma unroll
    for (int d = 0; d < 4; ++d) {
        const v4i16_t lo = vtr(tb + d * VPL), hi = vtr(tb + d * VPL + 512);
        const bf16x8 vf = (bf16x8){lo[0], lo[1], lo[2], lo[3], hi[0], hi[1], hi[2], hi[3]};
#pragma unroll
        for (int t = 0; t < NT; ++t) if (am & (1 << t)) S[t].o[d] = mfma16(vf, pf[t], S[t].o[d]);
    }
}
__device__ __forceinline__ float lsum(float lp) { lp += __shfl_xor(lp, 16); lp += __shfl_xor(lp, 32); return lp; }

__device__ __forceinline__ void finish(const St& S, float l, bf16* yrow  , LAS float* ssq_slot, int lg) {
    const float inv = 1.0f / l; float ss = 0.f;
#pragma unroll
    for (int d = 0; d < 4; ++d) { const f32x4 v = S.o[d] * inv; ss += (v[0] * v[0] + v[1] * v[1]) + (v[2] * v[2] + v[3] * v[3]);
        u32x2 w; w.x = pg8::cvt_pk_bf16(v[0], v[1]); w.y = pg8::cvt_pk_bf16(v[2], v[3]); *(u32x2*)(yrow + 16 * d + 4 * lg) = w; }
    ss += __shfl_xor(ss, 16); ss += __shfl_xor(ss, 32);
    if (lg == 0) *ssq_slot = ss;
}

__device__ __forceinline__ void attn_unit(Frame& F, int b, int t0, int layer) {
    LAS unsigned char* lds = F.lds;
    int lane = F.lane, lq = lane & 15, lg = lane >> 4; const int wave = F.wave;
#define RELANE() do { asm volatile("" : "+v"(lane)); lq = lane & 15; lg = lane >> 4; } while (0)
    const bf16* QKV = (const bf16*)(F.ws + WS_BIG); const bf16* MKV = (const bf16*)(F.ws + WS_MEMKV4) + (size_t)layer * MROWS * 512; bf16* Y = (bf16*)(F.ws + WS_HB);
    LAS bf16* Os = (LAS bf16*)(lds + L_OS); LAS float* Ms = (LAS float*)(lds + L_MS); LAS float* Ls = (LAS float*)(lds + L_LS);
    LAS float* ssq = (LAS float*)(lds + L_SSQ); LAS float* rpb = (LAS float*)(lds + L_RPB);
    LAS unsigned char* vl = lds + L_KV + wave * KV_WAVE;
    const size_t rowb = (size_t)b * T;
    { const float* rp = INP(4) + (size_t)layer * 6 * 465; for (int i = F.tid; i < 6 * 480; i += 512) { const int hh = i / 480, rem = i - hh * 480, ro = rem >> 5, co = rem & 31; rpb[i] = co < 31 ? rp[hh * 465 + ro * 31 + co] * LOG2E : -INFINITY; } }
    __syncthreads();
    const int R0 = t0 >> 6;
#pragma nounroll
    for (int pass = 0; pass < 3; ++pass) {
        RELANE();
        const int h = 2 * pass + (wave >> 2), kq = wave & 3;
        const int qc = 16 * kq + lq, cs = (kq == 0) ? 0 : (kq == 1) ? 8 : (kq == 2) ? 24 : 32;
        int c0q = qc - 8; c0q = c0q < 0 ? 0 : (c0q > 48 ? 48 : c0q);
        unsigned bcol[8];
#pragma unroll
        for (int e = 0; e < 8; ++e) { const int c = cs + 16 * (e >> 2) + 4 * lg + (e & 3); const bool ok = (c >= c0q) && (c <= c0q + 15);
            bcol[e] = (unsigned)(uintptr_t)(rpb + h * 480) + 4u * (unsigned)(ok ? (c - qc + 15) : 31); }
        int r0v[4]; bf16x8 qf[4][2]; St S[4];
#pragma unroll
        for (int rr = 0; rr < 4; ++rr) { const int r = R0 + rr; int r0 = r - 4; r0 = r0 < 0 ? 0 : (r0 > 120 ? 120 : r0); r0v[rr] = r0;
            const size_t qrow = rowb + (size_t)r * 64 + qc;
            qf[rr][0] = *(const bf16x8*)(QKV + qrow * NQKV + OFF_QA + h * 64 + lg * 8); qf[rr][1] = *(const bf16x8*)(QKV + qrow * NQKV + OFF_QA + h * 64 + 32 + lg * 8);
            st_init(S[rr]); }
        const int krmin = r0v[0], nrows = r0v[3] + 8 - krmin;
        const bf16* kbase = QKV + (rowb + (size_t)krmin * 64 + cs + (lane >> 3)) * NQKV + OFF_KA + h * 64 + (lane & 7) * 8;
        const bf16* vbase = kbase + (OFF_VA - OFF_KA);
        const size_t v8 = (size_t)8 * NQKV;
        const size_t rstep = (size_t)64 * NQKV;
        auto na_row = [&](int kr) {
            const Kf kf = kf_read(vl, lq, lg);
            f32x4 s0[4], s1[4];
            int am = 0;
#pragma unroll
            for (int rr = 0; rr < 4; ++rr) am |= (kr >= r0v[rr] && kr < r0v[rr] + 8) ? (1 << rr) : 0;
            am = __builtin_amdgcn_readfirstlane(am);
#pragma unroll
            for (int rr = 0; rr < 4; ++rr) if (am & (1 << rr)) {
                const unsigned ro = (unsigned)(kr - (R0 + rr) + 7) * 128u;
                f32x4 a0, a1;
#pragma unroll
                for (int e = 0; e < 4; ++e) { a0[e] = *(const LAS float*)(uintptr_t)(bcol[e] + ro); a1[e] = *(const LAS float*)(uintptr_t)(bcol[4 + e] + ro); }
                qk(kf, qf[rr], s0[rr], s1[rr]);
                s0[rr] = s0[rr] + a0; s1[rr] = s1[rr] + a1;
            }
            multi_soft_pv<4>(s0, s1, vl, lq, lg, S, am);
            asm volatile("" ::: "memory");
        };
        Ld LA;
        ld_issue(LA, kbase, vbase, v8);
#pragma nounroll
        for (int j = 0; j < nrows; ++j) {
            stage_kv(LA, vl, lane);
            asm volatile("" ::: "memory");
            { const int jn = (j + 1 < nrows) ? j + 1 : nrows - 1; ld_issue(LA, kbase + (size_t)jn * rstep, vbase + (size_t)jn * rstep, v8); }
            na_row(krmin + j);
        }
#pragma unroll
        for (int rr = 0; rr < 4; ++rr) { const float l = lsum(S[rr].lp);
            finish(S[rr], l, Y + (rowb + (size_t)(R0 + rr) * 64 + qc) * D + h * 64, ssq + h * 256 + (rr * 64 + qc), lg); }
    }
#pragma nounroll
    for (int pass = 0; pass < 2; ++pass) {
        RELANE();
        const int h = 2 * pass + (wave >> 2), j0 = 4 * (wave & 3);
        bf16x8 qf[4][2]; St S[4];
#pragma unroll
        for (int t = 0; t < 4; ++t) { const size_t qrow = rowb + t0 + 16 * (j0 + t) + lq;
            qf[t][0] = *(const bf16x8*)(QKV + qrow * NQKV + OFF_QM + h * 64 + lg * 8); qf[t][1] = *(const bf16x8*)(QKV + qrow * NQKV + OFF_QM + h * 64 + 32 + lg * 8);
            st_init(S[t]); }
        const bf16* kbase = MKV + ((size_t)b * NMEM + (lane >> 3)) * 512 + h * 64 + (lane & 7) * 8;
        const bf16* vbase = kbase + 256;
        Ld LA;
        ld_issue(LA, kbase, vbase, (size_t)8 * 512);
#pragma nounroll
        for (int s = 0; s < 8; ++s) {
            stage_kv(LA, vl, lane);
            asm volatile("" ::: "memory");
            { const int sn = (s + 1 < 8) ? s + 1 : 7; ld_issue(LA, kbase + sn * 32 * 512, vbase + sn * 32 * 512, (size_t)8 * 512); }
            const Kf kf = kf_read(vl, lq, lg);
            f32x4 s0[4], s1[4];
#pragma unroll
            for (int t = 0; t < 4; ++t) qk(kf, qf[t], s0[t], s1[t]);
            multi_soft_pv<4>(s0, s1, vl, lq, lg, S);
            asm volatile("" ::: "memory");
        }
#pragma unroll
        for (int t = 0; t < 4; ++t) { const int idx = 16 * (j0 + t) + lq; const float l = lsum(S[t].lp);
            finish(S[t], l, Y + (rowb + t0 + idx) * D + 768 + h * 64, ssq + (12 + h) * 256 + idx, lg); }
    }
    __syncthreads();
    for (int h = 0; h < 6; ++h) {
#pragma nounroll
        for (int br = 0; br < 2; ++br) {
            RELANE();
            const int sh = 2 * br, dl = 1 << sh, seg = T >> sh;
            const int res = br ? (wave >> 1) : 0, m0 = br ? ((t0 >> 2) + 32 * (wave & 1)) : (t0 + 32 * wave);
            bf16x8 qf[2][2]; St S[2]; int idxv[2];
#pragma unroll
            for (int t = 0; t < 2; ++t) { const size_t qrow = rowb + (size_t)(m0 + 16 * t + lq) * dl + res;
                qf[t][0] = *(const bf16x8*)(QKV + qrow * NQKV + OFF_QB + h * 64 + lg * 8); qf[t][1] = *(const bf16x8*)(QKV + qrow * NQKV + OFF_QB + h * 64 + 32 + lg * 8);
                st_init(S[t]); idxv[t] = br ? (128 * (wave & 1) + 64 * t + 4 * lq + res) : (32 * wave + 16 * t + lq); }
            const bool edge = (m0 - 64 < 0) || (m0 + 95 >= seg);
            auto dload = [&](Ld& L, int s) {
                const int kb = m0 - 64 + 32 * s;
                int kv = kb + (lane >> 3);
                const bf16* kcol = QKV + (rowb + res) * NQKV + OFF_KB + h * 64 + (lane & 7) * 8; const bf16* vcol = kcol + (OFF_VB - OFF_KB);
                const size_t rs = (size_t)dl * NQKV;
                if (edge) {
                    int v0 = kv, v1 = kv + 8, v2 = kv + 16, v3 = kv + 24;
                    v0 = v0 < 0 ? 0 : (v0 >= seg ? seg - 1 : v0); v1 = v1 < 0 ? 0 : (v1 >= seg ? seg - 1 : v1); v2 = v2 < 0 ? 0 : (v2 >= seg ? seg - 1 : v2); v3 = v3 < 0 ? 0 : (v3 >= seg ? seg - 1 : v3);
                    ld_issue8(L, kcol + (size_t)v0 * rs, kcol + (size_t)v1 * rs, kcol + (size_t)v2 * rs, kcol + (size_t)v3 * rs, vcol + (size_t)v0 * rs, vcol + (size_t)v1 * rs, vcol + (size_t)v2 * rs, vcol + (size_t)v3 * rs);
                } else ld_issue(L, kcol + (size_t)kv * rs, vcol + (size_t)kv * rs, 8 * rs); };
            auto dstep = [&](int s) {
                const Kf kf = kf_read(vl, lq, lg);
                const int kb = m0 - 64 + 32 * s;
                f32x4 s0[2], s1[2];
#pragma unroll
                for (int t = 0; t < 2; ++t) {
                    qk(kf, qf[t], s0[t], s1[t]);
                    if (edge || s == 0 || s == 4) {
                        const int qm = m0 + 16 * t + lq;
#pragma unroll
                        for (int e = 0; e < 8; ++e) { const int km = kb + 16 * (e >> 2) + 4 * lg + (e & 3); const int dd = km - qm;
                            const bool ok = (km >= 0) && (km < seg) && (dd >= -64) && (dd <= 64); if (!ok) { if (e < 4) s0[t][e] = -INFINITY; else s1[t][e - 4] = -INFINITY; } }
                    }
                }
                multi_soft_pv<2>(s0, s1, vl, lq, lg, S);
                asm volatile("" ::: "memory");
            };
            { Ld LA;
              dload(LA, 0);
#pragma nounroll
              for (int s = 0; s < 5; ++s) {
                  stage_kv(LA, vl, lane);
                  asm volatile("" ::: "memory");
                  dload(LA, s + 1 < 5 ? s + 1 : 4);
                  dstep(s);
              } }
#pragma unroll
            for (int t = 0; t < 2; ++t) {
                const int idx = idxv[t]; float l = lsum(S[t].lp);
                LAS u32x2* osr = (LAS u32x2*)(Os + idx * 64 + 4 * lg);
                if (br > 0) {
                    const float m1 = Ms[idx], l1 = Ls[idx]; const float mn = vmax2(S[t].m, m1);
                    const float a1 = __builtin_amdgcn_exp2f(m1 - mn), a2 = __builtin_amdgcn_exp2f(S[t].m - mn);
#pragma unroll
                    for (int d = 0; d < 4; ++d) { const u32x2 w = osr[4 * d]; const f32x4 o1 = (f32x4){bf_lo(w.x), bf_hi(w.x), bf_lo(w.y), bf_hi(w.y)}; S[t].o[d] = o1 * a1 + S[t].o[d] * a2; }
                    l = l1 * a1 + l * a2; S[t].m = mn;
                }
#pragma unroll
                for (int d = 0; d < 4; ++d) { u32x2 w; w.x = pg8::cvt_pk_bf16(S[t].o[d][0], S[t].o[d][1]); w.y = pg8::cvt_pk_bf16(S[t].o[d][2], S[t].o[d][3]); osr[4 * d] = w; }
                if (lg == 0) { Ms[idx] = S[t].m; Ls[idx] = l; }
            }
            __syncthreads();
        }
        {
            constexpr int dl = 16, seg = T >> 4;
#pragma nounroll
            for (int tix = wave; tix < 16; tix += 8) {
                RELANE();
                const int res = tix, m0 = t0 >> 4, idx = 16 * lq + res;
                const size_t qrow = rowb + (size_t)(m0 + lq) * dl + res;
                bf16x8 qf[2];
                qf[0] = *(const bf16x8*)(QKV + qrow * NQKV + OFF_QB + h * 64 + lg * 8); qf[1] = *(const bf16x8*)(QKV + qrow * NQKV + OFF_QB + h * 64 + 32 + lg * 8);
                St S; st_init(S);
                const int qm = m0 + lq;
                const bool edge = (m0 - 64 < 0) || (m0 + 95 >= seg);
                auto dload = [&](Ld& L, int s) {
                    const int kb = m0 - 64 + 32 * s;
                    int kv = kb + (lane >> 3);
                    const bf16* kcol = QKV + (rowb + res) * NQKV + OFF_KB + h * 64 + (lane & 7) * 8; const bf16* vcol = kcol + (OFF_VB - OFF_KB);
                    const size_t rs = (size_t)dl * NQKV;
                    if (edge) {
                        int v0 = kv, v1 = kv + 8, v2 = kv + 16, v3 = kv + 24;
                        v0 = v0 < 0 ? 0 : (v0 >= seg ? seg - 1 : v0); v1 = v1 < 0 ? 0 : (v1 >= seg ? seg - 1 : v1); v2 = v2 < 0 ? 0 : (v2 >= seg ? seg - 1 : v2); v3 = v3 < 0 ? 0 : (v3 >= seg ? seg - 1 : v3);
                        ld_issue8(L, kcol + (size_t)v0 * rs, kcol + (size_t)v1 * rs, kcol + (size_t)v2 * rs, kcol + (size_t)v3 * rs, vcol + (size_t)v0 * rs, vcol + (size_t)v1 * rs, vcol + (size_t)v2 * rs, vcol + (size_t)v3 * rs);
                    } else ld_issue(L, kcol + (size_t)kv * rs, vcol + (size_t)kv * rs, 8 * rs); };
                auto dstep = [&](int s) {
                    const Kf kf = kf_read(vl, lq, lg);
                    const int kb = m0 - 64 + 32 * s;
                    f32x4 s0, s1; qk(kf, qf, s0, s1);
                    if (edge || s == 0 || s == 4) {
#pragma unroll
                        for (int e = 0; e < 8; ++e) { const int km = kb + 16 * (e >> 2) + 4 * lg + (e & 3); const int dd = km - qm;
                            const bool ok = (km >= 0) && (km < seg) && (dd >= -64) && (dd <= 64); if (!ok) { if (e < 4) s0[e] = -INFINITY; else s1[e - 4] = -INFINITY; } }
                    }
                    soft_pv(s0, s1, vl, lq, lg, S);
                    asm volatile("" ::: "memory");
                };
                { Ld LA;
                  dload(LA, 0);
#pragma nounroll
                  for (int s = 0; s < 5; ++s) {
                      stage_kv(LA, vl, lane);
                      asm volatile("" ::: "memory");
                      dload(LA, s + 1 < 5 ? s + 1 : 4);
                      dstep(s);
                  } }
                float l = lsum(S.lp);
                LAS u32x2* osr = (LAS u32x2*)(Os + idx * 64 + 4 * lg);
                { const float m1 = Ms[idx], l1 = Ls[idx]; const float mn = vmax2(S.m, m1);
                  const float a1 = __builtin_amdgcn_exp2f(m1 - mn), a2 = __builtin_amdgcn_exp2f(S.m - mn);
#pragma unroll
                  for (int d = 0; d < 4; ++d) { const u32x2 w = osr[4 * d]; const f32x4 o1 = (f32x4){bf_lo(w.x), bf_hi(w.x), bf_lo(w.y), bf_hi(w.y)}; S.o[d] = o1 * a1 + S.o[d] * a2; }
                  l = l1 * a1 + l * a2; S.m = mn; }
                finish(S, l, Y + qrow * D + 384 + h * 64, ssq + (6 + h) * 256 + idx, lg);
            }
            __syncthreads();
        }
    }
    VM_WAIT(); __syncthreads();
    RELANE();
    {
        const float* gm = INP(7) + (size_t)layer * D;
        const int c0 = 8 * lane, c1 = 512 + 8 * lane;
        const int g0 = c0 < 384 ? 0 : 1, g1 = c1 < 768 ? 1 : 2;
        f32x4 ga[2], gb[2];
        ga[0] = *(const f32x4*)(gm + c0); ga[1] = *(const f32x4*)(gm + c0 + 4); gb[0] = *(const f32x4*)(gm + c1); gb[1] = *(const f32x4*)(gm + c1 + 4);
#pragma nounroll
        for (int i0 = 0; i0 < 32; i0 += 4) {
            u32x4 w0[4], w1[4]; float s0v[4], s1v[4];
#pragma unroll
            for (int q = 0; q < 4; ++q) { const bf16* yr = Y + (rowb + t0 + wave * 32 + i0 + q) * D; w0[q] = *(const u32x4*)(yr + c0); w1[q] = *(const u32x4*)(yr + c1); }
#pragma unroll
            for (int q = 0; q < 4; ++q) {
                const int idx = wave * 32 + i0 + q;
                float sa = 0.f, sb = 0.f, sm = 0.f;
#pragma unroll
                for (int hh = 0; hh < 6; ++hh) { sa += ssq[hh * 256 + idx]; sb += ssq[(6 + hh) * 256 + idx]; }
#pragma unroll
                for (int hh = 0; hh < 4; ++hh) sm += ssq[(12 + hh) * 256 + idx];
                const float ra = 1.0f / sqrtf(sa * (1.0f / 384.f) + RMS_EPS), rb = 1.0f / sqrtf(sb * (1.0f / 384.f) + RMS_EPS), rm = 1.0f / sqrtf(sm * (1.0f / 256.f) + RMS_EPS);
                s0v[q] = g0 == 0 ? ra : rb; s1v[q] = g1 == 1 ? rb : rm;
            }
#pragma unroll
            for (int q = 0; q < 4; ++q) {
                bf16* yr = Y + (rowb + t0 + wave * 32 + i0 + q) * D; const float s0 = s0v[q], s1 = s1v[q]; const u32x4 a = w0[q], bb = w1[q];
                u32x4 o0, o1;
                o0.x = pk2(bf_lo(a.x) * s0 * ga[0][0], bf_hi(a.x) * s0 * ga[0][1]); o0.y = pk2(bf_lo(a.y) * s0 * ga[0][2], bf_hi(a.y) * s0 * ga[0][3]);
                o0.z = pk2(bf_lo(a.z) * s0 * ga[1][0], bf_hi(a.z) * s0 * ga[1][1]); o0.w = pk2(bf_lo(a.w) * s0 * ga[1][2], bf_hi(a.w) * s0 * ga[1][3]);
                o1.x = pk2(bf_lo(bb.x) * s1 * gb[0][0], bf_hi(bb.x) * s1 * gb[0][1]); o1.y = pk2(bf_lo(bb.y) * s1 * gb[0][2], bf_hi(bb.y) * s1 * gb[0][3]);
                o1.z = pk2(bf_lo(bb.z) * s1 * gb[1][0], bf_hi(bb.z) * s1 * gb[1][1]); o1.w = pk2(bf_lo(bb.w) * s1 * gb[1][2], bf_hi(bb.w) * s1 * gb[1][3]);
                *(u32x4*)(yr + c0) = o0; *(u32x4*)(yr + c1) = o1;
            }
        }
    }
    __syncthreads();
}
}

#ifdef NO_G1
#define GEMM_SITE1(x)
#else
#define GEMM_SITE1(x) x
#endif
#ifdef NO_G2
#define GEMM_SITE2(x)
#else
#define GEMM_SITE2(x) x
#endif
#ifdef NO_G3
#define GEMM_SITE3(x)
#else
#define GEMM_SITE3(x) x
#endif
#ifdef NO_G4
#define GEMM_SITE4(x)
#else
#define GEMM_SITE4(x) x
#endif
#ifdef NO_G5
#define GEMM_SITE5(x)
#else
#define GEMM_SITE5(x) x
#endif
#ifdef NO_G6
#define GEMM_SITE6(x)
#else
#define GEMM_SITE6(x) x
#endif
#ifdef NO_G7
#define GEMM_SITE7(x)
#else
#define GEMM_SITE7(x) x
#endif
struct Args { const float* in[18]; float* out; unsigned char* ws; int ph_lo, ph_hi, use_bar, pad; };
constexpr int PH_PER_LAYER = 16, SEQ_FINAL = 1 + DEPTH * PH_PER_LAYER, SEQ_END = SEQ_FINAL + 1;

__global__ void __launch_bounds__(NWAVES * 64, 2) fwd_kernel(Args args) {
    extern __shared__ __attribute__((aligned(16))) unsigned char lds_raw[];
    Frame F;
    F.lds = (LAS unsigned char*)lds_raw; F.misc = F.lds + MISC_OFF;
    F.tid = threadIdx.x; F.lane = F.tid & 63; F.wave = __builtin_amdgcn_readfirstlane(F.tid >> 6);
    F.G = gridDim.x; F.bx = blockIdx.x; F.ws = args.ws; F.out = args.out;
    if (F.tid == 0) {
#pragma unroll
        for (int i = 0; i < 18; ++i) ((LAS unsigned long long*)(F.misc + MISC_PTAB))[i] = (unsigned long long)args.in[i];
        ((LAS unsigned long long*)(F.misc + MISC_PTAB))[18] = (unsigned long long)args.ws; ((LAS unsigned long long*)(F.misc + MISC_PTAB))[19] = (unsigned long long)args.out;
    }
    gu32* ctl = (gu32*)(F.ws + WS_CTL);
    if (F.tid < 4) ((LAS unsigned*)(F.misc + MISC_BARW))[F.tid] = 0u;
    __syncthreads();
    XcdBarrier bar; bar.bar = (unsigned*)(ctl + CW_BAR); bar.x = 0; bar.st = nullptr;
    if (args.use_bar) { bar = xcd_barrier_post((unsigned*)(ctl + CW_BAR), (volatile LAS unsigned*)(F.misc + MISC_BARW)); if (F.tid == 0) ((volatile LAS unsigned*)(F.misc + MISC_BARW))[2] = bar.x; __syncthreads(); }
    const int lo = args.ph_lo, hi = args.ph_hi;
#define IN(k) (lo <= (k) && (k) < hi)
#define LAUNDER() do { unsigned lb_ = (unsigned)(uintptr_t)(LAS unsigned char*)lds_raw; asm volatile("" : "+v"(lb_)); lb_ = (unsigned)__builtin_amdgcn_readfirstlane((int)lb_); F.lds = (LAS unsigned char*)(uintptr_t)lb_; F.misc = F.lds + MISC_OFF; \
    F.ws = (unsigned char*)inp_ptr(F.misc, 18); F.out = (float*)inp_ptr(F.misc, 19); asm volatile("" : "+v"(F.tid), "+v"(F.lane)); F.wave = __builtin_amdgcn_readfirstlane(F.tid >> 6); \
    { int bx_ = F.bx, g_ = F.G; asm volatile("" : "+v"(bx_), "+v"(g_)); F.bx = __builtin_amdgcn_readfirstlane(bx_); F.G = __builtin_amdgcn_readfirstlane(g_); } } while (0)
#define SEAM(k) do { if (args.use_bar && (k) + 1 < hi) { XcdBarrier b_; b_.bar = (unsigned*)((unsigned char*)inp_ptr(F.misc, 18) + WS_CTL) + CW_BAR; b_.st = (volatile LAS unsigned*)(F.misc + MISC_BARW); \
        b_.x = (unsigned)__builtin_amdgcn_readfirstlane((int)((volatile LAS unsigned*)(F.misc + MISC_BARW))[2]); xcd_barrier(b_); if (PROBE_BAR2) xcd_barrier(b_); } else { VM_WAIT(); __syncthreads(); } } while (0)

#define HB ((bf16*)(F.ws + WS_HB))
#define QKV ((bf16*)(F.ws + WS_BIG))
    LAS int* texp_l = (LAS int*)(F.misc + MISC_TEXP);

    if (IN(0)) { LAUNDER(); for (int rep = 0; rep < PROBE_CONV_REPS; ++rep) phase_convert(F);
        if (!(args.use_bar && hi > 2)) SEAM(0); }


    for (int L = 0; L < DEPTH; ++L) {
        const int base = 1 + L * PH_PER_LAYER;
        if (hi <= base || lo >= base + PH_PER_LAYER) continue;
        const bool moe = (L & 1) != 0; const int fi = L >> 1;
        const bool f8 = moe || DENSE_UP8(L), f8d = moe || DENSE_DN8(L);
#define wc (F.ws + WS_WC + (size_t)L * WC_STRIDE)
        const int comb = (L > 0 && ((L - 1) & 1)) ? 1 : 0;
        if (IN(base + 0) && (L == 0 || comb)) {
            LAUNDER();
            RowPass P{}; P.xsrc = (L == 0) ? INP(0) : (const float*)nullptr; P.xbf = (const bf16*)F.out; P.combine = comb; P.xdst = (bf16*)F.out; P.gain = INP(2) + (size_t)L * D;
            P.ob = nullptr; P.obp = XP; P.ssq = (float*)(F.ws + WS_SSQ); P.ob8 = nullptr; P.of = nullptr; P.router = 0; P.wr = nullptr;
            phase_rows(F, P);
            if (L == 0) phase_memnorm(F);
            SEAM(base + 0);
        }
        if (IN(base + 1)) {
            LAUNDER();
#if QKV_FP8
            { pg8::Gemm g{HB, (const bf16*)(wc + WC_IN), M, NQKV, D / 2, 0}; pg8::TileOrder S; S.init(M, NQKV, F.G, F.bx, nullptr);
              pg8::EpiQKVT<true> E{QKV, (const float*)(F.ws + WS_COS), (const float*)(F.ws + WS_SIN), ACC8_SCALE};
              GEMM_SITE1(pg8::gemm_phase(F.lds, g, S, E, F.tid)); }
#else
            { pg8::Gemm g{(const bf16*)F.out, (const bf16*)(wc + WC_IN), M, NQKV, D, 0}; pg8::TileOrder S; S.init(M, NQKV, F.G, F.bx, nullptr);
              pg8::EpiQKVT<false> E{QKV, (const float*)(F.ws + WS_COS), (const float*)(F.ws + WS_SIN), 1.0f, (const float*)(F.ws + WS_SSQ), 1};
              GEMM_SITE1(pg8::gemm_phase(F.lds, g, S, E, F.tid)); }
#endif
            if (L == 0) {
                LAUNDER();
                __syncthreads();
                for (int i = F.tid; i < MAXTILES + 8; i += 512) texp_l[i] = i >> 3;
                __syncthreads();
                pg8::Gemm g{(const bf16*)(F.ws + WS_MEMN4), (const bf16*)(F.ws + WS_WC + WC_MKV), DEPTH * MROWS, 512, D, WC_STRIDE}; pg8::TileOrder S; S.init(DEPTH * MROWS, 512, F.G, F.bx, texp_l);
                pg8::EpiPlain E{(bf16*)(F.ws + WS_MEMKV4), 512};
                GEMM_SITE2(pg8::gemm_phase(F.lds, g, S, E, F.tid));
            }
            SEAM(base + 1);
        }
        if (IN(base + 2)) {
            LAUNDER();
#ifndef NO_ATT
            for (int rep = 0; rep < PROBE_ATT_REPS; ++rep)
            for (int v = F.bx; v < M / 256; v += F.G) { const int u = (F.G == 256) ? ((v & 7) * 32 + (v >> 3)) : v;
                att::attn_unit(F, u >> 5, (u & 31) * 256, L); }
#endif
            SEAM(base + 2);
        }
        if (IN(base + 3)) {
            LAUNDER();
            pg8::Gemm g{HB, (const bf16*)(wc + WC_OUT), M, D, D, 0}; pg8::TileOrder S; S.init(M, D, F.G, F.bx, nullptr);
            pg8::EpiResT<false> E{(const float*)nullptr, (bf16*)F.out, nullptr, D, 0, 1.0f};
            GEMM_SITE3(pg8::gemm_phase(F.lds, g, S, E, F.tid));
            SEAM(base + 3);
        }
        if (IN(base + 4)) {
            LAUNDER();
            RowPass P{}; P.xsrc = nullptr; P.xbf = (const bf16*)F.out; P.xdst = nullptr; P.combine = 0; P.gain = INP(9) + (size_t)L * D; P.ob = f8 ? nullptr : HB; P.obp = D; P.ssq = nullptr; P.ob8 = f8 ? (unsigned char*)(F.ws + WS_HB) : nullptr; P.of = nullptr; P.router = moe ? 1 : 0; P.wr = INP(13) + (size_t)fi * D * NE;
            phase_rows(F, P);
            if (PROBE_PE2) { __syncthreads(); phase_rows(F, P); }
            SEAM(base + 4);
        }
        if (moe && IN(base + 5)) { LAUNDER(); phase_moe_assign(F); SEAM(base + 5); }
        int nT = M / 256;
        if (moe && hi > base + 6 && lo < base + 16) nT = __builtin_amdgcn_readfirstlane(((const int*)(F.ws + WS_TEXP))[MAXTILES]);
        nT = nT < 0 ? 0 : (nT > MAXTILES ? MAXTILES : nT);
        const int ntail = (moe && nT > 2 * CHUNK_TILES) ? nT - 2 * CHUNK_TILES : 0;
        const int nsteps = !moe ? 2 : 4;
        for (int k = 0; k < nsteps; ++k) {
            const int pk = base + 6 + k;
            if (!IN(pk)) continue;
            LAUNDER();
            int dc = -1, uc = -1;
            if (!moe) { if (k == 0) uc = 0; else dc = 0; }
            else {
                if (k == 0) uc = 0; else if (k == 1) { dc = 0; uc = ntail ? 2 : -1; } else if (k == 2) { dc = ntail ? 2 : -1; uc = 1; } else dc = 1; }
            {
                __syncthreads();
                const int* tg = (const int*)(F.ws + WS_TEXP);
                for (int i = F.tid; i < MAXTILES + 8; i += 512) texp_l[i] = (moe && i < nT) ? tg[i] : 0;
                __syncthreads();
            }
#define CH_TILE0(ch) (moe ? (ch) * CHUNK_TILES : 0)
#define CH_NTILE(ch) (moe ? ((nT - CH_TILE0(ch)) < CHUNK_TILES ? (nT - CH_TILE0(ch)) : CHUNK_TILES) : M / 256)
#define CH_HID(ch) (moe ? ((ch) == 2 ? (bf16*)(F.ws + WS_MEMN4) : (bf16*)(F.ws + WS_HIDC)) : (bf16*)(F.ws + WS_BIG))
            if (dc >= 0) {
                const int tile0 = CH_TILE0(dc), ntile = CH_NTILE(dc); bf16* hid = CH_HID(dc);
                if (f8d) {
                    pg8::Gemm g{hid, moe ? (const bf16*)(F.ws + WS_WM + (size_t)fi * WM_STRIDE + WM_DOWN) : (const bf16*)(F.ws + WS_WD + (size_t)fi * WD_STRIDE + 14 * MiB), ntile * 256, D, FF / 2, WD8_ESTRIDE};
                    pg8::TileOrder S; S.init(ntile * 256, D, F.G, F.bx, texp_l + tile0);
                    pg8::EpiResT<true> E{nullptr, (bf16*)F.out, (bf16*)(F.ws + WS_GA) + (size_t)tile0 * 256 * D, D, moe ? 1 : 2, ACCD8_SCALE};
                    GEMM_SITE5(pg8::gemm_phase(F.lds, g, S, E, F.tid));
                } else {
                    pg8::Gemm g{hid, (const bf16*)(F.ws + WS_WD + (size_t)fi * WD_STRIDE + 14 * MiB), ntile * 256, D, FF, 0}; pg8::TileOrder S; S.init(ntile * 256, D, F.G, F.bx, texp_l + tile0);
                    pg8::EpiResT<false> E{nullptr, (bf16*)F.out, nullptr, D, 2, 1.0f};
                    GEMM_SITE7(pg8::gemm_phase(F.lds, g, S, E, F.tid));
                }
            }
            if (dc >= 0 && uc >= 0) { LAUNDER(); __syncthreads(); }
            if (uc >= 0) {
                const int tile0 = CH_TILE0(uc), ntile = CH_NTILE(uc); bf16* hid = CH_HID(uc);
                if (f8) {
                    pg8::Gemm g{moe ? (const bf16*)(F.ws + WS_GA8 + (size_t)tile0 * 256 * D) : (const bf16*)(F.ws + WS_HB),
                                moe ? (const bf16*)(F.ws + WS_WM + (size_t)fi * WM_STRIDE) : (const bf16*)(F.ws + WS_WD + (size_t)fi * WD_STRIDE), ntile * 256, 2 * FF, D / 2, (size_t)7 * MiB};
                    pg8::TileOrderSkew S; S.init(ntile * 256, 2 * FF, F.G, F.bx, texp_l + tile0);
                    const bool sk = moe && (dc == 2) && (ntile == F.G);
                    S.nsk = sk ? 4 * CH_NTILE(dc) : 0; S.kd = 3; S.per = 28;
                    pg8::EpiSwigluT<true> E{hid, ACC8_SCALE, f8d ? 0 : 1};
                    GEMM_SITE4(pg8::gemm_phase(F.lds, g, S, E, F.tid));
                } else {
                    pg8::Gemm g{HB, (const bf16*)(F.ws + WS_WD + (size_t)fi * WD_STRIDE), ntile * 256, 2 * FF, D, 0}; pg8::TileOrder S; S.init(ntile * 256, 2 * FF, F.G, F.bx, texp_l + tile0);
                    pg8::EpiSwigluT<false> E{hid, 1.0f, 1};
                    GEMM_SITE6(pg8::gemm_phase(F.lds, g, S, E, F.tid));
                }
            }
            SEAM(pk);
        }
    }
    if (IN(SEQ_FINAL)) {
        LAUNDER();
        RowPass P{}; P.xsrc = nullptr; P.xbf = (const bf16*)F.out; P.xdst = nullptr; P.combine = 1; P.gain = INP(17); P.ob = nullptr; P.obp = D; P.ssq = nullptr; P.of = F.out; P.router = 0; P.wr = nullptr;
        phase_rows(F, P);
    }
#undef IN
#undef SEAM
}

extern "C" void kernel_launch(void* const* d_in, const int* in_sizes, int n_in, void* d_out, int out_size, void* d_ws, size_t ws_size, hipStream_t stream) {
    static int grid = 0;
    if (grid == 0) {
        if (n_in != 18 || out_size != M * D || ws_size < WS_END) { fprintf(stderr, "kernel_launch: unexpected problem (n_in %d out %d ws %zu)\n", n_in, out_size, ws_size); grid = -1; return; }
        int dev = 0, cus = 0, per_cu = 0;
        if (hipGetDevice(&dev) != hipSuccess || hipDeviceGetAttribute(&cus, hipDeviceAttributeMultiprocessorCount, dev) != hipSuccess) { grid = -1; return; }
        if (hipFuncSetAttribute((const void*)fwd_kernel, hipFuncAttributeMaxDynamicSharedMemorySize, LDS_BYTES) != hipSuccess) { fprintf(stderr, "kernel_launch: hipFuncSetAttribute failed\n"); grid = -1; return; }
        if (hipOccupancyMaxActiveBlocksPerMultiprocessor(&per_cu, (const void*)fwd_kernel, NWAVES * 64, LDS_BYTES) != hipSuccess || per_cu < 1) fprintf(stderr, "kernel_launch: occupancy query says %d\n", per_cu);
        (void)hipGetLastError();
        grid = cus;
    }
    if (grid < 0) return;
    (void)hipMemsetAsync((char*)d_ws + WS_CTL, 0, CTL_ZERO_BYTES, stream);
    Args a{};
    for (int i = 0; i < 18; ++i) a.in[i] = (const float*)d_in[i];
    a.out = (float*)d_out; a.ws = (unsigned char*)d_ws; a.pad = 0;
#if MK_ONE_LAUNCH
    a.ph_lo = 0; a.ph_hi = SEQ_END; a.use_bar = 1;
    hipLaunchKernelGGL(fwd_kernel, dim3(grid), dim3(NWAVES * 64), LDS_BYTES, stream, a);
#else
    a.use_bar = 0;
#ifndef MAXSEQ
#define MAXSEQ 1000
#ifndef PROBE_ATT_REPS
#define PROBE_ATT_REPS 1
#endif
#ifndef PROBE_QKV_REPS
#define PROBE_QKV_REPS 1
#endif
#ifndef PROBE_CONV_REPS
#define PROBE_CONV_REPS 1
#endif
#endif
    auto run = [&](int k) { if (k >= MAXSEQ) return; a.ph_lo = k; a.ph_hi = k + 1; hipLaunchKernelGGL(fwd_kernel, dim3(grid), dim3(NWAVES * 64), LDS_BYTES, stream, a); };
    run(0);
    for (int L = 0; L < DEPTH; ++L) {
        const int base = 1 + L * PH_PER_LAYER; const bool moe = (L & 1) != 0;
        for (int k = 0; k < 5; ++k) run(base + k);
        if (moe) { run(base + 5); for (int c = 0; c < NCHUNK; ++c) { run(base + 6 + 2 * c); run(base + 7 + 2 * c); } }
        else { run(base + 6); run(base + 7); }
    }
    run(SEQ_FINAL);
#endif
}
```
